# Optimizing an MI355X kernel written in HIP

```python
import jax, jax.numpy as jnp
from jax import lax
import numpy as np


D_MODEL = 2048
BATCH = 1
SEQ = 8192
DEPTH = 4
DEC_BATCH = 2
DEC_SEQ = 4096
PAST_LEN = 128

HEAD_DIM = 128
DILATED_GROUPS = ((128, 1), (512, 4), (2048, 16))
A_HEADS_PER_GROUP = 4
A_HEADS = A_HEADS_PER_GROUP * len(DILATED_GROUPS)
A_OUT = A_HEADS_PER_GROUP * HEAD_DIM
B_Q_HEADS = 8
B_KV_HEADS = 2
B_HALF_WINDOW = 128
B_OUT = B_Q_HEADS * HEAD_DIM
C_HEADS = 8
C_OUT = C_HEADS * HEAD_DIM
GRID_W = 64
NA_ROWS = 8
NA_COLS = 16
T5_BUCKETS = 32
T5_MAX_DIST = 1024
T5_HEADS = A_HEADS + B_Q_HEADS
D_FF = 5632
N_BRANCHES = 3
EPS = 1e-6
NEG_INF = -1e30
IN_SPLITS = (A_HEADS * HEAD_DIM, A_HEADS * HEAD_DIM, A_HEADS * HEAD_DIM,
             B_Q_HEADS * HEAD_DIM, B_KV_HEADS * HEAD_DIM, B_KV_HEADS * HEAD_DIM,
             C_HEADS * HEAD_DIM, C_HEADS * HEAD_DIM, C_HEADS * HEAD_DIM,
             N_BRANCHES * D_MODEL)
D_IN = sum(IN_SPLITS)

kernel_name = "hybrid_dilated_window_neighbourhood_encoder"


def rms_norm(x, g):
    xf = x.astype(jnp.float32)
    y = xf * lax.rsqrt(jnp.mean(xf * xf, axis=-1, keepdims=True) + EPS)
    return (y * g.astype(jnp.float32)).astype(x.dtype)


def swiglu_ffn(x, g, w_in, w_out):
    h = rms_norm(x, g)
    gate, up = jnp.split(h @ w_in, 2, axis=-1)
    return (jax.nn.silu(gate) * up) @ w_out


def t5_bucket(rel):
    nb = T5_BUCKETS // 2
    max_exact = nb // 2
    sign = (rel > 0).astype(np.int32) * nb
    n = np.abs(rel)
    large = max_exact + (np.log(np.maximum(n, 1) / max_exact) / np.log(T5_MAX_DIST / max_exact)
                         * (nb - max_exact)).astype(np.int32)
    large = np.minimum(large, nb - 1)
    return sign + np.where(n < max_exact, n, large)


def band_attn(q, k, v, hw, bias):
    n, L, hq, dh = q.shape
    hkv = k.shape[2]
    rep = hq // hkv
    blk = hw
    nb = -(-L // blk)
    lp = nb * blk
    qb = jnp.pad(q, ((0, 0), (0, lp - L), (0, 0), (0, 0))).reshape(n, nb, blk, hkv, rep, dh)
    kv_pad = ((0, 0), (blk, lp - L + blk), (0, 0), (0, 0))
    idx = np.arange(nb)[:, None] * blk + np.arange(3 * blk)[None, :]
    kb = jnp.pad(k, kv_pad)[:, idx]
    vb = jnp.pad(v, kv_pad)[:, idx]
    qpos = np.arange(nb)[:, None] * blk + np.arange(blk)[None, :]
    kpos = idx - blk
    valid = ((np.abs(kpos[:, None, :] - qpos[:, :, None]) <= hw)
             & (kpos[:, None, :] >= 0) & (kpos[:, None, :] < L))
    s = jnp.einsum('nbqgrd,nbkgd->nbgrqk', qb, kb, preferred_element_type=jnp.float32) * (dh ** -0.5)
    s = s + bias.astype(jnp.float32).reshape(hkv, rep, blk, 3 * blk)
    s = jnp.where(valid[None, :, None, None], s, NEG_INF)
    m = jnp.max(s, axis=-1)
    p = jnp.exp(s - m[..., None])
    den = jnp.sum(p, axis=-1)
    num = jnp.einsum('nbgrqk,nbkgd->nbqgrd', p, vb.astype(jnp.float32))
    num = num.reshape(n, lp, hq, dh)[:, :L]
    m = m.transpose(0, 1, 4, 2, 3).reshape(n, lp, hq)[:, :L]
    den = den.transpose(0, 1, 4, 2, 3).reshape(n, lp, hq)[:, :L]
    return num, m, den


def to_residue(x, d):
    b, L = x.shape[:2]
    y = x.reshape((b, L // d, d) + x.shape[2:])
    return jnp.swapaxes(y, 1, 2).reshape((b * d, L // d) + x.shape[2:])


def from_residue(y, d, b):
    y = y.reshape((b, d) + y.shape[1:])
    return jnp.swapaxes(y, 1, 2).reshape((b, -1) + y.shape[3:])


def dilated_attn(q, k, v, rel_bias):
    b, L = q.shape[:2]
    nums, ms, dens = [], [], []
    for g, (w, d) in enumerate(DILATED_GROUPS):
        hw = w // (2 * d)
        sl = slice(g * A_HEADS_PER_GROUP, (g + 1) * A_HEADS_PER_GROUP)
        qg, kg, vg = to_residue(q[:, :, sl], d), to_residue(k[:, :, sl], d), to_residue(v[:, :, sl], d)
        rel = (np.arange(3 * hw)[None, :] - hw - np.arange(hw)[:, None]) * d
        bias = rel_bias[t5_bucket(rel)][:, :, sl].transpose(2, 0, 1)
        num, m, den = band_attn(qg, kg, vg, hw, bias)
        nums.append(from_residue(num, d, b))
        ms.append(from_residue(m, d, b))
        dens.append(from_residue(den, d, b))
    m_all = jnp.max(jnp.stack(ms), axis=0)
    wts = [jnp.exp(mg - m_all) for mg in ms]
    numer = sum(wg[..., None] * ng for wg, ng in zip(wts, nums))
    denom = sum(wg * dg for wg, dg in zip(wts, dens))
    return (numer / denom[..., None]).reshape(b, L, A_OUT)


def window_sink_attn(q, k, v, sink, rel_bias):
    b, L = q.shape[:2]
    hw = B_HALF_WINDOW
    rel = np.arange(3 * hw)[None, :] - hw - np.arange(hw)[:, None]
    bias = rel_bias[t5_bucket(rel)][:, :, A_HEADS:].transpose(2, 0, 1)
    num, m, den = band_attn(q, k, v, hw, bias)
    s = sink.astype(jnp.float32)
    m2 = jnp.maximum(m, s)
    a = jnp.exp(m - m2)
    o = num * a[..., None] / (den * a + jnp.exp(s - m2))[..., None]
    return o.reshape(b, L, B_OUT)


def neighborhood_attn(q, k, v, rpb):
    b, L, h, dh = q.shape
    rows = L // GRID_W
    kr = min(NA_ROWS, rows)
    kc = NA_COLS
    ncb = GRID_W // kc
    ck = 2 * kc
    r = np.arange(rows)
    rs = np.clip(r - kr // 2, 0, rows - kr)
    key_rows = rs[:, None] + np.arange(kr)[None, :]
    cbi = np.arange(ncb)
    cs = np.clip(cbi * kc - kc // 2, 0, GRID_W - ck)
    key_cols = cs[:, None] + np.arange(ck)[None, :]
    tok = (key_rows[:, None, :, None] * GRID_W + key_cols[None, :, None, :]).reshape(rows, ncb, kr * ck)
    kg = k[:, tok]
    vg = v[:, tok]
    qb = q.reshape(b, rows, ncb, kc, h, dh)
    qcol = cbi[:, None] * kc + np.arange(kc)[None, :]
    qstart = np.clip(qcol - kc // 2, 0, GRID_W - kc)
    colvalid = ((key_cols[:, None, :] >= qstart[:, :, None])
                & (key_cols[:, None, :] < qstart[:, :, None] + kc))
    mask = np.broadcast_to(colvalid[:, :, None, :], (ncb, kc, kr, ck)).reshape(ncb, kc, kr * ck)
    dr_idx = key_rows - r[:, None] + NA_ROWS - 1
    dc_idx = np.clip(key_cols[:, None, :] - qcol[:, :, None] + kc - 1, 0, 2 * kc - 2)
    bias = rpb[:, dr_idx[:, None, None, :, None], dc_idx[None, :, :, None, :]]
    bias = bias.reshape(h, rows, ncb, kc, kr * ck).transpose(1, 2, 0, 3, 4).astype(jnp.float32)
    s = jnp.einsum('brcqhd,brckhd->brchqk', qb, kg, preferred_element_type=jnp.float32) * (dh ** -0.5)
    s = jnp.where(mask[None, None, :, None], s + bias[None], NEG_INF)
    p = jax.nn.softmax(s, axis=-1)
    o = jnp.einsum('brchqk,brckhd->brcqhd', p, vg.astype(jnp.float32))
    return o.reshape(b, L, C_OUT)


def token_mixer(x, norm_g, w_in, qk_g, sink, rpb, rel_bias, w_ba, w_bb, w_bc, w_o):
    b, L, _ = x.shape
    h = rms_norm(x, norm_g)
    parts = jnp.split(h @ w_in, np.cumsum(IN_SPLITS)[:-1].tolist(), axis=-1)
    qa, ka, va, qb, kb, vb, qc, kc, vc = [t.reshape(b, L, -1, HEAD_DIM) for t in parts[:9]]
    qa, ka = rms_norm(qa, qk_g[0]), rms_norm(ka, qk_g[1])
    qb, kb = rms_norm(qb, qk_g[2]), rms_norm(kb, qk_g[3])
    qc, kc = rms_norm(qc, qk_g[4]), rms_norm(kc, qk_g[5])
    o_a = dilated_attn(qa, ka, va, rel_bias).astype(x.dtype)
    o_b = window_sink_attn(qb, kb, vb, sink, rel_bias).astype(x.dtype)
    o_c = neighborhood_attn(qc, kc, vc, rpb).astype(x.dtype)
    gates = jax.nn.sigmoid(parts[9].astype(jnp.float32)).astype(x.dtype).reshape(b, L, N_BRANCHES, D_MODEL)
    z = gates[:, :, 0] * (o_a @ w_ba) + gates[:, :, 1] * (o_b @ w_bb) + gates[:, :, 2] * (o_c @ w_bc)
    return z @ w_o


def run_trunk(x, rel_bias, ffn1_norm, ffn1_w_in, ffn1_w_out, mix_norm, w_in, qk_norm, sink, rpb,
              w_branch_a, w_branch_b, w_branch_c, w_out, ffn2_norm, ffn2_w_in, ffn2_w_out):
    for l in range(DEPTH):
        x = x + 0.5 * swiglu_ffn(x, ffn1_norm[l], ffn1_w_in[l], ffn1_w_out[l])
        x = x + token_mixer(x, mix_norm[l], w_in[l], qk_norm[l], sink[l], rpb[l], rel_bias,
                            w_branch_a[l], w_branch_b[l], w_branch_c[l], w_out[l])
        x = x + 0.5 * swiglu_ffn(x, ffn2_norm[l], ffn2_w_in[l], ffn2_w_out[l])
    return x


def setup_inputs(seed: int = 0) -> dict:
    key = jax.random.key(seed)
    ks = jax.random.split(key, 19)

    def nrm(k, shape, scale):
        return jax.random.normal(k, shape, jnp.float32) * scale

    return {
        "x_prompt": nrm(ks[0], (BATCH, SEQ, D_MODEL), 1.0),
        "x_sample": nrm(ks[1], (DEC_BATCH, DEC_SEQ, D_MODEL), 1.0),
        "rel_bias": nrm(ks[2], (T5_BUCKETS, T5_HEADS), 0.2),
        "ffn1_norm": 1.0 + nrm(ks[3], (DEPTH, D_MODEL), 0.05),
        "ffn1_w_in": nrm(ks[4], (DEPTH, D_MODEL, 2 * D_FF), D_MODEL ** -0.5),
        "ffn1_w_out": nrm(ks[5], (DEPTH, D_FF, D_MODEL), 0.5 * D_FF ** -0.5),
        "mix_norm": 1.0 + nrm(ks[6], (DEPTH, D_MODEL), 0.05),
        "w_in": nrm(ks[7], (DEPTH, D_MODEL, D_IN), D_MODEL ** -0.5),
        "qk_norm": 1.0 + nrm(ks[8], (DEPTH, 6, HEAD_DIM), 0.05),
        "sink": nrm(ks[9], (DEPTH, B_Q_HEADS), 0.5),
        "rpb": nrm(ks[10], (DEPTH, C_HEADS, 2 * NA_ROWS - 1, 2 * NA_COLS - 1), 0.2),
        "w_branch_a": nrm(ks[11], (DEPTH, A_OUT, D_MODEL), A_OUT ** -0.5),
        "w_branch_b": nrm(ks[12], (DEPTH, B_OUT, D_MODEL), B_OUT ** -0.5),
        "w_branch_c": nrm(ks[13], (DEPTH, C_OUT, D_MODEL), C_OUT ** -0.5),
        "w_out": nrm(ks[14], (DEPTH, D_MODEL, D_MODEL), 0.5 * D_MODEL ** -0.5),
        "ffn2_norm": 1.0 + nrm(ks[15], (DEPTH, D_MODEL), 0.05),
        "ffn2_w_in": nrm(ks[16], (DEPTH, D_MODEL, 2 * D_FF), D_MODEL ** -0.5),
        "ffn2_w_out": nrm(ks[17], (DEPTH, D_FF, D_MODEL), 0.5 * D_FF ** -0.5),
    }


def reference(x_prompt, x_sample, rel_bias, ffn1_norm, ffn1_w_in, ffn1_w_out, mix_norm, w_in, qk_norm,
              sink, rpb, w_branch_a, w_branch_b, w_branch_c, w_out, ffn2_norm, ffn2_w_in, ffn2_w_out):
    y_prompt = run_trunk(x_prompt, rel_bias, ffn1_norm, ffn1_w_in, ffn1_w_out, mix_norm, w_in, qk_norm,
                         sink, rpb, w_branch_a, w_branch_b, w_branch_c, w_out, ffn2_norm, ffn2_w_in,
                         ffn2_w_out)
    y_sample = run_trunk(x_sample, rel_bias, ffn1_norm, ffn1_w_in, ffn1_w_out, mix_norm, w_in, qk_norm,
                         sink, rpb, w_branch_a, w_branch_b, w_branch_c, w_out, ffn2_norm, ffn2_w_in,
                         ffn2_w_out)
    return (y_prompt, y_sample)
```

```cpp
#include <hip/hip_runtime.h>
#include <cstdio>
#include <cstdint>

#ifndef ONE_LAUNCH
#define ONE_LAUNCH 0
#endif

typedef unsigned long long u64;
namespace pg8 {
#define PG8_LAS __attribute__((address_space(3)))
typedef unsigned short bf16_t;
typedef short bf16x8 __attribute__((ext_vector_type(8)));
typedef float f32x4 __attribute__((ext_vector_type(4)));
typedef unsigned u32x4 __attribute__((ext_vector_type(4)));
typedef unsigned u32x2 __attribute__((ext_vector_type(2)));
constexpr int BM = 256, BK = 64, HALF = 128, HTB = HALF * BK * 2, STAGE_BYTES = 8 * HTB, NXCD = 8, WGM = 8;

__host__ __device__ __forceinline__ int lds_byte(int r, int c) { const int st = (r >> 4) * 2 + (c >> 5), rr = r & 15, cc = c & 31, ob = rr * 64 + cc * 2; return st * 1024 + (ob ^ (((ob >> 9) & 1) << 5)); }
__host__ __device__ __forceinline__ void stage_rc(int b, int& R, int& C) { const int st = b / 1024, sb = b % 1024, swz = sb ^ (((sb >> 9) & 1) << 5); R = (st >> 1) * 16 + swz / 64; C = (st & 1) * 32 + (swz % 64) / 2; }
__host__ __device__ __forceinline__ int perm32(int rho) { const int n = rho >> 4, i = rho & 15; return 8 * (i >> 2) + 4 * n + (i & 3); }

struct Unit { int pm, pn; };
struct Gemm { const bf16_t* A; const bf16_t* Bt; int M, N, K; };

struct StaticOrder {
    int nM, nN, nwg, G, c;
    __host__ __device__ void init(int M, int N, int G_, int c_) { nM = M / BM; nN = N / BM; nwg = nM * nN; G = G_; c = c_; }
    __host__ __device__ bool next(int i, Unit& u) const {
        const long L = (long)i * G + c; if (L >= nwg) return false;
        int wgid = (int)L; { const int q = nwg / NXCD, r = nwg % NXCD, xcd = wgid % NXCD, off = wgid / NXCD; wgid = (xcd < r ? xcd * (q + 1) : r * (q + 1) + (xcd - r) * q) + off; }
        const int nig = WGM * nN, gid = wgid / nig, fm = gid * WGM, gsz = (nM - fm) < WGM ? (nM - fm) : WGM;
        u.pm = fm + ((wgid % nig) % gsz); u.pn = (wgid % nig) / gsz; return true;
    }
    __device__ __forceinline__ void a_ready(const Unit&) const {}
    __device__ __forceinline__ void done(const Unit&) const {}
};

__device__ __forceinline__ unsigned cvt_pk_bf16(float lo, float hi) { unsigned r; asm volatile("v_cvt_pk_bf16_f32 %0, %1, %2" : "=v"(r) : "v"(lo), "v"(hi)); return r; }
__device__ __forceinline__ float bf_lo(unsigned w) { return __uint_as_float(w << 16); }
__device__ __forceinline__ float bf_hi(unsigned w) { return __uint_as_float(w & 0xffff0000u); }

template <class Epi, class Sched, bool ALIGN_EPI = false, bool SP2 = false>
__device__ __forceinline__ void gemm_phase(PG8_LAS unsigned char* lds, const Gemm g, const Sched& S, const Epi& E) {
    int tid_ = threadIdx.x; asm volatile("" : "+v"(tid_));
    const int tid = tid_, wid = __builtin_amdgcn_readfirstlane(tid >> 6), lane = tid & 63, wr = wid >> 2, wc = wid & 3, fr = lane & 15, fq = lane >> 4;
    const int K = g.K, nt = K / BK;
    unsigned voffA[2], voffB[2];
#pragma unroll
    for (int i = 0; i < 2; ++i) { int R, C; stage_rc(tid * 16 + i * 8192, R, C); const int Rb = Epi::PERM ? ((R & ~31) + perm32(R & 31)) : R;
        voffA[i] = (unsigned)(R * K + C) * 2u; voffB[i] = (unsigned)(Rb * K + C) * 2u; }
    const size_t kstep = (size_t)(BK * 2);
    const size_t hstep = (size_t)HALF * K * 2;
    const size_t tstep = 2 * hstep;
    const unsigned ldsw = (unsigned)wid * 1024u;
    const int aoff = lds_byte(wr * 64 + fr, fq * 8), boff = lds_byte(wc * 32 + fr, fq * 8);
#define PG8_SA(b, h) (((b) * 2 + (h)) * HTB)
#define PG8_SB(b, h) ((4 + (b) * 2 + (h)) * HTB)
#define PG8_STAGE(bufoff, gbase, voff) do { _Pragma("unroll") for (int _i = 0; _i < 2; ++_i) \
        __builtin_amdgcn_global_load_lds((const unsigned*)((const char*)(gbase) + (voff)[_i]), (PG8_LAS unsigned*)(lds + (bufoff) + ldsw + _i * 8192), 16, 0, 0); } while (0)
#define PG8_LDA(dst, b, h) do { _Pragma("unroll") for (int m = 0; m < 4; ++m) _Pragma("unroll") for (int k = 0; k < 2; ++k) dst[m][k] = *(const PG8_LAS bf16x8*)(lds + PG8_SA(b, h) + aoff + m * 2048 + k * 1024); } while (0)
#define PG8_LDB(dst, b, h) do { _Pragma("unroll") for (int n = 0; n < 2; ++n) _Pragma("unroll") for (int k = 0; k < 2; ++k) dst[n][k] = *(const PG8_LAS bf16x8*)(lds + PG8_SB(b, h) + boff + n * 2048 + k * 1024); } while (0)
#define PG8_MMA(ai, bj, At, Bt) do { __builtin_amdgcn_s_setprio(1); _Pragma("unroll") for (int m = 0; m < 4; ++m) _Pragma("unroll") for (int n = 0; n < 2; ++n) _Pragma("unroll") for (int k = 0; k < 2; ++k) \
        acc[ai][bj][m][n] = __builtin_amdgcn_mfma_f32_16x16x32_bf16(Bt[n][k], At[m][k], acc[ai][bj][m][n], 0, 0, 0); __builtin_amdgcn_s_setprio(0); } while (0)
#define PG8_WAIT_V(n) asm volatile("s_waitcnt vmcnt(" #n ")" ::: "memory")
#define PG8_WAIT_L(n) asm volatile("s_waitcnt lgkmcnt(" #n ")" ::: "memory")
#define PG8_BAR __builtin_amdgcn_s_barrier()
#define PG8_SCHED __builtin_amdgcn_sched_barrier(0)
    Unit cur, nxt; int ui = 0;
    if (!S.next(0, cur)) return;
    f32x4 acc[2][2][4][2];
#pragma unroll
    for (int a = 0; a < 2; ++a)
#pragma unroll
        for (int b = 0; b < 2; ++b)
#pragma unroll
            for (int m = 0; m < 4; ++m)
#pragma unroll
                for (int n = 0; n < 2; ++n) acc[a][b][m][n] = (f32x4){0.f, 0.f, 0.f, 0.f};
    bf16x8 At[4][2], B0[2][2], B1[2][2];
    const char* cA = (const char*)g.A + (size_t)cur.pm * tstep; const char* cB = (const char*)g.Bt + (size_t)cur.pn * tstep;
    S.a_ready(cur);
    if constexpr (SP2) {
        PG8_STAGE(PG8_SB(0, 0), cB, voffB); PG8_STAGE(PG8_SB(0, 1), cB + hstep, voffB); PG8_STAGE(PG8_SA(0, 0), cA, voffA); PG8_STAGE(PG8_SA(0, 1), cA + hstep, voffA);
        if (wr == 1) PG8_BAR;
        PG8_WAIT_V(2); PG8_BAR;
        PG8_STAGE(PG8_SB(1, 0), cB + kstep, voffB); PG8_STAGE(PG8_SA(1, 0), cA + kstep, voffA); PG8_STAGE(PG8_SB(1, 1), cB + hstep + kstep, voffB);
        PG8_WAIT_V(6); PG8_BAR;
    } else {
        PG8_STAGE(PG8_SB(0, 0), cB, voffB); PG8_STAGE(PG8_SA(0, 0), cA, voffA); PG8_STAGE(PG8_SB(0, 1), cB + hstep, voffB); PG8_STAGE(PG8_SA(0, 1), cA + hstep, voffA);
        if (wr == 1) PG8_BAR;
        PG8_WAIT_V(4); PG8_BAR;
        PG8_STAGE(PG8_SB(1, 0), cB + kstep, voffB); PG8_STAGE(PG8_SA(1, 0), cA + kstep, voffA); PG8_STAGE(PG8_SB(1, 1), cB + hstep + kstep, voffB);
        PG8_WAIT_V(6); PG8_BAR;
    }
    for (;;) {
        const bool has_next = S.next(ui + 1, nxt);
        const char* nA = has_next ? (const char*)g.A + (size_t)nxt.pm * tstep : cA; const char* nB = has_next ? (const char*)g.Bt + (size_t)nxt.pn * tstep : cB;
        for (int t = 0; t < nt; t += 2) {
            const bool last = (t == nt - 2);
            const char* a1 = cA + (size_t)(t + 1) * kstep;
            const char* a2 = last ? nA : cA + (size_t)(t + 2) * kstep; const char* b2 = last ? nB : cB + (size_t)(t + 2) * kstep;
            const char* a3 = a2 + kstep; const char* b3 = b2 + kstep;
            if (last && has_next) S.a_ready(nxt);
            if constexpr (Epi::MID) { if (t == Epi::MID_T0 || t == Epi::MID_T1) E.mid(acc, cur, t, wr, wc, fr, fq); }
            if constexpr (SP2) {
            PG8_LDB(B0, 0, 0); PG8_LDB(B1, 0, 1); PG8_SCHED; PG8_LDA(At, 0, 0); PG8_STAGE(PG8_SA(1, 1), a1 + hstep, voffA);
            PG8_WAIT_V(8); PG8_WAIT_L(0); PG8_BAR; PG8_MMA(0, 0, At, B0); PG8_MMA(0, 1, At, B1); PG8_BAR; PG8_SCHED;
            PG8_LDA(At, 0, 1); PG8_STAGE(PG8_SB(0, 0), b2, voffB); PG8_STAGE(PG8_SB(0, 1), b2 + hstep, voffB); PG8_STAGE(PG8_SA(0, 0), a2, voffA);
            PG8_WAIT_V(8); PG8_WAIT_L(0); PG8_BAR; PG8_MMA(1, 0, At, B0); PG8_MMA(1, 1, At, B1); PG8_BAR; PG8_SCHED;
            PG8_LDB(B0, 1, 0); PG8_LDB(B1, 1, 1); PG8_SCHED; PG8_LDA(At, 1, 0); PG8_STAGE(PG8_SA(0, 1), a2 + hstep, voffA);
            PG8_WAIT_V(8); PG8_WAIT_L(0); PG8_BAR; PG8_MMA(0, 0, At, B0); PG8_MMA(0, 1, At, B1); PG8_BAR; PG8_SCHED;
            PG8_LDA(At, 1, 1); PG8_STAGE(PG8_SB(1, 0), b3, voffB); PG8_STAGE(PG8_SB(1, 1), b3 + hstep, voffB); PG8_STAGE(PG8_SA(1, 0), a3, voffA);
            PG8_WAIT_V(8); PG8_WAIT_L(0); PG8_BAR; PG8_MMA(1, 0, At, B0); PG8_MMA(1, 1, At, B1); PG8_BAR; PG8_SCHED;
            } else {
            PG8_LDB(B0, 0, 0); PG8_SCHED; PG8_LDA(At, 0, 0); PG8_STAGE(PG8_SA(1, 1), a1 + hstep, voffA);
            PG8_WAIT_L(8); PG8_BAR; PG8_WAIT_L(0); PG8_MMA(0, 0, At, B0); PG8_BAR; PG8_SCHED;
            PG8_LDB(B1, 0, 1); PG8_STAGE(PG8_SB(0, 0), b2, voffB);
            PG8_BAR; PG8_WAIT_L(0); PG8_MMA(0, 1, At, B1); PG8_BAR;
            PG8_LDA(At, 0, 1); PG8_STAGE(PG8_SA(0, 0), a2, voffA);
            PG8_BAR; PG8_WAIT_L(0); PG8_MMA(1, 0, At, B0); PG8_BAR; PG8_SCHED;
            PG8_STAGE(PG8_SB(0, 1), b2 + hstep, voffB);
            PG8_WAIT_V(6); PG8_BAR; PG8_MMA(1, 1, At, B1); PG8_BAR;
            PG8_LDB(B0, 1, 0); PG8_SCHED; PG8_LDA(At, 1, 0); PG8_STAGE(PG8_SA(0, 1), a2 + hstep, voffA);
            PG8_WAIT_L(8); PG8_BAR; PG8_WAIT_L(0); PG8_MMA(0, 0, At, B0); PG8_BAR; PG8_SCHED;
            PG8_LDB(B1, 1, 1); PG8_STAGE(PG8_SB(1, 0), b3, voffB);
            PG8_BAR; PG8_WAIT_L(0); PG8_MMA(0, 1, At, B1); PG8_BAR;
            PG8_LDA(At, 1, 1); PG8_STAGE(PG8_SA(1, 0), a3, voffA);
            PG8_BAR; PG8_WAIT_L(0); PG8_MMA(1, 0, At, B0); PG8_BAR; PG8_SCHED;
            PG8_STAGE(PG8_SB(1, 1), b3 + hstep, voffB);
            PG8_WAIT_V(6); PG8_BAR; PG8_MMA(1, 1, At, B1); PG8_BAR;
            }
        }
        if constexpr (ALIGN_EPI) { if (wr == 0) PG8_BAR; }
        E(acc, cur, wr, wc, fr, fq); S.done(cur);
        if (!has_next) break;
#pragma unroll
        for (int a = 0; a < 2; ++a)
#pragma unroll
            for (int b = 0; b < 2; ++b)
#pragma unroll
                for (int m = 0; m < 4; ++m)
#pragma unroll
                    for (int n = 0; n < 2; ++n) acc[a][b][m][n] = (f32x4){0.f, 0.f, 0.f, 0.f};
        cur = nxt; cA = nA; cB = nB; ++ui;
        if constexpr (ALIGN_EPI) { if (wr == 1) PG8_BAR; }
    }
    PG8_WAIT_V(0);
    if constexpr (!ALIGN_EPI) { if (wr == 0) PG8_BAR; }
    PG8_BAR;
#undef PG8_SA
#undef PG8_SB
#undef PG8_STAGE
#undef PG8_LDA
#undef PG8_LDB
#undef PG8_MMA
#undef PG8_WAIT_V
#undef PG8_WAIT_L
#undef PG8_BAR
#undef PG8_SCHED
}
}

constexpr int M = 16384, D = 2048, FF = 5632, NIN = 15360, KBR = 2560, DEPTH = 4;
constexpr int NWAVES = 8;
constexpr float EPS = 1e-6f;
constexpr float SSQ_SCALE = 16777216.0f;
typedef unsigned short bf16;
typedef pg8::f32x4 f32x4;
typedef pg8::u32x4 u32x4;
typedef pg8::u32x2 u32x2;
#define LAS __attribute__((address_space(3)))

constexpr size_t MiB = 1u << 20;
constexpr size_t WS_CTL = 0, CTL_ZERO_BYTES = 4 * MiB;
constexpr size_t WS_RSQ = 1 * MiB;
constexpr size_t WS_W = 8 * MiB, W_LAYER = 210 * MiB;
constexpr size_t W_1A = 0, W_1B = 44 * MiB, W_IN = 66 * MiB, W_BR = 126 * MiB, W_O = 136 * MiB, W_2A = 144 * MiB, W_2B = 188 * MiB;
constexpr size_t WS_XB = 848 * MiB;
constexpr size_t WS_ACT = 912 * MiB;
constexpr size_t WS_QA = WS_ACT, WS_KA = WS_QA + 48 * MiB, WS_VA = WS_KA + 48 * MiB, WS_QB = WS_VA + 48 * MiB, WS_KB = WS_QB + 32 * MiB, WS_VB = WS_KB + 8 * MiB,
                 WS_QC = WS_VB + 8 * MiB, WS_KC = WS_QC + 32 * MiB, WS_VC = WS_KC + 32 * MiB, WS_G = WS_VC + 32 * MiB;
constexpr size_t WS_O = WS_ACT + 480 * MiB;
constexpr size_t WS_OAG = WS_O + 80 * MiB;
constexpr size_t WS_LSE = WS_OAG + 48 * MiB;
constexpr size_t WS_Z = WS_LSE + 1 * MiB;
constexpr size_t WS_END = WS_Z + 64 * MiB;
static_assert(WS_G + (size_t)M * 6144 * 2 == WS_O, "QKVG map");
static_assert(WS_W + 4 * W_LAYER == WS_XB, "weight map");
constexpr int CW_BAR = 4096;

constexpr int RING_BYTES = 131072, MISC_OFF = RING_BYTES + 320, LDS_BYTES = 147456;

#define XB_TMO      128
#define XB_XCNT(j)  (256  + 64 * (j))
#define XB_XSUB(j)  (1280 + 64 * (j))
#define XB_XGEN(j)  (2304 + 64 * (j))
#define XB_TOP      3328
#define XB_TOPGEN   3392
#define XCD_BAR_WORDS 3456
#define XB_SPIN_CAP (1u << 22)
__device__ __forceinline__ unsigned xb_ld(unsigned* p)              { return __hip_atomic_load(p, __ATOMIC_RELAXED, __HIP_MEMORY_SCOPE_AGENT); }
__device__ __forceinline__ unsigned xb_add(unsigned* p, unsigned v) { return __hip_atomic_fetch_add(p, v, __ATOMIC_RELAXED, __HIP_MEMORY_SCOPE_AGENT); }
__device__ __forceinline__ unsigned xb_xcc_id() { return (unsigned)__builtin_amdgcn_s_getreg((3 << 11) | 20) & 0xFu; }
#define XB_SPIN(cond, bar) do { unsigned _sp = 0; while (cond) { __builtin_amdgcn_s_sleep(1); \
    if ((++_sp & 255u) == 0u) { if (xb_ld(&(bar)[XB_TMO])) break; if (_sp > XB_SPIN_CAP) { atomicAdd(&(bar)[XB_TMO], 1u); break; } } } } while (0)
struct XcdBarrier { unsigned* bar; unsigned x; volatile LAS unsigned* st; };
__device__ __forceinline__ XcdBarrier xcd_barrier_post(unsigned* bar, volatile LAS unsigned* st) {
    XcdBarrier b; b.bar = bar; b.x = xb_xcc_id(); b.st = st;
    if (threadIdx.x == 0) (void)xb_add(&bar[XB_XCNT(b.x)], 1u);
    return b;
}
__device__ __forceinline__ void xcd_barrier_complete(unsigned* bar, unsigned x, unsigned& nloc, unsigned& nx) {
    const unsigned G = gridDim.x * gridDim.y * gridDim.z;
    unsigned sum, cnt, mine, sp = 0u;
    for (;;) {
        sum = 0u; cnt = 0u; mine = 0u;
#pragma unroll
        for (unsigned j = 0; j < 16; ++j) { const unsigned c = xb_ld(&bar[XB_XCNT(j)]); sum += c; cnt += (c > 0u) ? 1u : 0u; mine = (j == x) ? c : mine; }
        if (sum == G) break;
        __builtin_amdgcn_s_sleep(1);
        if ((++sp & 255u) == 0u) { if (xb_ld(&bar[XB_TMO])) break; if (sp > XB_SPIN_CAP) { atomicAdd(&bar[XB_TMO], 1u); break; } }
    }
    nloc = mine > 0u ? mine : 1u; nx = cnt > 0u ? cnt : 1u;
}
__device__ __forceinline__ void xcd_barrier(const XcdBarrier& b) {
    asm volatile("s_waitcnt vmcnt(0)" ::: "memory");
    __syncthreads();
    if (threadIdx.x == 0) {
        unsigned* bar = b.bar;
        __builtin_amdgcn_s_waitcnt(0);
        unsigned nloc = b.st[0], nx = b.st[1];
        if (nloc == 0u) { xcd_barrier_complete(bar, b.x, nloc, nx); b.st[0] = nloc; b.st[1] = nx; }
        const unsigned old = xb_add(&bar[XB_XSUB(b.x)], 1u);
        const unsigned gen = old / nloc;
        if (old + 1u == (gen + 1u) * nloc) {
            __builtin_amdgcn_fence(__ATOMIC_RELEASE, "agent");
            asm volatile("s_waitcnt vmcnt(0)" ::: "memory");
            const unsigned og = xb_add(&bar[XB_TOP], 1u);
            const unsigned tg = og / nx;
            if (og + 1u == (tg + 1u) * nx) xb_add(&bar[XB_TOPGEN], 1u);
            else XB_SPIN(xb_ld(&bar[XB_TOPGEN]) == tg, bar);
            __builtin_amdgcn_fence(__ATOMIC_ACQUIRE, "agent");
            xb_add(&bar[XB_XGEN(b.x)], 1u);
            asm volatile("s_waitcnt vmcnt(0)" ::: "memory");
        } else {
            XB_SPIN(xb_ld(&bar[XB_XGEN(b.x)]) == gen, bar);
            __builtin_amdgcn_fence(__ATOMIC_ACQUIRE, "agent");
            asm volatile("s_waitcnt vmcnt(0)" ::: "memory");
        }
    }
    __syncthreads();
}

#define LDS_WAIT() asm volatile("s_waitcnt lgkmcnt(0)" ::: "memory")
__device__ __forceinline__ unsigned f2bf(float f) { unsigned u = __builtin_bit_cast(unsigned, f); return (u + 0x7fffu + ((u >> 16) & 1u)) >> 16; }
__device__ __forceinline__ unsigned pk2(float lo, float hi) { return f2bf(lo) | (f2bf(hi) << 16); }
__device__ __forceinline__ float bf_lo(unsigned w) { return __uint_as_float(w << 16); }
__device__ __forceinline__ float bf_hi(unsigned w) { return __uint_as_float(w & 0xffff0000u); }
__device__ __forceinline__ float wave_sum(float v) {
#pragma unroll
    for (int o = 1; o < 64; o <<= 1) v += __shfl_xor(v, o);
    return v;
}
__device__ __forceinline__ float wave_max(float v) {
#pragma unroll
    for (int o = 1; o < 64; o <<= 1) v = fmaxf(v, __shfl_xor(v, o));
    return v;
}
__device__ __forceinline__ float rstd_row(const u64* rsq, int row) {
    const u64 v = rsq[row];
    return rsqrtf((float)v * (1.0f / (SSQ_SCALE * (float)D)) + EPS);
}
__device__ __forceinline__ float sigmoidf_(float x) { return 1.0f / (1.0f + __expf(-x)); }

struct EpiUp {
    static constexpr bool PERM = true, MID = false; static constexpr int MID_T0 = -1, MID_T1 = -1;
    bf16* act; const u64* rsq;
    __device__ __forceinline__ void mid(f32x4 (&)[2][2][4][2], const pg8::Unit&, int, int, int, int, int) const {}
    __device__ __forceinline__ void operator()(const f32x4 (&acc)[2][2][4][2], const pg8::Unit& u, int wr, int wc, int fr, int fq) const {
        const int row0 = u.pm * 256 + wr * 64 + fr, col0 = u.pn * 128 + wc * 32 + 8 * fq;
#pragma unroll
        for (int ai = 0; ai < 2; ++ai)
#pragma unroll
            for (int m = 0; m < 4; ++m) {
                const int row = row0 + ai * 128 + m * 16; const float rs = rstd_row(rsq, row);
                float o[8];
#pragma unroll
                for (int n = 0; n < 2; ++n)
#pragma unroll
                    for (int j = 0; j < 4; ++j) { const float gt = acc[ai][0][m][n][j] * rs, up = acc[ai][1][m][n][j] * rs; o[4 * n + j] = gt * sigmoidf_(gt) * up; }
                u32x4 w; w.x = pg8::cvt_pk_bf16(o[0], o[1]); w.y = pg8::cvt_pk_bf16(o[2], o[3]); w.z = pg8::cvt_pk_bf16(o[4], o[5]); w.w = pg8::cvt_pk_bf16(o[6], o[7]);
                *(u32x4*)(act + (size_t)row * FF + col0) = w;
            }
    }
};
template <int HALFSC> struct EpiRes {
    static constexpr bool PERM = true, MID = false; static constexpr int MID_T0 = -1, MID_T1 = -1;
    float* x; bf16* xb; u64* rsq_next;
    __device__ __forceinline__ void mid(f32x4 (&)[2][2][4][2], const pg8::Unit&, int, int, int, int, int) const {}
    __device__ __forceinline__ void operator()(const f32x4 (&acc)[2][2][4][2], const pg8::Unit& u, int wr, int wc, int fr, int fq) const {
        const float sc = HALFSC ? 0.5f : 1.0f;
        const int row0 = u.pm * 256 + wr * 64 + fr, col0 = u.pn * 256 + wc * 32 + 8 * fq;
#pragma unroll
        for (int ai = 0; ai < 2; ++ai)
#pragma unroll
            for (int m = 0; m < 4; ++m) {
                const int row = row0 + ai * 128 + m * 16; float ssq = 0.f;
#pragma unroll
                for (int bj = 0; bj < 2; ++bj) {
                    float* p = x + (size_t)row * D + col0 + bj * 128;
                    f32x4 a = *(const f32x4*)p, b = *(const f32x4*)(p + 4);
                    a = a + acc[ai][bj][m][0] * sc; b = b + acc[ai][bj][m][1] * sc;
                    *(f32x4*)p = a; *(f32x4*)(p + 4) = b;
                    ssq += (a[0] * a[0] + a[1] * a[1]) + (a[2] * a[2] + a[3] * a[3]) + (b[0] * b[0] + b[1] * b[1]) + (b[2] * b[2] + b[3] * b[3]);
                    u32x4 w; w.x = pg8::cvt_pk_bf16(a[0], a[1]); w.y = pg8::cvt_pk_bf16(a[2], a[3]); w.z = pg8::cvt_pk_bf16(b[0], b[1]); w.w = pg8::cvt_pk_bf16(b[2], b[3]);
                    *(u32x4*)(xb + (size_t)row * D + col0 + bj * 128) = w;
                }
                ssq += __shfl_xor(ssq, 16); ssq += __shfl_xor(ssq, 32);
                if (fq == 0) __hip_atomic_fetch_add(rsq_next + row, (u64)(ssq * SSQ_SCALE), __ATOMIC_RELAXED, __HIP_MEMORY_SCOPE_AGENT);
            }
    }
};
struct EpiIn {
    static constexpr bool PERM = true, MID = false; static constexpr int MID_T0 = -1, MID_T1 = -1;
    unsigned char* ws; const u64* rsq;
    __device__ __forceinline__ void mid(f32x4 (&)[2][2][4][2], const pg8::Unit&, int, int, int, int, int) const {}
    __device__ __forceinline__ void operator()(const f32x4 (&acc)[2][2][4][2], const pg8::Unit& u, int wr, int wc, int fr, int fq) const {
        const int c = u.pn; size_t off; int ldc, lc; bool gate = false;
        if (c < 6) { off = WS_QA; ldc = 1536; lc = c; } else if (c < 12) { off = WS_KA; ldc = 1536; lc = c - 6; } else if (c < 18) { off = WS_VA; ldc = 1536; lc = c - 12; }
        else if (c < 22) { off = WS_QB; ldc = 1024; lc = c - 18; } else if (c == 22) { off = WS_KB; ldc = 256; lc = 0; } else if (c == 23) { off = WS_VB; ldc = 256; lc = 0; }
        else if (c < 28) { off = WS_QC; ldc = 1024; lc = c - 24; } else if (c < 32) { off = WS_KC; ldc = 1024; lc = c - 28; } else if (c < 36) { off = WS_VC; ldc = 1024; lc = c - 32; }
        else { off = WS_G; ldc = 6144; lc = c - 36; gate = true; }
        bf16* dst = (bf16*)(ws + off);
        const int row0 = u.pm * 256 + wr * 64 + fr, col0 = lc * 256 + wc * 32 + 8 * fq;
#pragma unroll
        for (int ai = 0; ai < 2; ++ai)
#pragma unroll
            for (int m = 0; m < 4; ++m) {
                const int row = row0 + ai * 128 + m * 16; const float rs = rstd_row(rsq, row);
#pragma unroll
                for (int bj = 0; bj < 2; ++bj) {
                    f32x4 a = acc[ai][bj][m][0] * rs, b = acc[ai][bj][m][1] * rs;
                    if (gate) {
#pragma unroll
                        for (int j = 0; j < 4; ++j) { a[j] = fmaxf(sigmoidf_(a[j]), 1e-30f); b[j] = fmaxf(sigmoidf_(b[j]), 1e-30f); }
                    }
                    u32x4 w; w.x = pg8::cvt_pk_bf16(a[0], a[1]); w.y = pg8::cvt_pk_bf16(a[2], a[3]); w.z = pg8::cvt_pk_bf16(b[0], b[1]); w.w = pg8::cvt_pk_bf16(b[2], b[3]);
                    *(u32x4*)(dst + (size_t)row * ldc + col0 + bj * 128) = w;
                }
            }
    }
};
struct EpiBr {
    static constexpr bool PERM = true, MID = true; static constexpr int MID_T0 = 8, MID_T1 = 24;
    const bf16* G; bf16* z;
    __device__ __forceinline__ void mid(f32x4 (&acc)[2][2][4][2], const pg8::Unit& u, int t, int wr, int wc, int fr, int fq) const {
        const bf16* ga = G + (t == MID_T0 ? 0 : 2048);
        int frx = fr, fqx = fq; asm volatile("" : "+v"(frx), "+v"(fqx));
        const int row0 = u.pm * 256 + wr * 64 + frx, col0 = u.pn * 256 + wc * 32 + 8 * fqx;
#pragma unroll
        for (int ai = 0; ai < 2; ++ai)
#pragma unroll
            for (int m = 0; m < 4; ++m) {
                const int row = row0 + ai * 128 + m * 16;
#pragma unroll
                for (int bj = 0; bj < 2; ++bj) {
                    const bf16* p = ga + (size_t)row * 6144 + col0 + bj * 128;
                    const u32x4 na = *(const u32x4*)p, nb = *(const u32x4*)(p + 2048);
#pragma unroll
                    for (int j = 0; j < 2; ++j) {
                        acc[ai][bj][m][0][2 * j]     *= bf_lo(na[j]) / bf_lo(nb[j]);
                        acc[ai][bj][m][0][2 * j + 1] *= bf_hi(na[j]) / bf_hi(nb[j]);
                        acc[ai][bj][m][1][2 * j]     *= bf_lo(na[2 + j]) / bf_lo(nb[2 + j]);
                        acc[ai][bj][m][1][2 * j + 1] *= bf_hi(na[2 + j]) / bf_hi(nb[2 + j]);
                    }
                    asm volatile("" : "+v"(acc[ai][bj][m][0]), "+v"(acc[ai][bj][m][1]) :: "memory");
                }
            }
    }
    __device__ __forceinline__ void operator()(const f32x4 (&acc)[2][2][4][2], const pg8::Unit& u, int wr, int wc, int fr, int fq) const {
        const int row0 = u.pm * 256 + wr * 64 + fr, col0 = u.pn * 256 + wc * 32 + 8 * fq;
#pragma unroll
        for (int ai = 0; ai < 2; ++ai)
#pragma unroll
            for (int m = 0; m < 4; ++m) {
                const int row = row0 + ai * 128 + m * 16;
#pragma unroll
                for (int bj = 0; bj < 2; ++bj) {
                    const u32x4 ng = *(const u32x4*)(G + (size_t)row * 6144 + 4096 + col0 + bj * 128);
                    const f32x4 a = acc[ai][bj][m][0], b = acc[ai][bj][m][1];
                    u32x4 w; w.x = pg8::cvt_pk_bf16(a[0] * bf_lo(ng[0]), a[1] * bf_hi(ng[0])); w.y = pg8::cvt_pk_bf16(a[2] * bf_lo(ng[1]), a[3] * bf_hi(ng[1]));
                    w.z = pg8::cvt_pk_bf16(b[0] * bf_lo(ng[2]), b[1] * bf_hi(ng[2])); w.w = pg8::cvt_pk_bf16(b[2] * bf_lo(ng[3]), b[3] * bf_hi(ng[3]));
                    *(u32x4*)(z + (size_t)row * D + col0 + bj * 128) = w;
                }
            }
    }
};

__device__ __forceinline__ void cvt_item(const float* __restrict__ W, int N, const float* __restrict__ scale, bf16* dst, int dpitch, int dcol, int mode, int kb, int nb, LAS unsigned* T, int lane) {
    const int k0 = kb * 64, n0 = nb * 64, kpl = lane >> 4, n4 = (lane & 15) * 4;
    f32x4 r0[8], r1[8];
#pragma unroll
    for (int i = 0; i < 8; ++i) { const int k = k0 + 2 * (4 * i + kpl); r0[i] = *(const f32x4*)(W + (size_t)k * N + n0 + n4); r1[i] = *(const f32x4*)(W + (size_t)(k + 1) * N + n0 + n4); }
#pragma unroll
    for (int i = 0; i < 8; ++i) { const int kp = 4 * i + kpl, k = k0 + 2 * kp; const float s0 = scale ? scale[k] : 1.f, s1 = scale ? scale[k + 1] : 1.f;
#pragma unroll
        for (int j = 0; j < 4; ++j) T[(n4 + j) * 33 + kp] = pk2(r0[i][j] * s0, r1[i][j] * s1); }
    LDS_WAIT(); asm volatile("" ::: "memory");
    const int q = lane & 7;
#pragma unroll
    for (int i = 0; i < 8; ++i) { const int n = 8 * i + (lane >> 3); const LAS unsigned* s = T + n * 33 + 4 * q;
        u32x4 o; o.x = s[0]; o.y = s[1]; o.z = s[2]; o.w = s[3];
        const int c = n0 + n; int drow = c;
        if (mode == 1) { drow = (c < FF) ? (256 * (c >> 7) + (c & 127)) : (256 * ((c - FF) >> 7) + 128 + ((c - FF) & 127)); }
        *(u32x4*)(dst + (size_t)drow * dpitch + dcol + k0 + 8 * q) = o; }
    LDS_WAIT(); asm volatile("" ::: "memory");
}

struct Args { const float* in[18]; float* out; unsigned char* ws; int ph_lo, ph_hi; };
typedef const __attribute__((address_space(4))) Args* KArgs;

__device__ __forceinline__ void prologue(KArgs a, LAS unsigned char* lds, int gw, int NGW, int wave, int lane) {
    LAS unsigned* T = (LAS unsigned*)(lds + wave * 16384);
    constexpr int I0 = 32 * 176, I1 = 88 * 32, I2 = 32 * 240, I3 = 8 * 32, I4 = 16 * 32, I5 = 16 * 32, I6 = 32 * 32, PER = 2 * I0 + 2 * I1 + I2 + I3 + I4 + I5 + I6;
    for (int it = gw; it < DEPTH * PER; it += NGW) {
        const int l = it / PER; int r = it % PER; unsigned char* wl = a->ws + WS_W + (size_t)l * W_LAYER;
        if (r < I0) { cvt_item(a->in[4] + (size_t)l * D * 2 * FF, 2 * FF, a->in[3] + l * D, (bf16*)(wl + W_1A), D, 0, 1, r / 176, r % 176, T, lane); continue; } r -= I0;
        if (r < I1) { cvt_item(a->in[5] + (size_t)l * FF * D, D, nullptr, (bf16*)(wl + W_1B), FF, 0, 0, r / 32, r % 32, T, lane); continue; } r -= I1;
        if (r < I2) { cvt_item(a->in[7] + (size_t)l * D * NIN, NIN, a->in[6] + l * D, (bf16*)(wl + W_IN), D, 0, 0, r / 240, r % 240, T, lane); continue; } r -= I2;
        if (r < I3) { cvt_item(a->in[11] + (size_t)l * 512 * D, D, nullptr, (bf16*)(wl + W_BR), KBR, 0, 0, r / 32, r % 32, T, lane); continue; } r -= I3;
        if (r < I4) { cvt_item(a->in[12] + (size_t)l * 1024 * D, D, nullptr, (bf16*)(wl + W_BR), KBR, 512, 0, r / 32, r % 32, T, lane); continue; } r -= I4;
        if (r < I5) { cvt_item(a->in[13] + (size_t)l * 1024 * D, D, nullptr, (bf16*)(wl + W_BR), KBR, 1536, 0, r / 32, r % 32, T, lane); continue; } r -= I5;
        if (r < I6) { cvt_item(a->in[14] + (size_t)l * D * D, D, nullptr, (bf16*)(wl + W_O), D, 0, 0, r / 32, r % 32, T, lane); continue; } r -= I6;
        if (r < I0) { cvt_item(a->in[16] + (size_t)l * D * 2 * FF, 2 * FF, a->in[15] + l * D, (bf16*)(wl + W_2A), D, 0, 1, r / 176, r % 176, T, lane); continue; } r -= I0;
        cvt_item(a->in[17] + (size_t)l * FF * D, D, nullptr, (bf16*)(wl + W_2B), FF, 0, 0, r / 32, r % 32, T, lane);
    }
    u64* rsq0 = (u64*)(a->ws + WS_RSQ); bf16* xb = (bf16*)(a->ws + WS_XB);
    for (int row = gw; row < M; row += NGW) {
        const float* src = row < 8192 ? a->in[0] + (size_t)row * D : a->in[1] + (size_t)(row - 8192) * D;
        f32x4 v[8]; float s = 0.f;
#pragma unroll
        for (int j = 0; j < 8; ++j) { v[j] = *(const f32x4*)(src + 256 * j + 4 * lane); s += (v[j][0] * v[j][0] + v[j][1] * v[j][1]) + (v[j][2] * v[j][2] + v[j][3] * v[j][3]); }
#pragma unroll
        for (int j = 0; j < 8; ++j) { *(f32x4*)(a->out + (size_t)row * D + 256 * j + 4 * lane) = v[j];
            u32x2 w; w.x = pk2(v[j][0], v[j][1]); w.y = pk2(v[j][2], v[j][3]); *(u32x2*)(xb + (size_t)row * D + 256 * j + 4 * lane) = w; }
        s = wave_sum(s);
        if (lane == 0) rsq0[row] = (u64)(s * SSQ_SCALE);
    }
}

__device__ __forceinline__ int t5_bucket_dev(int rel) {
    const int n = rel < 0 ? -rel : rel; int b;
    if (n < 8) b = n; else { int lg = 8 + (int)(log((double)n / 8.0) / log(1024.0 / 8.0) * 8.0); b = lg < 15 ? lg : 15; }
    return b + (rel > 0 ? 16 : 0);
}
__device__ __forceinline__ void seq_of(int row, int& base, int& L) { if (row < 8192) { base = 0; L = 8192; } else if (row < 12288) { base = 8192; L = 4096; } else { base = 12288; L = 4096; } }

__device__ __forceinline__ void qknorm_phase(unsigned char* ws, const float* qk_norm, int l, int gw, int NGW, int lane) {
    const float* qkg = qk_norm + (size_t)l * 6 * 128;
    for (int it = gw; it < M * 50; it += NGW) {
        const int row = it / 50, s = it % 50; size_t off; int ldc, h, gi;
        if (s < 12) { off = WS_QA; ldc = 1536; h = s; gi = 0; } else if (s < 24) { off = WS_KA; ldc = 1536; h = s - 12; gi = 1; }
        else if (s < 32) { off = WS_QB; ldc = 1024; h = s - 24; gi = 2; } else if (s < 34) { off = WS_KB; ldc = 256; h = s - 32; gi = 3; }
        else if (s < 42) { off = WS_QC; ldc = 1024; h = s - 34; gi = 4; } else { off = WS_KC; ldc = 1024; h = s - 42; gi = 5; }
        unsigned* p = (unsigned*)((bf16*)(ws + off) + (size_t)row * ldc + h * 128) + lane;
        const unsigned w = *p; const float v0 = bf_lo(w), v1 = bf_hi(w);
        const float ss = wave_sum(v0 * v0 + v1 * v1);
        const float r = rsqrtf(ss * (1.0f / 128.0f) + EPS);
        *p = pk2(v0 * r * qkg[gi * 128 + 2 * lane], v1 * r * qkg[gi * 128 + 2 * lane + 1]);
    }
}

__device__ __forceinline__ void attn_naive_phase(unsigned char* ws, const float* relb, const float* sink_all, const float* rpb_all, int l, LAS unsigned char* lds, int gw, int NGW, int wave, int lane) {
    LAS unsigned char* tab = lds + 8192;
    for (int n = threadIdx.x; n <= 1024; n += NWAVES * 64) tab[n] = (unsigned char)t5_bucket_dev(-n);
    __syncthreads();
    LAS float* pl = (LAS float*)(lds + wave * 16384); LAS int* tl = (LAS int*)(lds + wave * 16384 + 2048);
    const float* sink = sink_all + l * 8; const float* rpb = rpb_all + (size_t)l * 8 * 15 * 31;
    for (int it = gw; it < 28 * M; it += NGW) {
        const int h28 = it / M, row = it % M; int base, L; seq_of(row, base, L); const int t = row - base;
        const bf16 *Q, *Kp, *Vp; int ldq, ldk, qoff, koff, nslots, type, g = 0, hh = 0, d = 1;
        if (h28 < 12) { type = 0; g = h28 >> 2; hh = h28 & 3; d = (g == 0) ? 1 : (g == 1 ? 4 : 16); Q = (const bf16*)(ws + WS_QA); Kp = (const bf16*)(ws + WS_KA); Vp = (const bf16*)(ws + WS_VA); ldq = 1536; ldk = 1536; qoff = h28 * 128; koff = h28 * 128; nslots = 129; }
        else if (h28 < 20) { type = 1; hh = h28 - 12; Q = (const bf16*)(ws + WS_QB); Kp = (const bf16*)(ws + WS_KB); Vp = (const bf16*)(ws + WS_VB); ldq = 1024; ldk = 256; qoff = hh * 128; koff = (hh >> 2) * 128; nslots = 257; }
        else { type = 2; hh = h28 - 20; Q = (const bf16*)(ws + WS_QC); Kp = (const bf16*)(ws + WS_KC); Vp = (const bf16*)(ws + WS_VC); ldq = 1024; ldk = 1024; qoff = hh * 128; koff = hh * 128; nslots = 128; }
        const int rows = L >> 6, r = t >> 6, c = t & 63; int rs = r - 4; rs = rs < 0 ? 0 : (rs > rows - 8 ? rows - 8 : rs); int qs = c - 8; qs = qs < 0 ? 0 : (qs > 48 ? 48 : qs);
        const bf16* qp = Q + (size_t)row * ldq + qoff;
        float mx = -1e30f;
#pragma unroll 1
        for (int j = lane; j < nslots; j += 64) {
            bool valid = true; int tk = t; float bias = 0.f;
            if (type == 0) { const int rel = (j - 64) * d; tk = t + rel; valid = tk >= 0 && tk < L; const int n = rel < 0 ? -rel : rel; bias = relb[((int)tab[n] + (rel > 0 ? 16 : 0)) * 20 + h28]; }
            else if (type == 1) { const int rel = j - 128; tk = t + rel; valid = tk >= 0 && tk < L; const int n = rel < 0 ? -rel : rel; bias = relb[((int)tab[n] + (rel > 0 ? 16 : 0)) * 20 + 12 + hh]; }
            else { const int kr = rs + (j >> 4), kc = qs + (j & 15); tk = kr * 64 + kc; bias = rpb[(hh * 15 + (kr - r + 7)) * 31 + (kc - c + 15)]; }
            if (!valid) tk = t;
            float dot = 0.f; const bf16* kp = Kp + (size_t)(base + tk) * ldk + koff;
#pragma unroll 4
            for (int ch = 0; ch < 16; ++ch) { const u32x4 kv = *(const u32x4*)(kp + 8 * ch); const u32x4 qv = *(const u32x4*)(qp + 8 * ch);
#pragma unroll
                for (int e = 0; e < 4; ++e) dot += bf_lo(qv[e]) * bf_lo(kv[e]) + bf_hi(qv[e]) * bf_hi(kv[e]); }
            const float sc = valid ? dot * 0.08838834764831845f + bias : -1e30f;
            mx = fmaxf(mx, sc);
            pl[j] = sc; tl[j] = tk;
        }
        mx = wave_max(mx);
        if (type == 1) mx = fmaxf(mx, sink[hh]);
        float den = 0.f;
#pragma unroll 1
        for (int j = lane; j < nslots; j += 64) { const float sc = pl[j]; const float p = (sc > -1e29f) ? __expf(sc - mx) : 0.f; den += p; pl[j] = p; }
        den = wave_sum(den);
        if (type == 1) den += __expf(sink[hh] - mx);
        LDS_WAIT(); asm volatile("" ::: "memory");
        float o0 = 0.f, o1 = 0.f;
#pragma unroll 4
        for (int j = 0; j < nslots; ++j) { const float p = pl[j]; const int tk = tl[j];
            const unsigned w = *(const unsigned*)(Vp + (size_t)(base + tk) * ldk + koff + 2 * lane); o0 += p * bf_lo(w); o1 += p * bf_hi(w); }
        const float inv = 1.0f / den; o0 *= inv; o1 *= inv;
        if (type == 0) { *(unsigned*)((bf16*)(ws + WS_OAG) + ((size_t)g * M + row) * 512 + hh * 128 + 2 * lane) = pk2(o0, o1);
            if (lane == 0) ((float*)(ws + WS_LSE))[((size_t)g * M + row) * 4 + hh] = mx + __logf(den); }
        else { *(unsigned*)((bf16*)(ws + WS_O) + (size_t)row * KBR + (type == 1 ? 512 : 1536) + hh * 128 + 2 * lane) = pk2(o0, o1); }
        LDS_WAIT(); asm volatile("" ::: "memory");
    }
}
__device__ __forceinline__ void combine_phase(unsigned char* ws, int gw, int NGW, int lane) {
    const float* lse = (const float*)(ws + WS_LSE); const bf16* oag = (const bf16*)(ws + WS_OAG); bf16* O = (bf16*)(ws + WS_O);
    for (int it = gw; it < M * 4; it += NGW) {
        const int row = it >> 2, hh = it & 3;
        const float l0 = lse[((size_t)0 * M + row) * 4 + hh], l1 = lse[((size_t)1 * M + row) * 4 + hh], l2 = lse[((size_t)2 * M + row) * 4 + hh];
        const float mx = fmaxf(l0, fmaxf(l1, l2)); float w0 = __expf(l0 - mx), w1 = __expf(l1 - mx), w2 = __expf(l2 - mx); const float inv = 1.0f / (w0 + w1 + w2); w0 *= inv; w1 *= inv; w2 *= inv;
        const unsigned a0 = *(const unsigned*)(oag + ((size_t)0 * M + row) * 512 + hh * 128 + 2 * lane), a1 = *(const unsigned*)(oag + ((size_t)1 * M + row) * 512 + hh * 128 + 2 * lane), a2 = *(const unsigned*)(oag + ((size_t)2 * M + row) * 512 + hh * 128 + 2 * lane);
        *(unsigned*)(O + (size_t)row * KBR + hh * 128 + 2 * lane) = pk2(w0 * bf_lo(a0) + w1 * bf_lo(a1) + w2 * bf_lo(a2), w0 * bf_hi(a0) + w1 * bf_hi(a1) + w2 * bf_hi(a2));
    }
}

constexpr int NP = 10;
enum { PH_UP1 = 0, PH_DN1, PH_IN, PH_QKN, PH_ATT, PH_CMB, PH_BR, PH_OUT, PH_UP2, PH_DN2 };
constexpr int NPH = 1 + DEPTH * NP;

__device__ __forceinline__ KArgs kargs() { u64 p = (u64)__builtin_amdgcn_kernarg_segment_ptr(); asm volatile("" : "+s"(p)); return (KArgs)p; }
__device__ __forceinline__ int otid() { int t = threadIdx.x; asm volatile("" : "+v"(t)); return t; }
__device__ __forceinline__ int vcu_of() { const int G = gridDim.x, bx = blockIdx.x; return (G % 8 == 0) ? (bx % 8) * (G / 8) + bx / 8 : bx; }

__global__ void __launch_bounds__(NWAVES * 64, 2) fwd(Args args) {
    extern __shared__ __attribute__((aligned(16))) unsigned char lds_raw[];
    LAS unsigned char* lds = (LAS unsigned char*)lds_raw;
    { const int tid = otid(); for (int u = tid; u < (LDS_BYTES - RING_BYTES) / 4; u += NWAVES * 64) ((LAS unsigned*)(lds + RING_BYTES))[u] = 0u; }
    __syncthreads();
    if (ONE_LAUNCH) (void)xcd_barrier_post((unsigned*)(kargs()->ws + WS_CTL) + CW_BAR, (volatile LAS unsigned*)(lds + MISC_OFF) + 8);
    const int lo = args.ph_lo, hi = args.ph_hi;
#define IN(k) (lo <= (k) && (k) < hi)
#define SEAM(k) do { if (ONE_LAUNCH && IN(k) && IN((k) + 1)) { XcdBarrier b_; b_.bar = (unsigned*)(kargs()->ws + WS_CTL) + CW_BAR; b_.x = xb_xcc_id(); b_.st = (volatile LAS unsigned*)(lds + MISC_OFF) + 8; xcd_barrier(b_); } } while (0)
#define TIDS() const int tid = otid(), lane = tid & 63, wave = __builtin_amdgcn_readfirstlane(tid >> 6); const int gw = vcu_of() * NWAVES + wave, NGW = (int)gridDim.x * NWAVES; (void)lane; (void)gw; (void)NGW

    if (IN(0)) { KArgs ka = kargs(); TIDS(); prologue(ka, lds, gw, NGW, wave, lane); __syncthreads(); }
    SEAM(0);
    for (int l = 0; l < DEPTH; ++l) {
        const int g0 = 1 + l * NP;
        if (IN(g0 + PH_UP1)) {
            KArgs ka = kargs(); unsigned char* ws = ka->ws; unsigned char* wl = ws + WS_W + (size_t)l * W_LAYER;
            pg8::Gemm g{(const bf16*)(ws + WS_XB), (const bf16*)(wl + W_1A), M, 2 * FF, D}; pg8::StaticOrder S; S.init(M, 2 * FF, (int)gridDim.x, (int)blockIdx.x);
            EpiUp E{(bf16*)(ws + WS_ACT), (const u64*)(ws + WS_RSQ) + (size_t)(3 * l + 0) * M};
            pg8::gemm_phase<EpiUp, pg8::StaticOrder, true, true>(lds, g, S, E);
        }
        SEAM(g0 + PH_UP1);
        if (IN(g0 + PH_DN1)) {
            KArgs ka = kargs(); unsigned char* ws = ka->ws; unsigned char* wl = ws + WS_W + (size_t)l * W_LAYER;
            pg8::Gemm g{(const bf16*)(ws + WS_ACT), (const bf16*)(wl + W_1B), M, D, FF}; pg8::StaticOrder S; S.init(M, D, (int)gridDim.x, (int)blockIdx.x);
            EpiRes<1> E{ka->out, (bf16*)(ws + WS_XB), (u64*)(ws + WS_RSQ) + (size_t)(3 * l + 1) * M};
            pg8::gemm_phase<EpiRes<1>, pg8::StaticOrder, true, true>(lds, g, S, E);
        }
        SEAM(g0 + PH_DN1);
        if (IN(g0 + PH_IN)) {
            KArgs ka = kargs(); unsigned char* ws = ka->ws; unsigned char* wl = ws + WS_W + (size_t)l * W_LAYER;
            pg8::Gemm g{(const bf16*)(ws + WS_XB), (const bf16*)(wl + W_IN), M, NIN, D}; pg8::StaticOrder S; S.init(M, NIN, (int)gridDim.x, (int)blockIdx.x);
            EpiIn E{ws, (const u64*)(ws + WS_RSQ) + (size_t)(3 * l + 1) * M};
            pg8::gemm_phase<EpiIn, pg8::StaticOrder, true, true>(lds, g, S, E);
        }
        SEAM(g0 + PH_IN);
        if (IN(g0 + PH_QKN)) { KArgs ka = kargs(); TIDS(); qknorm_phase(ka->ws, ka->in[8], l, gw, NGW, lane); }
        SEAM(g0 + PH_QKN);
        if (IN(g0 + PH_ATT)) { KArgs ka = kargs(); TIDS(); attn_naive_phase(ka->ws, ka->in[2], ka->in[9], ka->in[10], l, lds, gw, NGW, wave, lane); __syncthreads(); }
        SEAM(g0 + PH_ATT);
        if (IN(g0 + PH_CMB)) { KArgs ka = kargs(); TIDS(); combine_phase(ka->ws, gw, NGW, lane); }
        SEAM(g0 + PH_CMB);
        if (IN(g0 + PH_BR)) {
            KArgs ka = kargs(); unsigned char* ws = ka->ws; unsigned char* wl = ws + WS_W + (size_t)l * W_LAYER;
            pg8::Gemm g{(const bf16*)(ws + WS_O), (const bf16*)(wl + W_BR), M, D, KBR}; pg8::StaticOrder S; S.init(M, D, (int)gridDim.x, (int)blockIdx.x);
            EpiBr E{(const bf16*)(ws + WS_G), (bf16*)(ws + WS_Z)};
            pg8::gemm_phase<EpiBr, pg8::StaticOrder, true, true>(lds, g, S, E);
        }
        SEAM(g0 + PH_BR);
        if (IN(g0 + PH_OUT)) {
            KArgs ka = kargs(); unsigned char* ws = ka->ws; unsigned char* wl = ws + WS_W + (size_t)l * W_LAYER;
            pg8::Gemm g{(const bf16*)(ws + WS_Z), (const bf16*)(wl + W_O), M, D, D}; pg8::StaticOrder S; S.init(M, D, (int)gridDim.x, (int)blockIdx.x);
            EpiRes<0> E{ka->out, (bf16*)(ws + WS_XB), (u64*)(ws + WS_RSQ) + (size_t)(3 * l + 2) * M};
            pg8::gemm_phase<EpiRes<0>, pg8::StaticOrder, true, true>(lds, g, S, E);
        }
        SEAM(g0 + PH_OUT);
        if (IN(g0 + PH_UP2)) {
            KArgs ka = kargs(); unsigned char* ws = ka->ws; unsigned char* wl = ws + WS_W + (size_t)l * W_LAYER;
            pg8::Gemm g{(const bf16*)(ws + WS_XB), (const bf16*)(wl + W_2A), M, 2 * FF, D}; pg8::StaticOrder S; S.init(M, 2 * FF, (int)gridDim.x, (int)blockIdx.x);
            EpiUp E{(bf16*)(ws + WS_ACT), (const u64*)(ws + WS_RSQ) + (size_t)(3 * l + 2) * M};
            pg8::gemm_phase<EpiUp, pg8::StaticOrder, true, true>(lds, g, S, E);
        }
        SEAM(g0 + PH_UP2);
        if (IN(g0 + PH_DN2)) {
            KArgs ka = kargs(); unsigned char* ws = ka->ws; unsigned char* wl = ws + WS_W + (size_t)l * W_LAYER;
            pg8::Gemm g{(const bf16*)(ws + WS_ACT), (const bf16*)(wl + W_2B), M, D, FF}; pg8::StaticOrder S; S.init(M, D, (int)gridDim.x, (int)blockIdx.x);
            EpiRes<1> E{ka->out, (bf16*)(ws + WS_XB), (u64*)(ws + WS_RSQ) + (size_t)(3 * l + 3) * M};
            pg8::gemm_phase<EpiRes<1>, pg8::StaticOrder, true, true>(lds, g, S, E);
        }
        SEAM(g0 + PH_DN2);
    }
#undef IN
#undef SEAM
#undef TIDS
}

extern "C" void kernel_launch(void* const* d_in, const int* in_sizes, int n_in, void* d_out, int out_size, void* d_ws, size_t ws_size, hipStream_t stream) {
    static int grid = 0;
    if (grid == 0) {
        if (n_in != 18 || out_size != M * D || ws_size < WS_END) { fprintf(stderr, "kernel_launch: unexpected problem (n_in %d, out %d, ws %zu, need %zu); nothing launched\n", n_in, out_size, ws_size, (size_t)WS_END); grid = -1; return; }
        int dev = 0, cus = 0, per_cu = 0;
        if (hipGetDevice(&dev) != hipSuccess || hipDeviceGetAttribute(&cus, hipDeviceAttributeMultiprocessorCount, dev) != hipSuccess) { grid = -1; return; }
        if (hipFuncSetAttribute((const void*)fwd, hipFuncAttributeMaxDynamicSharedMemorySize, LDS_BYTES) != hipSuccess) { fprintf(stderr, "kernel_launch: hipFuncSetAttribute failed\n"); grid = -1; return; }
        if (hipOccupancyMaxActiveBlocksPerMultiprocessor(&per_cu, (const void*)fwd, NWAVES * 64, LDS_BYTES) != hipSuccess || per_cu < 1) { fprintf(stderr, "kernel_launch: occupancy query says %d\n", per_cu); }
        (void)hipGetLastError();
        grid = cus;
    }
    if (grid < 0) return;
    (void)hipMemsetAsync((char*)d_ws + WS_CTL, 0, CTL_ZERO_BYTES, stream);
    Args a{};
    for (int i = 0; i < 18; ++i) a.in[i] = (const float*)d_in[i];
    a.out = (float*)d_out; a.ws = (unsigned char*)d_ws;
    if (ONE_LAUNCH) { a.ph_lo = 0; a.ph_hi = NPH; hipLaunchKernelGGL(fwd, dim3(grid), dim3(NWAVES * 64), LDS_BYTES, stream, a); }
    else for (int p = 0; p < NPH; ++p) { a.ph_lo = p; a.ph_hi = p + 1; hipLaunchKernelGGL(fwd, dim3(grid), dim3(NWAVES * 64), LDS_BYTES, stream, a); }
}
```

```cpp
#include <hip/hip_runtime.h>
#include <cstdio>
#include <cstdint>

#ifndef ONE_LAUNCH
#define ONE_LAUNCH 1
#endif

typedef unsigned long long u64;
namespace pg8 {
#define PG8_LAS __attribute__((address_space(3)))
typedef unsigned short bf16_t;
typedef short bf16x8 __attribute__((ext_vector_type(8)));
typedef float f32x4 __attribute__((ext_vector_type(4)));
typedef unsigned u32x4 __attribute__((ext_vector_type(4)));
typedef unsigned u32x2 __attribute__((ext_vector_type(2)));
constexpr int BM = 256, BK = 64, HALF = 128, HTB = HALF * BK * 2, STAGE_BYTES = 8 * HTB, NXCD = 8, WGM = 8;

__host__ __device__ __forceinline__ int lds_byte(int r, int c) { const int st = (r >> 4) * 2 + (c >> 5), rr = r & 15, cc = c & 31, ob = rr * 64 + cc * 2; return st * 1024 + (ob ^ (((ob >> 9) & 1) << 5)); }
__host__ __device__ __forceinline__ void stage_rc(int b, int& R, int& C) { const int st = b / 1024, sb = b % 1024, swz = sb ^ (((sb >> 9) & 1) << 5); R = (st >> 1) * 16 + swz / 64; C = (st & 1) * 32 + (swz % 64) / 2; }
__host__ __device__ __forceinline__ int perm32(int rho) { const int n = rho >> 4, i = rho & 15; return 8 * (i >> 2) + 4 * n + (i & 3); }

struct Unit { int pm, pn; };
struct Gemm { const bf16_t* A; const bf16_t* Bt; int M, N, K; };

struct StaticOrder {
    int nM, nN, nwg, G, c;
    __host__ __device__ void init(int M, int N, int G_, int c_) { nM = M / BM; nN = N / BM; nwg = nM * nN; G = G_; c = c_; }
    __host__ __device__ bool next(int i, Unit& u) const {
        const long L = (long)i * G + c; if (L >= nwg) return false;
        int wgid = (int)L; { const int q = nwg / NXCD, r = nwg % NXCD, xcd = wgid % NXCD, off = wgid / NXCD; wgid = (xcd < r ? xcd * (q + 1) : r * (q + 1) + (xcd - r) * q) + off; }
        const int nig = WGM * nN, gid = wgid / nig, fm = gid * WGM, gsz = (nM - fm) < WGM ? (nM - fm) : WGM;
        u.pm = fm + ((wgid % nig) % gsz); u.pn = (wgid % nig) / gsz; return true;
    }
    __device__ __forceinline__ void a_ready(const Unit&) const {}
    __device__ __forceinline__ void done(const Unit&) const {}
};

__device__ __forceinline__ unsigned cvt_pk_bf16(float lo, float hi) { unsigned r; asm volatile("v_cvt_pk_bf16_f32 %0, %1, %2" : "=v"(r) : "v"(lo), "v"(hi)); return r; }
__device__ __forceinline__ float bf_lo(unsigned w) { return __uint_as_float(w << 16); }
__device__ __forceinline__ float bf_hi(unsigned w) { return __uint_as_float(w & 0xffff0000u); }

template <class Epi, class Sched, bool ALIGN_EPI = false, bool SP2 = false>
__device__ __forceinline__ void gemm_phase(PG8_LAS unsigned char* lds, const Gemm g, const Sched& S, const Epi& E) {
    int tid_ = threadIdx.x; asm volatile("" : "+v"(tid_));
    const int tid = tid_, wid = __builtin_amdgcn_readfirstlane(tid >> 6), lane = tid & 63, wr = wid >> 2, wc = wid & 3, fr = lane & 15, fq = lane >> 4;
    const int K = g.K, nt = K / BK;
    unsigned voffA[2], voffB[2];
#pragma unroll
    for (int i = 0; i < 2; ++i) { int R, C; stage_rc(tid * 16 + i * 8192, R, C); const int Rb = Epi::PERM ? ((R & ~31) + perm32(R & 31)) : R;
        voffA[i] = (unsigned)(R * K + C) * 2u; voffB[i] = (unsigned)(Rb * K + C) * 2u; }
    const size_t kstep = (size_t)(BK * 2);
    const size_t hstep = (size_t)HALF * K * 2;
    const size_t tstep = 2 * hstep;
    const unsigned ldsw = (unsigned)wid * 1024u;
    const int aoff = lds_byte(wr * 64 + fr, fq * 8), boff = lds_byte(wc * 32 + fr, fq * 8);
#define PG8_SA(b, h) (((b) * 2 + (h)) * HTB)
#define PG8_SB(b, h) ((4 + (b) * 2 + (h)) * HTB)
#define PG8_STAGE(bufoff, gbase, voff) do { _Pragma("unroll") for (int _i = 0; _i < 2; ++_i) \
        __builtin_amdgcn_global_load_lds((const unsigned*)((const char*)(gbase) + (voff)[_i]), (PG8_LAS unsigned*)(lds + (bufoff) + ldsw + _i * 8192), 16, 0, 0); } while (0)
#define PG8_LDA(dst, b, h) do { _Pragma("unroll") for (int m = 0; m < 4; ++m) _Pragma("unroll") for (int k = 0; k < 2; ++k) dst[m][k] = *(const PG8_LAS bf16x8*)(lds + PG8_SA(b, h) + aoff + m * 2048 + k * 1024); } while (0)
#define PG8_LDB(dst, b, h) do { _Pragma("unroll") for (int n = 0; n < 2; ++n) _Pragma("unroll") for (int k = 0; k < 2; ++k) dst[n][k] = *(const PG8_LAS bf16x8*)(lds + PG8_SB(b, h) + boff + n * 2048 + k * 1024); } while (0)
#define PG8_MMA(ai, bj, At, Bt) do { __builtin_amdgcn_s_setprio(1); _Pragma("unroll") for (int m = 0; m < 4; ++m) _Pragma("unroll") for (int n = 0; n < 2; ++n) _Pragma("unroll") for (int k = 0; k < 2; ++k) \
        acc[ai][bj][m][n] = __builtin_amdgcn_mfma_f32_16x16x32_bf16(Bt[n][k], At[m][k], acc[ai][bj][m][n], 0, 0, 0); __builtin_amdgcn_s_setprio(0); } while (0)
#define PG8_WAIT_V(n) asm volatile("s_waitcnt vmcnt(" #n ")" ::: "memory")
#define PG8_WAIT_L(n) asm volatile("s_waitcnt lgkmcnt(" #n ")" ::: "memory")
#define PG8_BAR __builtin_amdgcn_s_barrier()
#define PG8_SCHED __builtin_amdgcn_sched_barrier(0)
    Unit cur, nxt; int ui = 0;
    if (!S.next(0, cur)) return;
    f32x4 acc[2][2][4][2];
#pragma unroll
    for (int a = 0; a < 2; ++a)
#pragma unroll
        for (int b = 0; b < 2; ++b)
#pragma unroll
            for (int m = 0; m < 4; ++m)
#pragma unroll
                for (int n = 0; n < 2; ++n) acc[a][b][m][n] = (f32x4){0.f, 0.f, 0.f, 0.f};
    bf16x8 At[4][2], B0[2][2], B1[2][2];
    const char* cA = (const char*)g.A + (size_t)cur.pm * tstep; const char* cB = (const char*)g.Bt + (size_t)cur.pn * tstep;
    S.a_ready(cur);
    if constexpr (SP2) {
        PG8_STAGE(PG8_SB(0, 0), cB, voffB); PG8_STAGE(PG8_SB(0, 1), cB + hstep, voffB); PG8_STAGE(PG8_SA(0, 0), cA, voffA); PG8_STAGE(PG8_SA(0, 1), cA + hstep, voffA);
        if (wr == 1) PG8_BAR;
        PG8_WAIT_V(2); PG8_BAR;
        PG8_STAGE(PG8_SB(1, 0), cB + kstep, voffB); PG8_STAGE(PG8_SA(1, 0), cA + kstep, voffA); PG8_STAGE(PG8_SB(1, 1), cB + hstep + kstep, voffB);
        PG8_WAIT_V(6); PG8_BAR;
    } else {
        PG8_STAGE(PG8_SB(0, 0), cB, voffB); PG8_STAGE(PG8_SA(0, 0), cA, voffA); PG8_STAGE(PG8_SB(0, 1), cB + hstep, voffB); PG8_STAGE(PG8_SA(0, 1), cA + hstep, voffA);
        if (wr == 1) PG8_BAR;
        PG8_WAIT_V(4); PG8_BAR;
        PG8_STAGE(PG8_SB(1, 0), cB + kstep, voffB); PG8_STAGE(PG8_SA(1, 0), cA + kstep, voffA); PG8_STAGE(PG8_SB(1, 1), cB + hstep + kstep, voffB);
        PG8_WAIT_V(6); PG8_BAR;
    }
    for (;;) {
        const bool has_next = S.next(ui + 1, nxt);
        const char* nA = has_next ? (const char*)g.A + (size_t)nxt.pm * tstep : cA; const char* nB = has_next ? (const char*)g.Bt + (size_t)nxt.pn * tstep : cB;
        for (int t = 0; t < nt; t += 2) {
            const bool last = (t == nt - 2);
            const char* a1 = cA + (size_t)(t + 1) * kstep;
            const char* a2 = last ? nA : cA + (size_t)(t + 2) * kstep; const char* b2 = last ? nB : cB + (size_t)(t + 2) * kstep;
            const char* a3 = a2 + kstep; const char* b3 = b2 + kstep;
            if (last && has_next) S.a_ready(nxt);
            if constexpr (Epi::MID) { if (t == Epi::MID_T0 || t == Epi::MID_T1) E.mid(acc, cur, t, wr, wc, fr, fq); }
            if constexpr (SP2) {
            PG8_LDB(B0, 0, 0); PG8_LDB(B1, 0, 1); PG8_SCHED; PG8_LDA(At, 0, 0); PG8_STAGE(PG8_SA(1, 1), a1 + hstep, voffA);
            PG8_WAIT_V(8); PG8_WAIT_L(0); PG8_BAR; PG8_MMA(0, 0, At, B0); PG8_MMA(0, 1, At, B1); PG8_BAR; PG8_SCHED;
            PG8_LDA(At, 0, 1); PG8_STAGE(PG8_SB(0, 0), b2, voffB); PG8_STAGE(PG8_SB(0, 1), b2 + hstep, voffB); PG8_STAGE(PG8_SA(0, 0), a2, voffA);
            PG8_WAIT_V(8); PG8_WAIT_L(0); PG8_BAR; PG8_MMA(1, 0, At, B0); PG8_MMA(1, 1, At, B1); PG8_BAR; PG8_SCHED;
            PG8_LDB(B0, 1, 0); PG8_LDB(B1, 1, 1); PG8_SCHED; PG8_LDA(At, 1, 0); PG8_STAGE(PG8_SA(0, 1), a2 + hstep, voffA);
            PG8_WAIT_V(8); PG8_WAIT_L(0); PG8_BAR; PG8_MMA(0, 0, At, B0); PG8_MMA(0, 1, At, B1); PG8_BAR; PG8_SCHED;
            PG8_LDA(At, 1, 1); PG8_STAGE(PG8_SB(1, 0), b3, voffB); PG8_STAGE(PG8_SB(1, 1), b3 + hstep, voffB); PG8_STAGE(PG8_SA(1, 0), a3, voffA);
            PG8_WAIT_V(8); PG8_WAIT_L(0); PG8_BAR; PG8_MMA(1, 0, At, B0); PG8_MMA(1, 1, At, B1); PG8_BAR; PG8_SCHED;
            } else {
            PG8_LDB(B0, 0, 0); PG8_SCHED; PG8_LDA(At, 0, 0); PG8_STAGE(PG8_SA(1, 1), a1 + hstep, voffA);
            PG8_WAIT_L(8); PG8_BAR; PG8_WAIT_L(0); PG8_MMA(0, 0, At, B0); PG8_BAR; PG8_SCHED;
            PG8_LDB(B1, 0, 1); PG8_STAGE(PG8_SB(0, 0), b2, voffB);
            PG8_BAR; PG8_WAIT_L(0); PG8_MMA(0, 1, At, B1); PG8_BAR;
            PG8_LDA(At, 0, 1); PG8_STAGE(PG8_SA(0, 0), a2, voffA);
            PG8_BAR; PG8_WAIT_L(0); PG8_MMA(1, 0, At, B0); PG8_BAR; PG8_SCHED;
            PG8_STAGE(PG8_SB(0, 1), b2 + hstep, voffB);
            PG8_WAIT_V(6); PG8_BAR; PG8_MMA(1, 1, At, B1); PG8_BAR;
            PG8_LDB(B0, 1, 0); PG8_SCHED; PG8_LDA(At, 1, 0); PG8_STAGE(PG8_SA(0, 1), a2 + hstep, voffA);
            PG8_WAIT_L(8); PG8_BAR; PG8_WAIT_L(0); PG8_MMA(0, 0, At, B0); PG8_BAR; PG8_SCHED;
            PG8_LDB(B1, 1, 1); PG8_STAGE(PG8_SB(1, 0), b3, voffB);
            PG8_BAR; PG8_WAIT_L(0); PG8_MMA(0, 1, At, B1); PG8_BAR;
            PG8_LDA(At, 1, 1); PG8_STAGE(PG8_SA(1, 0), a3, voffA);
            PG8_BAR; PG8_WAIT_L(0); PG8_MMA(1, 0, At, B0); PG8_BAR; PG8_SCHED;
            PG8_STAGE(PG8_SB(1, 1), b3 + hstep, voffB);
            PG8_WAIT_V(6); PG8_BAR; PG8_MMA(1, 1, At, B1); PG8_BAR;
            }
        }
        if constexpr (ALIGN_EPI) { if (wr == 0) PG8_BAR; }
        E(acc, cur, wr, wc, fr, fq); S.done(cur);
        if (!has_next) break;
#pragma unroll
        for (int a = 0; a < 2; ++a)
#pragma unroll
            for (int b = 0; b < 2; ++b)
#pragma unroll
                for (int m = 0; m < 4; ++m)
#pragma unroll
                    for (int n = 0; n < 2; ++n) acc[a][b][m][n] = (f32x4){0.f, 0.f, 0.f, 0.f};
        cur = nxt; cA = nA; cB = nB; ++ui;
        if constexpr (ALIGN_EPI) { if (wr == 1) PG8_BAR; }
    }
    PG8_WAIT_V(0);
    if constexpr (!ALIGN_EPI) { if (wr == 0) PG8_BAR; }
    PG8_BAR;
#undef PG8_SA
#undef PG8_SB
#undef PG8_STAGE
#undef PG8_LDA
#undef PG8_LDB
#undef PG8_MMA
#undef PG8_WAIT_V
#undef PG8_WAIT_L
#undef PG8_BAR
#undef PG8_SCHED
}
}

constexpr int M = 16384, D = 2048, FF = 5632, NIN = 15360, KBR = 2560, DEPTH = 4;
constexpr int NWAVES = 8;
constexpr float EPS = 1e-6f;
constexpr float SSQ_SCALE = 16777216.0f;
typedef unsigned short bf16;
typedef pg8::f32x4 f32x4;
typedef pg8::u32x4 u32x4;
typedef pg8::u32x2 u32x2;
#define LAS __attribute__((address_space(3)))

constexpr size_t MiB = 1u << 20;
constexpr size_t WS_CTL = 0, CTL_ZERO_BYTES = 4 * MiB;
constexpr size_t WS_RSQ = 1 * MiB;
constexpr size_t WS_W = 8 * MiB, W_LAYER = 210 * MiB;
constexpr size_t W_1A = 0, W_1B = 44 * MiB, W_IN = 66 * MiB, W_BR = 126 * MiB, W_O = 136 * MiB, W_2A = 144 * MiB, W_2B = 188 * MiB;
constexpr size_t WS_XB = 848 * MiB;
constexpr size_t WS_ACT = 912 * MiB;
constexpr size_t WS_QA = WS_ACT, WS_KA = WS_QA + 48 * MiB, WS_VA = WS_KA + 48 * MiB, WS_QB = WS_VA + 48 * MiB, WS_KB = WS_QB + 32 * MiB, WS_VB = WS_KB + 8 * MiB,
                 WS_QC = WS_VB + 8 * MiB, WS_KC = WS_QC + 32 * MiB, WS_VC = WS_KC + 32 * MiB, WS_G = WS_VC + 32 * MiB;
constexpr size_t WS_O = WS_ACT + 480 * MiB;
constexpr size_t WS_OAG = WS_O + 80 * MiB;
constexpr size_t WS_LSE = WS_OAG + 48 * MiB;
constexpr size_t WS_Z = WS_LSE + 1 * MiB;
constexpr size_t WS_END = WS_Z + 64 * MiB;
static_assert(WS_G + (size_t)M * 6144 * 2 == WS_O, "QKVG map");
static_assert(WS_W + 4 * W_LAYER == WS_XB, "weight map");
constexpr int CW_BAR = 4096;

constexpr int RING_BYTES = 131072, MISC_OFF = RING_BYTES + 320, LDS_BYTES = 147456;

#define XB_TMO      128
#define XB_XCNT(j)  (256  + 64 * (j))
#define XB_XSUB(j)  (1280 + 64 * (j))
#define XB_XGEN(j)  (2304 + 64 * (j))
#define XB_TOP      3328
#define XB_TOPGEN   3392
#define XCD_BAR_WORDS 3456
#define XB_SPIN_CAP (1u << 22)
__device__ __forceinline__ unsigned xb_ld(unsigned* p)              { return __hip_atomic_load(p, __ATOMIC_RELAXED, __HIP_MEMORY_SCOPE_AGENT); }
__device__ __forceinline__ unsigned xb_add(unsigned* p, unsigned v) { return __hip_atomic_fetch_add(p, v, __ATOMIC_RELAXED, __HIP_MEMORY_SCOPE_AGENT); }
__device__ __forceinline__ unsigned xb_xcc_id() { return (unsigned)__builtin_amdgcn_s_getreg((3 << 11) | 20) & 0xFu; }
#define XB_SPIN(cond, bar) do { unsigned _sp = 0; while (cond) { __builtin_amdgcn_s_sleep(1); \
    if ((++_sp & 255u) == 0u) { if (xb_ld(&(bar)[XB_TMO])) break; if (_sp > XB_SPIN_CAP) { atomicAdd(&(bar)[XB_TMO], 1u); break; } } } } while (0)
struct XcdBarrier { unsigned* bar; unsigned x; volatile LAS unsigned* st; };
__device__ __forceinline__ XcdBarrier xcd_barrier_post(unsigned* bar, volatile LAS unsigned* st) {
    XcdBarrier b; b.bar = bar; b.x = xb_xcc_id(); b.st = st;
    if (threadIdx.x == 0) (void)xb_add(&bar[XB_XCNT(b.x)], 1u);
    return b;
}
__device__ __forceinline__ void xcd_barrier_complete(unsigned* bar, unsigned x, unsigned& nloc, unsigned& nx) {
    const unsigned G = gridDim.x * gridDim.y * gridDim.z;
    unsigned sum, cnt, mine, sp = 0u;
    for (;;) {
        sum = 0u; cnt = 0u; mine = 0u;
#pragma unroll
        for (unsigned j = 0; j < 16; ++j) { const unsigned c = xb_ld(&bar[XB_XCNT(j)]); sum += c; cnt += (c > 0u) ? 1u : 0u; mine = (j == x) ? c : mine; }
        if (sum == G) break;
        __builtin_amdgcn_s_sleep(1);
        if ((++sp & 255u) == 0u) { if (xb_ld(&bar[XB_TMO])) break; if (sp > XB_SPIN_CAP) { atomicAdd(&bar[XB_TMO], 1u); break; } }
    }
    nloc = mine > 0u ? mine : 1u; nx = cnt > 0u ? cnt : 1u;
}
__device__ __forceinline__ void xcd_barrier(const XcdBarrier& b) {
    asm volatile("s_waitcnt vmcnt(0)" ::: "memory");
    __syncthreads();
    if (threadIdx.x == 0) {
        unsigned* bar = b.bar;
        __builtin_amdgcn_s_waitcnt(0);
        unsigned nloc = b.st[0], nx = b.st[1];
        if (nloc == 0u) { xcd_barrier_complete(bar, b.x, nloc, nx); b.st[0] = nloc; b.st[1] = nx; }
        const unsigned old = xb_add(&bar[XB_XSUB(b.x)], 1u);
        const unsigned gen = old / nloc;
        if (old + 1u == (gen + 1u) * nloc) {
            __builtin_amdgcn_fence(__ATOMIC_RELEASE, "agent");
            asm volatile("s_waitcnt vmcnt(0)" ::: "memory");
            const unsigned og = xb_add(&bar[XB_TOP], 1u);
            const unsigned tg = og / nx;
            if (og + 1u == (tg + 1u) * nx) xb_add(&bar[XB_TOPGEN], 1u);
            else XB_SPIN(xb_ld(&bar[XB_TOPGEN]) == tg, bar);
            __builtin_amdgcn_fence(__ATOMIC_ACQUIRE, "agent");
            xb_add(&bar[XB_XGEN(b.x)], 1u);
            asm volatile("s_waitcnt vmcnt(0)" ::: "memory");
        } else {
            XB_SPIN(xb_ld(&bar[XB_XGEN(b.x)]) == gen, bar);
            __builtin_amdgcn_fence(__ATOMIC_ACQUIRE, "agent");
            asm volatile("s_waitcnt vmcnt(0)" ::: "memory");
        }
    }
    __syncthreads();
}

#define LDS_WAIT() asm volatile("s_waitcnt lgkmcnt(0)" ::: "memory")
__device__ __forceinline__ unsigned f2bf(float f) { unsigned u = __builtin_bit_cast(unsigned, f); return (u + 0x7fffu + ((u >> 16) & 1u)) >> 16; }
__device__ __forceinline__ unsigned pk2(float lo, float hi) { return f2bf(lo) | (f2bf(hi) << 16); }
__device__ __forceinline__ float bf_lo(unsigned w) { return __uint_as_float(w << 16); }
__device__ __forceinline__ float bf_hi(unsigned w) { return __uint_as_float(w & 0xffff0000u); }
__device__ __forceinline__ float wave_sum(float v) {
#pragma unroll
    for (int o = 1; o < 64; o <<= 1) v += __shfl_xor(v, o);
    return v;
}
__device__ __forceinline__ float wave_max(float v) {
#pragma unroll
    for (int o = 1; o < 64; o <<= 1) v = fmaxf(v, __shfl_xor(v, o));
    return v;
}
__device__ __forceinline__ float rstd_row(const u64* rsq, int row) {
    const u64 v = rsq[row];
    return rsqrtf((float)v * (1.0f / (SSQ_SCALE * (float)D)) + EPS);
}
__device__ __forceinline__ float sigmoidf_(float x) { return 1.0f / (1.0f + __expf(-x)); }

struct EpiUp {
    static constexpr bool PERM = true, MID = false; static constexpr int MID_T0 = -1, MID_T1 = -1;
    bf16* act; const u64* rsq;
    __device__ __forceinline__ void mid(f32x4 (&)[2][2][4][2], const pg8::Unit&, int, int, int, int, int) const {}
    __device__ __forceinline__ void operator()(const f32x4 (&acc)[2][2][4][2], const pg8::Unit& u, int wr, int wc, int fr, int fq) const {
        const int row0 = u.pm * 256 + wr * 64 + fr, col0 = u.pn * 128 + wc * 32 + 8 * fq;
#pragma unroll
        for (int ai = 0; ai < 2; ++ai)
#pragma unroll
            for (int m = 0; m < 4; ++m) {
                const int row = row0 + ai * 128 + m * 16; const float rs = rstd_row(rsq, row);
                float o[8];
#pragma unroll
                for (int n = 0; n < 2; ++n)
#pragma unroll
                    for (int j = 0; j < 4; ++j) { const float gt = acc[ai][0][m][n][j] * rs, up = acc[ai][1][m][n][j] * rs; o[4 * n + j] = gt * sigmoidf_(gt) * up; }
                u32x4 w; w.x = pg8::cvt_pk_bf16(o[0], o[1]); w.y = pg8::cvt_pk_bf16(o[2], o[3]); w.z = pg8::cvt_pk_bf16(o[4], o[5]); w.w = pg8::cvt_pk_bf16(o[6], o[7]);
                *(u32x4*)(act + (size_t)row * FF + col0) = w;
            }
    }
};
template <int HALFSC> struct EpiRes {
    static constexpr bool PERM = true, MID = false; static constexpr int MID_T0 = -1, MID_T1 = -1;
    float* x; bf16* xb; u64* rsq_next;
    __device__ __forceinline__ void mid(f32x4 (&)[2][2][4][2], const pg8::Unit&, int, int, int, int, int) const {}
    __device__ __forceinline__ void operator()(const f32x4 (&acc)[2][2][4][2], const pg8::Unit& u, int wr, int wc, int fr, int fq) const {
        const float sc = HALFSC ? 0.5f : 1.0f;
        const int row0 = u.pm * 256 + wr * 64 + fr, col0 = u.pn * 256 + wc * 32 + 8 * fq;
#pragma unroll
        for (int ai = 0; ai < 2; ++ai)
#pragma unroll
            for (int m = 0; m < 4; ++m) {
                const int row = row0 + ai * 128 + m * 16; float ssq = 0.f;
#pragma unroll
                for (int bj = 0; bj < 2; ++bj) {
                    float* p = x + (size_t)row * D + col0 + bj * 128;
                    f32x4 a = *(const f32x4*)p, b = *(const f32x4*)(p + 4);
                    a = a + acc[ai][bj][m][0] * sc; b = b + acc[ai][bj][m][1] * sc;
                    *(f32x4*)p = a; *(f32x4*)(p + 4) = b;
                    ssq += (a[0] * a[0] + a[1] * a[1]) + (a[2] * a[2] + a[3] * a[3]) + (b[0] * b[0] + b[1] * b[1]) + (b[2] * b[2] + b[3] * b[3]);
                    u32x4 w; w.x = pg8::cvt_pk_bf16(a[0], a[1]); w.y = pg8::cvt_pk_bf16(a[2], a[3]); w.z = pg8::cvt_pk_bf16(b[0], b[1]); w.w = pg8::cvt_pk_bf16(b[2], b[3]);
                    *(u32x4*)(xb + (size_t)row * D + col0 + bj * 128) = w;
                }
                ssq += __shfl_xor(ssq, 16); ssq += __shfl_xor(ssq, 32);
                if (fq == 0) __hip_atomic_fetch_add(rsq_next + row, (u64)(ssq * SSQ_SCALE), __ATOMIC_RELAXED, __HIP_MEMORY_SCOPE_AGENT);
            }
    }
};
struct EpiIn {
    static constexpr bool PERM = true, MID = false; static constexpr int MID_T0 = -1, MID_T1 = -1;
    unsigned char* ws; const u64* rsq;
    __device__ __forceinline__ void mid(f32x4 (&)[2][2][4][2], const pg8::Unit&, int, int, int, int, int) const {}
    __device__ __forceinline__ void operator()(const f32x4 (&acc)[2][2][4][2], const pg8::Unit& u, int wr, int wc, int fr, int fq) const {
        const int c = u.pn; size_t off; int ldc, lc; bool gate = false;
        if (c < 6) { off = WS_QA; ldc = 1536; lc = c; } else if (c < 12) { off = WS_KA; ldc = 1536; lc = c - 6; } else if (c < 18) { off = WS_VA; ldc = 1536; lc = c - 12; }
        else if (c < 22) { off = WS_QB; ldc = 1024; lc = c - 18; } else if (c == 22) { off = WS_KB; ldc = 256; lc = 0; } else if (c == 23) { off = WS_VB; ldc = 256; lc = 0; }
        else if (c < 28) { off = WS_QC; ldc = 1024; lc = c - 24; } else if (c < 32) { off = WS_KC; ldc = 1024; lc = c - 28; } else if (c < 36) { off = WS_VC; ldc = 1024; lc = c - 32; }
        else { off = WS_G; ldc = 6144; lc = c - 36; gate = true; }
        bf16* dst = (bf16*)(ws + off);
        const int row0 = u.pm * 256 + wr * 64 + fr, col0 = lc * 256 + wc * 32 + 8 * fq;
#pragma unroll
        for (int ai = 0; ai < 2; ++ai)
#pragma unroll
            for (int m = 0; m < 4; ++m) {
                const int row = row0 + ai * 128 + m * 16; const float rs = rstd_row(rsq, row);
#pragma unroll
                for (int bj = 0; bj < 2; ++bj) {
                    f32x4 a = acc[ai][bj][m][0] * rs, b = acc[ai][bj][m][1] * rs;
                    if (gate) {
#pragma unroll
                        for (int j = 0; j < 4; ++j) { a[j] = fmaxf(sigmoidf_(a[j]), 1e-30f); b[j] = fmaxf(sigmoidf_(b[j]), 1e-30f); }
                    }
                    u32x4 w; w.x = pg8::cvt_pk_bf16(a[0], a[1]); w.y = pg8::cvt_pk_bf16(a[2], a[3]); w.z = pg8::cvt_pk_bf16(b[0], b[1]); w.w = pg8::cvt_pk_bf16(b[2], b[3]);
                    *(u32x4*)(dst + (size_t)row * ldc + col0 + bj * 128) = w;
                }
            }
    }
};
struct EpiBr {
    static constexpr bool PERM = true, MID = true; static constexpr int MID_T0 = 8, MID_T1 = 24;
    const bf16* G; bf16* z;
    __device__ __forceinline__ void mid(f32x4 (&acc)[2][2][4][2], const pg8::Unit& u, int t, int wr, int wc, int fr, int fq) const {
        const bf16* ga = G + (t == MID_T0 ? 0 : 2048);
        int frx = fr, fqx = fq; asm volatile("" : "+v"(frx), "+v"(fqx));
        const int row0 = u.pm * 256 + wr * 64 + frx, col0 = u.pn * 256 + wc * 32 + 8 * fqx;
#pragma unroll
        for (int ai = 0; ai < 2; ++ai)
#pragma unroll
            for (int m = 0; m < 4; ++m) {
                const int row = row0 + ai * 128 + m * 16;
#pragma unroll
                for (int bj = 0; bj < 2; ++bj) {
                    const bf16* p = ga + (size_t)row * 6144 + col0 + bj * 128;
                    const u32x4 na = *(const u32x4*)p, nb = *(const u32x4*)(p + 2048);
#pragma unroll
                    for (int j = 0; j < 2; ++j) {
                        acc[ai][bj][m][0][2 * j]     *= bf_lo(na[j]) / bf_lo(nb[j]);
                        acc[ai][bj][m][0][2 * j + 1] *= bf_hi(na[j]) / bf_hi(nb[j]);
                        acc[ai][bj][m][1][2 * j]     *= bf_lo(na[2 + j]) / bf_lo(nb[2 + j]);
                        acc[ai][bj][m][1][2 * j + 1] *= bf_hi(na[2 + j]) / bf_hi(nb[2 + j]);
                    }
                    asm volatile("" : "+v"(acc[ai][bj][m][0]), "+v"(acc[ai][bj][m][1]) :: "memory");
                }
            }
    }
    __device__ __forceinline__ void operator()(const f32x4 (&acc)[2][2][4][2], const pg8::Unit& u, int wr, int wc, int fr, int fq) const {
        const int row0 = u.pm * 256 + wr * 64 + fr, col0 = u.pn * 256 + wc * 32 + 8 * fq;
#pragma unroll
        for (int ai = 0; ai < 2; ++ai)
#pragma unroll
            for (int m = 0; m < 4; ++m) {
                const int row = row0 + ai * 128 + m * 16;
#pragma unroll
                for (int bj = 0; bj < 2; ++bj) {
                    const u32x4 ng = *(const u32x4*)(G + (size_t)row * 6144 + 4096 + col0 + bj * 128);
                    const f32x4 a = acc[ai][bj][m][0], b = acc[ai][bj][m][1];
                    u32x4 w; w.x = pg8::cvt_pk_bf16(a[0] * bf_lo(ng[0]), a[1] * bf_hi(ng[0])); w.y = pg8::cvt_pk_bf16(a[2] * bf_lo(ng[1]), a[3] * bf_hi(ng[1]));
                    w.z = pg8::cvt_pk_bf16(b[0] * bf_lo(ng[2]), b[1] * bf_hi(ng[2])); w.w = pg8::cvt_pk_bf16(b[2] * bf_lo(ng[3]), b[3] * bf_hi(ng[3]));
                    *(u32x4*)(z + (size_t)row * D + col0 + bj * 128) = w;
                }
            }
    }
};

__device__ __forceinline__ void cvt_item(const float* __restrict__ W, int N, const float* __restrict__ scale, bf16* dst, int dpitch, int dcol, int mode, int kb, int nb, LAS unsigned* T, int lane) {
    const int k0 = kb * 64, n0 = nb * 64, kpl = lane >> 4, n4 = (lane & 15) * 4;
    f32x4 r0[8], r1[8];
#pragma unroll
    for (int i = 0; i < 8; ++i) { const int k = k0 + 2 * (4 * i + kpl); r0[i] = *(const f32x4*)(W + (size_t)k * N + n0 + n4); r1[i] = *(const f32x4*)(W + (size_t)(k + 1) * N + n0 + n4); }
#pragma unroll
    for (int i = 0; i < 8; ++i) { const int kp = 4 * i + kpl, k = k0 + 2 * kp; const float s0 = scale ? scale[k] : 1.f, s1 = scale ? scale[k + 1] : 1.f;
#pragma unroll
        for (int j = 0; j < 4; ++j) T[(n4 + j) * 33 + kp] = pk2(r0[i][j] * s0, r1[i][j] * s1); }
    LDS_WAIT(); asm volatile("" ::: "memory");
    const int q = lane & 7;
#pragma unroll
    for (int i = 0; i < 8; ++i) { const int n = 8 * i + (lane >> 3); const LAS unsigned* s = T + n * 33 + 4 * q;
        u32x4 o; o.x = s[0]; o.y = s[1]; o.z = s[2]; o.w = s[3];
        const int c = n0 + n; int drow = c;
        if (mode == 1) { drow = (c < FF) ? (256 * (c >> 7) + (c & 127)) : (256 * ((c - FF) >> 7) + 128 + ((c - FF) & 127)); }
        *(u32x4*)(dst + (size_t)drow * dpitch + dcol + k0 + 8 * q) = o; }
    LDS_WAIT(); asm volatile("" ::: "memory");
}

struct Args { const float* in[18]; float* out; unsigned char* ws; int ph_lo, ph_hi; };
typedef const __attribute__((address_space(4))) Args* KArgs;

__device__ __forceinline__ void prologue(KArgs a, LAS unsigned char* lds, int gw, int NGW, int wave, int lane) {
    LAS unsigned* T = (LAS unsigned*)(lds + wave * 16384);
    constexpr int I0 = 32 * 176, I1 = 88 * 32, I2 = 32 * 240, I3 = 8 * 32, I4 = 16 * 32, I5 = 16 * 32, I6 = 32 * 32, PER = 2 * I0 + 2 * I1 + I2 + I3 + I4 + I5 + I6;
    for (int it = gw; it < DEPTH * PER; it += NGW) {
        const int l = it / PER; int r = it % PER; unsigned char* wl = a->ws + WS_W + (size_t)l * W_LAYER;
        if (r < I0) { cvt_item(a->in[4] + (size_t)l * D * 2 * FF, 2 * FF, a->in[3] + l * D, (bf16*)(wl + W_1A), D, 0, 1, r / 176, r % 176, T, lane); continue; } r -= I0;
        if (r < I1) { cvt_item(a->in[5] + (size_t)l * FF * D, D, nullptr, (bf16*)(wl + W_1B), FF, 0, 0, r / 32, r % 32, T, lane); continue; } r -= I1;
        if (r < I2) { cvt_item(a->in[7] + (size_t)l * D * NIN, NIN, a->in[6] + l * D, (bf16*)(wl + W_IN), D, 0, 0, r / 240, r % 240, T, lane); continue; } r -= I2;
        if (r < I3) { cvt_item(a->in[11] + (size_t)l * 512 * D, D, nullptr, (bf16*)(wl + W_BR), KBR, 0, 0, r / 32, r % 32, T, lane); continue; } r -= I3;
        if (r < I4) { cvt_item(a->in[12] + (size_t)l * 1024 * D, D, nullptr, (bf16*)(wl + W_BR), KBR, 512, 0, r / 32, r % 32, T, lane); continue; } r -= I4;
        if (r < I5) { cvt_item(a->in[13] + (size_t)l * 1024 * D, D, nullptr, (bf16*)(wl + W_BR), KBR, 1536, 0, r / 32, r % 32, T, lane); continue; } r -= I5;
        if (r < I6) { cvt_item(a->in[14] + (size_t)l * D * D, D, nullptr, (bf16*)(wl + W_O), D, 0, 0, r / 32, r % 32, T, lane); continue; } r -= I6;
        if (r < I0) { cvt_item(a->in[16] + (size_t)l * D * 2 * FF, 2 * FF, a->in[15] + l * D, (bf16*)(wl + W_2A), D, 0, 1, r / 176, r % 176, T, lane); continue; } r -= I0;
        cvt_item(a->in[17] + (size_t)l * FF * D, D, nullptr, (bf16*)(wl + W_2B), FF, 0, 0, r / 32, r % 32, T, lane);
    }
    u64* rsq0 = (u64*)(a->ws + WS_RSQ); bf16* xb = (bf16*)(a->ws + WS_XB);
    for (int row = gw; row < M; row += NGW) {
        const float* src = row < 8192 ? a->in[0] + (size_t)row * D : a->in[1] + (size_t)(row - 8192) * D;
        f32x4 v[8]; float s = 0.f;
#pragma unroll
        for (int j = 0; j < 8; ++j) { v[j] = *(const f32x4*)(src + 256 * j + 4 * lane); s += (v[j][0] * v[j][0] + v[j][1] * v[j][1]) + (v[j][2] * v[j][2] + v[j][3] * v[j][3]); }
#pragma unroll
        for (int j = 0; j < 8; ++j) { *(f32x4*)(a->out + (size_t)row * D + 256 * j + 4 * lane) = v[j];
            u32x2 w; w.x = pk2(v[j][0], v[j][1]); w.y = pk2(v[j][2], v[j][3]); *(u32x2*)(xb + (size_t)row * D + 256 * j + 4 * lane) = w; }
        s = wave_sum(s);
        if (lane == 0) rsq0[row] = (u64)(s * SSQ_SCALE);
    }
}

__device__ __forceinline__ int t5_bucket_dev(int rel) {
    const int n = rel < 0 ? -rel : rel; int b;
    if (n < 8) b = n; else { int lg = 8 + (int)(log((double)n / 8.0) / log(1024.0 / 8.0) * 8.0); b = lg < 15 ? lg : 15; }
    return b + (rel > 0 ? 16 : 0);
}
__device__ __forceinline__ void seq_of(int row, int& base, int& L) { if (row < 8192) { base = 0; L = 8192; } else if (row < 12288) { base = 8192; L = 4096; } else { base = 12288; L = 4096; } }

__device__ __forceinline__ void qknorm_phase(unsigned char* ws, const float* qk_norm, int l, int gw, int NGW, int lane) {
    const float* qkg = qk_norm + (size_t)l * 6 * 128;
    for (int it = gw; it < M * 50; it += NGW) {
        const int row = it / 50, s = it % 50; size_t off; int ldc, h, gi;
        if (s < 12) { off = WS_QA; ldc = 1536; h = s; gi = 0; } else if (s < 24) { off = WS_KA; ldc = 1536; h = s - 12; gi = 1; }
        else if (s < 32) { off = WS_QB; ldc = 1024; h = s - 24; gi = 2; } else if (s < 34) { off = WS_KB; ldc = 256; h = s - 32; gi = 3; }
        else if (s < 42) { off = WS_QC; ldc = 1024; h = s - 34; gi = 4; } else { off = WS_KC; ldc = 1024; h = s - 42; gi = 5; }
        unsigned* p = (unsigned*)((bf16*)(ws + off) + (size_t)row * ldc + h * 128) + lane;
        const unsigned w = *p; const float v0 = bf_lo(w), v1 = bf_hi(w);
        const float ss = wave_sum(v0 * v0 + v1 * v1);
        const float r = rsqrtf(ss * (1.0f / 128.0f) + EPS);
        *p = pk2(v0 * r * qkg[gi * 128 + 2 * lane], v1 * r * qkg[gi * 128 + 2 * lane + 1]);
    }
}

__device__ __forceinline__ void attn_naive_phase(unsigned char* ws, const float* relb, const float* sink_all, const float* rpb_all, int l, LAS unsigned char* lds, int gw, int NGW, int wave, int lane) {
    LAS unsigned char* tab = lds + 8192;
    for (int n = threadIdx.x; n <= 1024; n += NWAVES * 64) tab[n] = (unsigned char)t5_bucket_dev(-n);
    __syncthreads();
    LAS float* pl = (LAS float*)(lds + wave * 16384); LAS int* tl = (LAS int*)(lds + wave * 16384 + 2048);
    const float* sink = sink_all + l * 8; const float* rpb = rpb_all + (size_t)l * 8 * 15 * 31;
    for (int it = gw; it < 28 * M; it += NGW) {
        const int h28 = it / M, row = it % M; int base, L; seq_of(row, base, L); const int t = row - base;
        const bf16 *Q, *Kp, *Vp; int ldq, ldk, qoff, koff, nslots, type, g = 0, hh = 0, d = 1;
        if (h28 < 12) { type = 0; g = h28 >> 2; hh = h28 & 3; d = (g == 0) ? 1 : (g == 1 ? 4 : 16); Q = (const bf16*)(ws + WS_QA); Kp = (const bf16*)(ws + WS_KA); Vp = (const bf16*)(ws + WS_VA); ldq = 1536; ldk = 1536; qoff = h28 * 128; koff = h28 * 128; nslots = 129; }
        else if (h28 < 20) { type = 1; hh = h28 - 12; Q = (const bf16*)(ws + WS_QB); Kp = (const bf16*)(ws + WS_KB); Vp = (const bf16*)(ws + WS_VB); ldq = 1024; ldk = 256; qoff = hh * 128; koff = (hh >> 2) * 128; nslots = 257; }
        else { type = 2; hh = h28 - 20; Q = (const bf16*)(ws + WS_QC); Kp = (const bf16*)(ws + WS_KC); Vp = (const bf16*)(ws + WS_VC); ldq = 1024; ldk = 1024; qoff = hh * 128; koff = hh * 128; nslots = 128; }
        const int rows = L >> 6, r = t >> 6, c = t & 63; int rs = r - 4; rs = rs < 0 ? 0 : (rs > rows - 8 ? rows - 8 : rs); int qs = c - 8; qs = qs < 0 ? 0 : (qs > 48 ? 48 : qs);
        const bf16* qp = Q + (size_t)row * ldq + qoff;
        float mx = -1e30f;
#pragma unroll 1
        for (int j = lane; j < nslots; j += 64) {
            bool valid = true; int tk = t; float bias = 0.f;
            if (type == 0) { const int rel = (j - 64) * d; tk = t + rel; valid = tk >= 0 && tk < L; const int n = rel < 0 ? -rel : rel; bias = relb[((int)tab[n] + (rel > 0 ? 16 : 0)) * 20 + h28]; }
            else if (type == 1) { const int rel = j - 128; tk = t + rel; valid = tk >= 0 && tk < L; const int n = rel < 0 ? -rel : rel; bias = relb[((int)tab[n] + (rel > 0 ? 16 : 0)) * 20 + 12 + hh]; }
            else { const int kr = rs + (j >> 4), kc = qs + (j & 15); tk = kr * 64 + kc; bias = rpb[(hh * 15 + (kr - r + 7)) * 31 + (kc - c + 15)]; }
            if (!valid) tk = t;
            float dot = 0.f; const bf16* kp = Kp + (size_t)(base + tk) * ldk + koff;
#pragma unroll 4
            for (int ch = 0; ch < 16; ++ch) { const u32x4 kv = *(const u32x4*)(kp + 8 * ch); const u32x4 qv = *(const u32x4*)(qp + 8 * ch);
#pragma unroll
                for (int e = 0; e < 4; ++e) dot += bf_lo(qv[e]) * bf_lo(kv[e]) + bf_hi(qv[e]) * bf_hi(kv[e]); }
            const float sc = valid ? dot * 0.08838834764831845f + bias : -1e30f;
            mx = fmaxf(mx, sc);
            pl[j] = sc; tl[j] = tk;
        }
        mx = wave_max(mx);
        if (type == 1) mx = fmaxf(mx, sink[hh]);
        float den = 0.f;
#pragma unroll 1
        for (int j = lane; j < nslots; j += 64) { const float sc = pl[j]; const float p = (sc > -1e29f) ? __expf(sc - mx) : 0.f; den += p; pl[j] = p; }
        den = wave_sum(den);
        if (type == 1) den += __expf(sink[hh] - mx);
        LDS_WAIT(); asm volatile("" ::: "memory");
        float o0 = 0.f, o1 = 0.f;
#pragma unroll 4
        for (int j = 0; j < nslots; ++j) { const float p = pl[j]; const int tk = tl[j];
            const unsigned w = *(const unsigned*)(Vp + (size_t)(base + tk) * ldk + koff + 2 * lane); o0 += p * bf_lo(w); o1 += p * bf_hi(w); }
        const float inv = 1.0f / den; o0 *= inv; o1 *= inv;
        if (type == 0) { *(unsigned*)((bf16*)(ws + WS_OAG) + ((size_t)g * M + row) * 512 + hh * 128 + 2 * lane) = pk2(o0, o1);
            if (lane == 0) ((float*)(ws + WS_LSE))[((size_t)g * M + row) * 4 + hh] = mx + __logf(den); }
        else { *(unsigned*)((bf16*)(ws + WS_O) + (size_t)row * KBR + (type == 1 ? 512 : 1536) + hh * 128 + 2 * lane) = pk2(o0, o1); }
        LDS_WAIT(); asm volatile("" ::: "memory");
    }
}
__device__ __forceinline__ void combine_phase(unsigned char* ws, int gw, int NGW, int lane) {
    const float* lse = (const float*)(ws + WS_LSE); const bf16* oag = (const bf16*)(ws + WS_OAG); bf16* O = (bf16*)(ws + WS_O);
    for (int it = gw; it < M * 4; it += NGW) {
        const int row = it >> 2, hh = it & 3;
        const float l0 = lse[((size_t)0 * M + row) * 4 + hh], l1 = lse[((size_t)1 * M + row) * 4 + hh], l2 = lse[((size_t)2 * M + row) * 4 + hh];
        const float mx = fmaxf(l0, fmaxf(l1, l2)); float w0 = __expf(l0 - mx), w1 = __expf(l1 - mx), w2 = __expf(l2 - mx); const float inv = 1.0f / (w0 + w1 + w2); w0 *= inv; w1 *= inv; w2 *= inv;
        const unsigned a0 = *(const unsigned*)(oag + ((size_t)0 * M + row) * 512 + hh * 128 + 2 * lane), a1 = *(const unsigned*)(oag + ((size_t)1 * M + row) * 512 + hh * 128 + 2 * lane), a2 = *(const unsigned*)(oag + ((size_t)2 * M + row) * 512 + hh * 128 + 2 * lane);
        *(unsigned*)(O + (size_t)row * KBR + hh * 128 + 2 * lane) = pk2(w0 * bf_lo(a0) + w1 * bf_lo(a1) + w2 * bf_lo(a2), w0 * bf_hi(a0) + w1 * bf_hi(a1) + w2 * bf_hi(a2));
    }
}

constexpr int NP = 10;
enum { PH_UP1 = 0, PH_DN1, PH_IN, PH_QKN, PH_ATT, PH_CMB, PH_BR, PH_OUT, PH_UP2, PH_DN2 };
constexpr int NPH = 1 + DEPTH * NP;

__device__ __forceinline__ KArgs kargs() { u64 p = (u64)__builtin_amdgcn_kernarg_segment_ptr(); asm volatile("" : "+s"(p)); return (KArgs)p; }
__device__ __forceinline__ int otid() { int t = threadIdx.x; asm volatile("" : "+v"(t)); return t; }
__device__ __forceinline__ int vcu_of() { const int G = gridDim.x, bx = blockIdx.x; return (G % 8 == 0) ? (bx % 8) * (G / 8) + bx / 8 : bx; }

__global__ void __launch_bounds__(NWAVES * 64, 2) fwd(Args args) {
    extern __shared__ __attribute__((aligned(16))) unsigned char lds_raw[];
    LAS unsigned char* lds = (LAS unsigned char*)lds_raw;
    { const int tid = otid(); for (int u = tid; u < (LDS_BYTES - RING_BYTES) / 4; u += NWAVES * 64) ((LAS unsigned*)(lds + RING_BYTES))[u] = 0u; }
    __syncthreads();
    if (ONE_LAUNCH) (void)xcd_barrier_post((unsigned*)(kargs()->ws + WS_CTL) + CW_BAR, (volatile LAS unsigned*)(lds + MISC_OFF) + 8);
    const int lo = args.ph_lo, hi = args.ph_hi;
#define IN(k) (lo <= (k) && (k) < hi)
#define SEAM(k) do { if (ONE_LAUNCH && IN(k) && IN((k) + 1)) { XcdBarrier b_; b_.bar = (unsigned*)(kargs()->ws + WS_CTL) + CW_BAR; b_.x = xb_xcc_id(); b_.st = (volatile LAS unsigned*)(lds + MISC_OFF) + 8; xcd_barrier(b_); } } while (0)
#define TIDS() const int tid = otid(), lane = tid & 63, wave = __builtin_amdgcn_readfirstlane(tid >> 6); const int gw = vcu_of() * NWAVES + wave, NGW = (int)gridDim.x * NWAVES; (void)lane; (void)gw; (void)NGW

    if (IN(0)) { KArgs ka = kargs(); TIDS(); prologue(ka, lds, gw, NGW, wave, lane); __syncthreads(); }
    SEAM(0);
    for (int l = 0; l < DEPTH; ++l) {
        const int g0 = 1 + l * NP;
        if (IN(g0 + PH_UP1)) {
            KArgs ka = kargs(); unsigned char* ws = ka->ws; unsigned char* wl = ws + WS_W + (size_t)l * W_LAYER;
            pg8::Gemm g{(const bf16*)(ws + WS_XB), (const bf16*)(wl + W_1A), M, 2 * FF, D}; pg8::StaticOrder S; S.init(M, 2 * FF, (int)gridDim.x, (int)blockIdx.x);
            EpiUp E{(bf16*)(ws + WS_ACT), (const u64*)(ws + WS_RSQ) + (size_t)(3 * l + 0) * M};
            pg8::gemm_phase<EpiUp, pg8::StaticOrder, true, true>(lds, g, S, E);
        }
        SEAM(g0 + PH_UP1);
        if (IN(g0 + PH_DN1)) {
            KArgs ka = kargs(); unsigned char* ws = ka->ws; unsigned char* wl = ws + WS_W + (size_t)l * W_LAYER;
            pg8::Gemm g{(const bf16*)(ws + WS_ACT), (const bf16*)(wl + W_1B), M, D, FF}; pg8::StaticOrder S; S.init(M, D, (int)gridDim.x, (int)blockIdx.x);
            EpiRes<1> E{ka->out, (bf16*)(ws + WS_XB), (u64*)(ws + WS_RSQ) + (size_t)(3 * l + 1) * M};
            pg8::gemm_phase<EpiRes<1>, pg8::StaticOrder, true, true>(lds, g, S, E);
        }
        SEAM(g0 + PH_DN1);
        if (IN(g0 + PH_IN)) {
            KArgs ka = kargs(); unsigned char* ws = ka->ws; unsigned char* wl = ws + WS_W + (size_t)l * W_LAYER;
            pg8::Gemm g{(const bf16*)(ws + WS_XB), (const bf16*)(wl + W_IN), M, NIN, D}; pg8::StaticOrder S; S.init(M, NIN, (int)gridDim.x, (int)blockIdx.x);
            EpiIn E{ws, (const u64*)(ws + WS_RSQ) + (size_t)(3 * l + 1) * M};
            pg8::gemm_phase<EpiIn, pg8::StaticOrder, true, true>(lds, g, S, E);
        }
        SEAM(g0 + PH_IN);
        if (IN(g0 + PH_QKN)) { KArgs ka = kargs(); TIDS(); qknorm_phase(ka->ws, ka->in[8], l, gw, NGW, lane); }
        SEAM(g0 + PH_QKN);
        if (IN(g0 + PH_ATT)) { KArgs ka = kargs(); TIDS(); attn_naive_phase(ka->ws, ka->in[2], ka->in[9], ka->in[10], l, lds, gw, NGW, wave, lane); __syncthreads(); }
        SEAM(g0 + PH_ATT);
        if (IN(g0 + PH_CMB)) { KArgs ka = kargs(); TIDS(); combine_phase(ka->ws, gw, NGW, lane); }
        SEAM(g0 + PH_CMB);
        if (IN(g0 + PH_BR)) {
            KArgs ka = kargs(); unsigned char* ws = ka->ws; unsigned char* wl = ws + WS_W + (size_t)l * W_LAYER;
            pg8::Gemm g{(const bf16*)(ws + WS_O), (const bf16*)(wl + W_BR), M, D, KBR}; pg8::StaticOrder S; S.init(M, D, (int)gridDim.x, (int)blockIdx.x);
            EpiBr E{(const bf16*)(ws + WS_G), (bf16*)(ws + WS_Z)};
            pg8::gemm_phase<EpiBr, pg8::StaticOrder, true, true>(lds, g, S, E);
        }
        SEAM(g0 + PH_BR);
        if (IN(g0 + PH_OUT)) {
            KArgs ka = kargs(); unsigned char* ws = ka->ws; unsigned char* wl = ws + WS_W + (size_t)l * W_LAYER;
            pg8::Gemm g{(const bf16*)(ws + WS_Z), (const bf16*)(wl + W_O), M, D, D}; pg8::StaticOrder S; S.init(M, D, (int)gridDim.x, (int)blockIdx.x);
            EpiRes<0> E{ka->out, (bf16*)(ws + WS_XB), (u64*)(ws + WS_RSQ) + (size_t)(3 * l + 2) * M};
            pg8::gemm_phase<EpiRes<0>, pg8::StaticOrder, true, true>(lds, g, S, E);
        }
        SEAM(g0 + PH_OUT);
        if (IN(g0 + PH_UP2)) {
            KArgs ka = kargs(); unsigned char* ws = ka->ws; unsigned char* wl = ws + WS_W + (size_t)l * W_LAYER;
            pg8::Gemm g{(const bf16*)(ws + WS_XB), (const bf16*)(wl + W_2A), M, 2 * FF, D}; pg8::StaticOrder S; S.init(M, 2 * FF, (int)gridDim.x, (int)blockIdx.x);
            EpiUp E{(bf16*)(ws + WS_ACT), (const u64*)(ws + WS_RSQ) + (size_t)(3 * l + 2) * M};
            pg8::gemm_phase<EpiUp, pg8::StaticOrder, true, true>(lds, g, S, E);
        }
        SEAM(g0 + PH_UP2);
        if (IN(g0 + PH_DN2)) {
            KArgs ka = kargs(); unsigned char* ws = ka->ws; unsigned char* wl = ws + WS_W + (size_t)l * W_LAYER;
            pg8::Gemm g{(const bf16*)(ws + WS_ACT), (const bf16*)(wl + W_2B), M, D, FF}; pg8::StaticOrder S; S.init(M, D, (int)gridDim.x, (int)blockIdx.x);
            EpiRes<1> E{ka->out, (bf16*)(ws + WS_XB), (u64*)(ws + WS_RSQ) + (size_t)(3 * l + 3) * M};
            pg8::gemm_phase<EpiRes<1>, pg8::StaticOrder, true, true>(lds, g, S, E);
        }
        SEAM(g0 + PH_DN2);
    }
#undef IN
#undef SEAM
#undef TIDS
}

extern "C" void kernel_launch(void* const* d_in, const int* in_sizes, int n_in, void* d_out, int out_size, void* d_ws, size_t ws_size, hipStream_t stream) {
    static int grid = 0;
    if (grid == 0) {
        if (n_in != 18 || out_size != M * D || ws_size < WS_END) { fprintf(stderr, "kernel_launch: unexpected problem (n_in %d, out %d, ws %zu, need %zu); nothing launched\n", n_in, out_size, ws_size, (size_t)WS_END); grid = -1; return; }
        int dev = 0, cus = 0, per_cu = 0;
        if (hipGetDevice(&dev) != hipSuccess || hipDeviceGetAttribute(&cus, hipDeviceAttributeMultiprocessorCount, dev) != hipSuccess) { grid = -1; return; }
        if (hipFuncSetAttribute((const void*)fwd, hipFuncAttributeMaxDynamicSharedMemorySize, LDS_BYTES) != hipSuccess) { fprintf(stderr, "kernel_launch: hipFuncSetAttribute failed\n"); grid = -1; return; }
        if (hipOccupancyMaxActiveBlocksPerMultiprocessor(&per_cu, (const void*)fwd, NWAVES * 64, LDS_BYTES) != hipSuccess || per_cu < 1) { fprintf(stderr, "kernel_launch: occupancy query says %d\n", per_cu); }
        (void)hipGetLastError();
        grid = cus;
    }
    if (grid < 0) return;
    (void)hipMemsetAsync((char*)d_ws + WS_CTL, 0, CTL_ZERO_BYTES, stream);
    Args a{};
    for (int i = 0; i < 18; ++i) a.in[i] = (const float*)d_in[i];
    a.out = (float*)d_out; a.ws = (unsigned char*)d_ws;
    if (ONE_LAUNCH) { a.ph_lo = 0; a.ph_hi = NPH; hipLaunchKernelGGL(fwd, dim3(grid), dim3(NWAVES * 64), LDS_BYTES, stream, a); }
    else for (int p = 0; p < NPH; ++p) { a.ph_lo = p; a.ph_hi = p + 1; hipLaunchKernelGGL(fwd, dim3(grid), dim3(NWAVES * 64), LDS_BYTES, stream, a); }
}
```

```cpp
#include <hip/hip_runtime.h>
#include <cstdio>
#include <cstdint>

#ifndef ONE_LAUNCH
#define ONE_LAUNCH 1
#endif

#ifndef FAST_MASK
#define FAST_MASK 7
#endif
#ifndef NORM_ON_LOAD
#define NORM_ON_LOAD 0
#endif
typedef unsigned long long u64;
namespace pg8 {
#define PG8_LAS __attribute__((address_space(3)))
typedef unsigned short bf16_t;
typedef short bf16x8 __attribute__((ext_vector_type(8)));
typedef float f32x4 __attribute__((ext_vector_type(4)));
typedef unsigned u32x4 __attribute__((ext_vector_type(4)));
typedef unsigned u32x2 __attribute__((ext_vector_type(2)));
constexpr int BM = 256, BK = 64, HALF = 128, HTB = HALF * BK * 2, STAGE_BYTES = 8 * HTB, NXCD = 8, WGM = 8;

__host__ __device__ __forceinline__ int lds_byte(int r, int c) { const int st = (r >> 4) * 2 + (c >> 5), rr = r & 15, cc = c & 31, ob = rr * 64 + cc * 2; return st * 1024 + (ob ^ (((ob >> 9) & 1) << 5)); }
__host__ __device__ __forceinline__ void stage_rc(int b, int& R, int& C) { const int st = b / 1024, sb = b % 1024, swz = sb ^ (((sb >> 9) & 1) << 5); R = (st >> 1) * 16 + swz / 64; C = (st & 1) * 32 + (swz % 64) / 2; }
__host__ __device__ __forceinline__ int perm32(int rho) { const int n = rho >> 4, i = rho & 15; return 8 * (i >> 2) + 4 * n + (i & 3); }

struct Unit { int pm, pn; };
struct Gemm { const bf16_t* A; const bf16_t* Bt; int M, N, K; };

struct StaticOrder {
    int nM, nN, nwg, G, c;
    __host__ __device__ void init(int M, int N, int G_, int c_) { nM = M / BM; nN = N / BM; nwg = nM * nN; G = G_; c = c_; }
    __host__ __device__ bool next(int i, Unit& u) const {
        const long L = (long)i * G + c; if (L >= nwg) return false;
        int wgid = (int)L; { const int q = nwg / NXCD, r = nwg % NXCD, xcd = wgid % NXCD, off = wgid / NXCD; wgid = (xcd < r ? xcd * (q + 1) : r * (q + 1) + (xcd - r) * q) + off; }
        const int nig = WGM * nN, gid = wgid / nig, fm = gid * WGM, gsz = (nM - fm) < WGM ? (nM - fm) : WGM;
        u.pm = fm + ((wgid % nig) % gsz); u.pn = (wgid % nig) / gsz; return true;
    }
    __device__ __forceinline__ void a_ready(const Unit&) const {}
    __device__ __forceinline__ void done(const Unit&) const {}
};

__device__ __forceinline__ unsigned cvt_pk_bf16(float lo, float hi) { unsigned r; asm volatile("v_cvt_pk_bf16_f32 %0, %1, %2" : "=v"(r) : "v"(lo), "v"(hi)); return r; }
__device__ __forceinline__ float bf_lo(unsigned w) { return __uint_as_float(w << 16); }
__device__ __forceinline__ float bf_hi(unsigned w) { return __uint_as_float(w & 0xffff0000u); }

template <class Epi, class Sched, bool ALIGN_EPI = false, bool SP2 = false>
__device__ __forceinline__ void gemm_phase(PG8_LAS unsigned char* lds, const Gemm g, const Sched& S, const Epi& E, const int tid  ) {
    const int wid = __builtin_amdgcn_readfirstlane(tid >> 6), lane = tid & 63, wr = wid >> 2, wc = wid & 3, fr = lane & 15, fq = lane >> 4;
    const int K = g.K, nt = K / BK;
    unsigned voffA[2], voffB[2];
#pragma unroll
    for (int i = 0; i < 2; ++i) { int R, C; stage_rc(tid * 16 + i * 8192, R, C); const int Rb = Epi::PERM ? ((R & ~31) + perm32(R & 31)) : R;
        voffA[i] = (unsigned)(R * K + C) * 2u; voffB[i] = (unsigned)(Rb * K + C) * 2u; }
    const size_t kstep = (size_t)(BK * 2);
    const size_t hstep = (size_t)HALF * K * 2;
    const size_t tstep = 2 * hstep;
    const unsigned ldsw = (unsigned)wid * 1024u;
    const int aoff = lds_byte(wr * 64 + fr, fq * 8), boff = lds_byte(wc * 32 + fr, fq * 8);
#define PG8_SA(b, h) (((b) * 2 + (h)) * HTB)
#define PG8_SB(b, h) ((4 + (b) * 2 + (h)) * HTB)
#define PG8_STAGE(bufoff, gbase, voff) do { _Pragma("unroll") for (int _i = 0; _i < 2; ++_i) \
        __builtin_amdgcn_global_load_lds((const unsigned*)((const char*)(gbase) + (voff)[_i]), (PG8_LAS unsigned*)(lds + (bufoff) + ldsw + _i * 8192), 16, 0, 0); } while (0)
#define PG8_LDA(dst, b, h) do { _Pragma("unroll") for (int m = 0; m < 4; ++m) _Pragma("unroll") for (int k = 0; k < 2; ++k) dst[m][k] = *(const PG8_LAS bf16x8*)(lds + PG8_SA(b, h) + aoff + m * 2048 + k * 1024); } while (0)
#define PG8_LDB(dst, b, h) do { _Pragma("unroll") for (int n = 0; n < 2; ++n) _Pragma("unroll") for (int k = 0; k < 2; ++k) dst[n][k] = *(const PG8_LAS bf16x8*)(lds + PG8_SB(b, h) + boff + n * 2048 + k * 1024); } while (0)
#define PG8_MMA(ai, bj, At, Bt) do { __builtin_amdgcn_s_setprio(1); _Pragma("unroll") for (int m = 0; m < 4; ++m) _Pragma("unroll") for (int n = 0; n < 2; ++n) _Pragma("unroll") for (int k = 0; k < 2; ++k) \
        acc[ai][bj][m][n] = __builtin_amdgcn_mfma_f32_16x16x32_bf16(Bt[n][k], At[m][k], acc[ai][bj][m][n], 0, 0, 0); __builtin_amdgcn_s_setprio(0); } while (0)
#define PG8_WAIT_V(n) asm volatile("s_waitcnt vmcnt(" #n ")" ::: "memory")
#define PG8_WAIT_L(n) asm volatile("s_waitcnt lgkmcnt(" #n ")" ::: "memory")
#define PG8_BAR __builtin_amdgcn_s_barrier()
#define PG8_SCHED __builtin_amdgcn_sched_barrier(0)
    Unit cur, nxt; int ui = 0;
    if (!S.next(0, cur)) return;
    f32x4 acc[2][2][4][2];
#pragma unroll
    for (int a = 0; a < 2; ++a)
#pragma unroll
        for (int b = 0; b < 2; ++b)
#pragma unroll
            for (int m = 0; m < 4; ++m)
#pragma unroll
                for (int n = 0; n < 2; ++n) acc[a][b][m][n] = (f32x4){0.f, 0.f, 0.f, 0.f};
    bf16x8 At[4][2], B0[2][2], B1[2][2];
    const char* cA = (const char*)g.A + (size_t)cur.pm * tstep; const char* cB = (const char*)g.Bt + (size_t)cur.pn * tstep;
    S.a_ready(cur);
    if constexpr (SP2) {
        PG8_STAGE(PG8_SB(0, 0), cB, voffB); PG8_STAGE(PG8_SB(0, 1), cB + hstep, voffB); PG8_STAGE(PG8_SA(0, 0), cA, voffA); PG8_STAGE(PG8_SA(0, 1), cA + hstep, voffA);
        if (wr == 1) PG8_BAR;
        PG8_WAIT_V(2); PG8_BAR;
        PG8_STAGE(PG8_SB(1, 0), cB + kstep, voffB); PG8_STAGE(PG8_SA(1, 0), cA + kstep, voffA); PG8_STAGE(PG8_SB(1, 1), cB + hstep + kstep, voffB);
        PG8_WAIT_V(6); PG8_BAR;
    } else {
        PG8_STAGE(PG8_SB(0, 0), cB, voffB); PG8_STAGE(PG8_SA(0, 0), cA, voffA); PG8_STAGE(PG8_SB(0, 1), cB + hstep, voffB); PG8_STAGE(PG8_SA(0, 1), cA + hstep, voffA);
        if (wr == 1) PG8_BAR;
        PG8_WAIT_V(4); PG8_BAR;
        PG8_STAGE(PG8_SB(1, 0), cB + kstep, voffB); PG8_STAGE(PG8_SA(1, 0), cA + kstep, voffA); PG8_STAGE(PG8_SB(1, 1), cB + hstep + kstep, voffB);
        PG8_WAIT_V(6); PG8_BAR;
    }
    for (;;) {
        const bool has_next = S.next(ui + 1, nxt);
        const char* nA = has_next ? (const char*)g.A + (size_t)nxt.pm * tstep : cA; const char* nB = has_next ? (const char*)g.Bt + (size_t)nxt.pn * tstep : cB;
        for (int t = 0; t < nt; t += 2) {
            const bool last = (t == nt - 2);
            const char* a1 = cA + (size_t)(t + 1) * kstep;
            const char* a2 = last ? nA : cA + (size_t)(t + 2) * kstep; const char* b2 = last ? nB : cB + (size_t)(t + 2) * kstep;
            const char* a3 = a2 + kstep; const char* b3 = b2 + kstep;
            if (last && has_next) S.a_ready(nxt);
            if constexpr (Epi::MID) { if (t == Epi::MID_T0 || t == Epi::MID_T1) E.mid(acc, cur, t, wr, wc, fr, fq); }
            if constexpr (SP2) {
            PG8_LDB(B0, 0, 0); PG8_LDB(B1, 0, 1); PG8_SCHED; PG8_LDA(At, 0, 0); PG8_STAGE(PG8_SA(1, 1), a1 + hstep, voffA);
            PG8_WAIT_V(8); PG8_WAIT_L(0); PG8_BAR; PG8_MMA(0, 0, At, B0); PG8_MMA(0, 1, At, B1); PG8_BAR; PG8_SCHED;
            PG8_LDA(At, 0, 1); PG8_STAGE(PG8_SB(0, 0), b2, voffB); PG8_STAGE(PG8_SB(0, 1), b2 + hstep, voffB); PG8_STAGE(PG8_SA(0, 0), a2, voffA);
            PG8_WAIT_V(8); PG8_WAIT_L(0); PG8_BAR; PG8_MMA(1, 0, At, B0); PG8_MMA(1, 1, At, B1); PG8_BAR; PG8_SCHED;
            PG8_LDB(B0, 1, 0); PG8_LDB(B1, 1, 1); PG8_SCHED; PG8_LDA(At, 1, 0); PG8_STAGE(PG8_SA(0, 1), a2 + hstep, voffA);
            PG8_WAIT_V(8); PG8_WAIT_L(0); PG8_BAR; PG8_MMA(0, 0, At, B0); PG8_MMA(0, 1, At, B1); PG8_BAR; PG8_SCHED;
            PG8_LDA(At, 1, 1); PG8_STAGE(PG8_SB(1, 0), b3, voffB); PG8_STAGE(PG8_SB(1, 1), b3 + hstep, voffB); PG8_STAGE(PG8_SA(1, 0), a3, voffA);
            PG8_WAIT_V(8); PG8_WAIT_L(0); PG8_BAR; PG8_MMA(1, 0, At, B0); PG8_MMA(1, 1, At, B1); PG8_BAR; PG8_SCHED;
            } else {
            PG8_LDB(B0, 0, 0); PG8_SCHED; PG8_LDA(At, 0, 0); PG8_STAGE(PG8_SA(1, 1), a1 + hstep, voffA);
            PG8_WAIT_L(8); PG8_BAR; PG8_WAIT_L(0); PG8_MMA(0, 0, At, B0); PG8_BAR; PG8_SCHED;
            PG8_LDB(B1, 0, 1); PG8_STAGE(PG8_SB(0, 0), b2, voffB);
            PG8_BAR; PG8_WAIT_L(0); PG8_MMA(0, 1, At, B1); PG8_BAR;
            PG8_LDA(At, 0, 1); PG8_STAGE(PG8_SA(0, 0), a2, voffA);
            PG8_BAR; PG8_WAIT_L(0); PG8_MMA(1, 0, At, B0); PG8_BAR; PG8_SCHED;
            PG8_STAGE(PG8_SB(0, 1), b2 + hstep, voffB);
            PG8_WAIT_V(6); PG8_BAR; PG8_MMA(1, 1, At, B1); PG8_BAR;
            PG8_LDB(B0, 1, 0); PG8_SCHED; PG8_LDA(At, 1, 0); PG8_STAGE(PG8_SA(0, 1), a2 + hstep, voffA);
            PG8_WAIT_L(8); PG8_BAR; PG8_WAIT_L(0); PG8_MMA(0, 0, At, B0); PG8_BAR; PG8_SCHED;
            PG8_LDB(B1, 1, 1); PG8_STAGE(PG8_SB(1, 0), b3, voffB);
            PG8_BAR; PG8_WAIT_L(0); PG8_MMA(0, 1, At, B1); PG8_BAR;
            PG8_LDA(At, 1, 1); PG8_STAGE(PG8_SA(1, 0), a3, voffA);
            PG8_BAR; PG8_WAIT_L(0); PG8_MMA(1, 0, At, B0); PG8_BAR; PG8_SCHED;
            PG8_STAGE(PG8_SB(1, 1), b3 + hstep, voffB);
            PG8_WAIT_V(6); PG8_BAR; PG8_MMA(1, 1, At, B1); PG8_BAR;
            }
        }
        if constexpr (ALIGN_EPI) { if (wr == 0) PG8_BAR; }
        E(acc, cur, wr, wc, fr, fq); S.done(cur);
        if (!has_next) break;
#pragma unroll
        for (int a = 0; a < 2; ++a)
#pragma unroll
            for (int b = 0; b < 2; ++b)
#pragma unroll
                for (int m = 0; m < 4; ++m)
#pragma unroll
                    for (int n = 0; n < 2; ++n) acc[a][b][m][n] = (f32x4){0.f, 0.f, 0.f, 0.f};
        cur = nxt; cA = nA; cB = nB; ++ui;
        if constexpr (ALIGN_EPI) { if (wr == 1) PG8_BAR; }
    }
    PG8_WAIT_V(0);
    if constexpr (!ALIGN_EPI) { if (wr == 0) PG8_BAR; }
    PG8_BAR;
#undef PG8_SA
#undef PG8_SB
#undef PG8_STAGE
#undef PG8_LDA
#undef PG8_LDB
#undef PG8_MMA
#undef PG8_WAIT_V
#undef PG8_WAIT_L
#undef PG8_BAR
#undef PG8_SCHED
}
}

constexpr int M = 16384, D = 2048, FF = 5632, NIN = 15360, KBR = 2560, DEPTH = 4;
constexpr int NWAVES = 8;
constexpr float EPS = 1e-6f;
constexpr float SSQ_SCALE = 16777216.0f;
typedef unsigned short bf16;
typedef pg8::f32x4 f32x4;
typedef pg8::u32x4 u32x4;
typedef pg8::u32x2 u32x2;
#define LAS __attribute__((address_space(3)))

constexpr size_t MiB = 1u << 20;
constexpr size_t WS_CTL = 0, CTL_ZERO_BYTES = 4 * MiB;
constexpr size_t WS_RSQ = 1 * MiB;
constexpr size_t WS_W = 8 * MiB, W_LAYER = 210 * MiB;
constexpr size_t W_1A = 0, W_1B = 44 * MiB, W_IN = 66 * MiB, W_BR = 126 * MiB, W_O = 136 * MiB, W_2A = 144 * MiB, W_2B = 188 * MiB;
constexpr size_t WS_XB = 848 * MiB;
constexpr size_t WS_ACT = 912 * MiB;
constexpr size_t WS_QA = WS_ACT, WS_KA = WS_QA + 48 * MiB, WS_VA = WS_KA + 48 * MiB, WS_QB = WS_VA + 48 * MiB, WS_KB = WS_QB + 32 * MiB, WS_VB = WS_KB + 8 * MiB,
                 WS_QC = WS_VB + 8 * MiB, WS_KC = WS_QC + 32 * MiB, WS_VC = WS_KC + 32 * MiB, WS_G = WS_VC + 32 * MiB;
constexpr size_t WS_O = WS_ACT + 480 * MiB;
constexpr size_t WS_OAG = WS_O + 80 * MiB;
constexpr size_t WS_LSE = WS_OAG + 48 * MiB;
constexpr size_t WS_Z = WS_LSE + 1 * MiB;
constexpr size_t WS_END = WS_Z + 64 * MiB;
static_assert(WS_G + (size_t)M * 6144 * 2 == WS_O, "QKVG map");
static_assert(WS_W + 4 * W_LAYER == WS_XB, "weight map");
constexpr int CW_BAR = 4096;

constexpr int RING_BYTES = 131072, MISC_OFF = RING_BYTES + 320, LDS_BYTES = 147456;

#define XB_TMO      128
#define XB_XCNT(j)  (256  + 64 * (j))
#define XB_XSUB(j)  (1280 + 64 * (j))
#define XB_XGEN(j)  (2304 + 64 * (j))
#define XB_TOP      3328
#define XB_TOPGEN   3392
#define XCD_BAR_WORDS 3456
#define XB_SPIN_CAP (1u << 22)
__device__ __forceinline__ unsigned xb_ld(unsigned* p)              { return __hip_atomic_load(p, __ATOMIC_RELAXED, __HIP_MEMORY_SCOPE_AGENT); }
__device__ __forceinline__ unsigned xb_add(unsigned* p, unsigned v) { return __hip_atomic_fetch_add(p, v, __ATOMIC_RELAXED, __HIP_MEMORY_SCOPE_AGENT); }
__device__ __forceinline__ unsigned xb_xcc_id() { return (unsigned)__builtin_amdgcn_s_getreg((3 << 11) | 20) & 0xFu; }
#define XB_SPIN(cond, bar) do { unsigned _sp = 0; while (cond) { __builtin_amdgcn_s_sleep(1); \
    if ((++_sp & 255u) == 0u) { if (xb_ld(&(bar)[XB_TMO])) break; if (_sp > XB_SPIN_CAP) { atomicAdd(&(bar)[XB_TMO], 1u); break; } } } } while (0)
struct XcdBarrier { unsigned* bar; unsigned x; volatile LAS unsigned* st; };
__device__ __forceinline__ XcdBarrier xcd_barrier_post(unsigned* bar, volatile LAS unsigned* st, int tid) {
    XcdBarrier b; b.bar = bar; b.x = xb_xcc_id(); b.st = st;
    if (tid == 0) (void)xb_add(&bar[XB_XCNT(b.x)], 1u);
    return b;
}
__device__ __forceinline__ void xcd_barrier_complete(unsigned* bar, unsigned x, unsigned& nloc, unsigned& nx) {
    const unsigned G = gridDim.x * gridDim.y * gridDim.z;
    unsigned sum, cnt, mine, sp = 0u;
    for (;;) {
        sum = 0u; cnt = 0u; mine = 0u;
#pragma unroll
        for (unsigned j = 0; j < 16; ++j) { const unsigned c = xb_ld(&bar[XB_XCNT(j)]); sum += c; cnt += (c > 0u) ? 1u : 0u; mine = (j == x) ? c : mine; }
        if (sum == G) break;
        __builtin_amdgcn_s_sleep(1);
        if ((++sp & 255u) == 0u) { if (xb_ld(&bar[XB_TMO])) break; if (sp > XB_SPIN_CAP) { atomicAdd(&bar[XB_TMO], 1u); break; } }
    }
    nloc = mine > 0u ? mine : 1u; nx = cnt > 0u ? cnt : 1u;
}
__device__ __forceinline__ void xcd_barrier(const XcdBarrier& b, int tid) {
    asm volatile("s_waitcnt vmcnt(0)" ::: "memory");
    __syncthreads();
    if (tid == 0) {
        unsigned* bar = b.bar;
        __builtin_amdgcn_s_waitcnt(0);
        unsigned nloc = b.st[0], nx = b.st[1];
        if (nloc == 0u) { xcd_barrier_complete(bar, b.x, nloc, nx); b.st[0] = nloc; b.st[1] = nx; }
        const unsigned old = xb_add(&bar[XB_XSUB(b.x)], 1u);
        const unsigned gen = old / nloc;
        if (old + 1u == (gen + 1u) * nloc) {
            __builtin_amdgcn_fence(__ATOMIC_RELEASE, "agent");
            asm volatile("s_waitcnt vmcnt(0)" ::: "memory");
            const unsigned og = xb_add(&bar[XB_TOP], 1u);
            const unsigned tg = og / nx;
            if (og + 1u == (tg + 1u) * nx) xb_add(&bar[XB_TOPGEN], 1u);
            else XB_SPIN(xb_ld(&bar[XB_TOPGEN]) == tg, bar);
            __builtin_amdgcn_fence(__ATOMIC_ACQUIRE, "agent");
            xb_add(&bar[XB_XGEN(b.x)], 1u);
            asm volatile("s_waitcnt vmcnt(0)" ::: "memory");
        } else {
            XB_SPIN(xb_ld(&bar[XB_XGEN(b.x)]) == gen, bar);
            __builtin_amdgcn_fence(__ATOMIC_ACQUIRE, "agent");
            asm volatile("s_waitcnt vmcnt(0)" ::: "memory");
        }
    }
    __syncthreads();
}

#define LDS_WAIT() asm volatile("s_waitcnt lgkmcnt(0)" ::: "memory")
__device__ __forceinline__ unsigned f2bf(float f) { unsigned u = __builtin_bit_cast(unsigned, f); return (u + 0x7fffu + ((u >> 16) & 1u)) >> 16; }
__device__ __forceinline__ unsigned pk2(float lo, float hi) { return f2bf(lo) | (f2bf(hi) << 16); }
__device__ __forceinline__ float bf_lo(unsigned w) { return __uint_as_float(w << 16); }
__device__ __forceinline__ float bf_hi(unsigned w) { return __uint_as_float(w & 0xffff0000u); }
__device__ __forceinline__ float wave_sum(float v) {
#pragma unroll
    for (int o = 1; o < 64; o <<= 1) v += __shfl_xor(v, o);
    return v;
}
__device__ __forceinline__ float wave_max(float v) {
#pragma unroll
    for (int o = 1; o < 64; o <<= 1) v = fmaxf(v, __shfl_xor(v, o));
    return v;
}
__device__ __forceinline__ float rstd_row(const u64* rsq, int row) {
    const u64 v = rsq[row];
    return rsqrtf((float)v * (1.0f / (SSQ_SCALE * (float)D)) + EPS);
}
__device__ __forceinline__ float sigmoidf_(float x) { return 1.0f / (1.0f + __expf(-x)); }

struct EpiUp {
    static constexpr bool PERM = true, MID = false; static constexpr int MID_T0 = -1, MID_T1 = -1;
    bf16* act; const u64* rsq;
    __device__ __forceinline__ void mid(f32x4 (&)[2][2][4][2], const pg8::Unit&, int, int, int, int, int) const {}
    __device__ __forceinline__ void operator()(const f32x4 (&acc)[2][2][4][2], const pg8::Unit& u, int wr, int wc, int fr, int fq) const {
        const int row0 = u.pm * 256 + wr * 64 + fr, col0 = u.pn * 128 + wc * 32 + 8 * fq;
#pragma unroll
        for (int ai = 0; ai < 2; ++ai)
#pragma unroll
            for (int m = 0; m < 4; ++m) {
                const int row = row0 + ai * 128 + m * 16; const float rs = rstd_row(rsq, row);
                float o[8];
#pragma unroll
                for (int n = 0; n < 2; ++n)
#pragma unroll
                    for (int j = 0; j < 4; ++j) { const float gt = acc[ai][0][m][n][j] * rs, up = acc[ai][1][m][n][j] * rs; o[4 * n + j] = gt * sigmoidf_(gt) * up; }
                u32x4 w; w.x = pg8::cvt_pk_bf16(o[0], o[1]); w.y = pg8::cvt_pk_bf16(o[2], o[3]); w.z = pg8::cvt_pk_bf16(o[4], o[5]); w.w = pg8::cvt_pk_bf16(o[6], o[7]);
                *(u32x4*)(act + (size_t)row * FF + col0) = w;
            }
    }
};
template <int HALFSC> struct EpiRes {
    static constexpr bool PERM = true, MID = false; static constexpr int MID_T0 = -1, MID_T1 = -1;
    float* x; bf16* xb; u64* rsq_next;
    __device__ __forceinline__ void mid(f32x4 (&)[2][2][4][2], const pg8::Unit&, int, int, int, int, int) const {}
    __device__ __forceinline__ void operator()(const f32x4 (&acc)[2][2][4][2], const pg8::Unit& u, int wr, int wc, int fr, int fq) const {
        const float sc = HALFSC ? 0.5f : 1.0f;
        const int row0 = u.pm * 256 + wr * 64 + fr, col0 = u.pn * 256 + wc * 32 + 8 * fq;
#pragma unroll
        for (int ai = 0; ai < 2; ++ai)
#pragma unroll
            for (int m = 0; m < 4; ++m) {
                const int row = row0 + ai * 128 + m * 16; float ssq = 0.f;
#pragma unroll
                for (int bj = 0; bj < 2; ++bj) {
                    float* p = x + (size_t)row * D + col0 + bj * 128;
                    f32x4 a = *(const f32x4*)p, b = *(const f32x4*)(p + 4);
                    a = a + acc[ai][bj][m][0] * sc; b = b + acc[ai][bj][m][1] * sc;
                    *(f32x4*)p = a; *(f32x4*)(p + 4) = b;
                    ssq += (a[0] * a[0] + a[1] * a[1]) + (a[2] * a[2] + a[3] * a[3]) + (b[0] * b[0] + b[1] * b[1]) + (b[2] * b[2] + b[3] * b[3]);
                    u32x4 w; w.x = pg8::cvt_pk_bf16(a[0], a[1]); w.y = pg8::cvt_pk_bf16(a[2], a[3]); w.z = pg8::cvt_pk_bf16(b[0], b[1]); w.w = pg8::cvt_pk_bf16(b[2], b[3]);
                    *(u32x4*)(xb + (size_t)row * D + col0 + bj * 128) = w;
                }
                ssq += __shfl_xor(ssq, 16); ssq += __shfl_xor(ssq, 32);
                if (fq == 0) __hip_atomic_fetch_add(rsq_next + row, (u64)(ssq * SSQ_SCALE), __ATOMIC_RELAXED, __HIP_MEMORY_SCOPE_AGENT);
            }
    }
};
struct EpiIn {
    static constexpr bool PERM = true, MID = false; static constexpr int MID_T0 = -1, MID_T1 = -1;
    unsigned char* ws; const u64* rsq;
    __device__ __forceinline__ void mid(f32x4 (&)[2][2][4][2], const pg8::Unit&, int, int, int, int, int) const {}
    __device__ __forceinline__ void operator()(const f32x4 (&acc)[2][2][4][2], const pg8::Unit& u, int wr, int wc, int fr, int fq) const {
        const int c = u.pn; size_t off; int ldc, lc; bool gate = false;
        if (c < 6) { off = WS_QA; ldc = 1536; lc = c; } else if (c < 12) { off = WS_KA; ldc = 1536; lc = c - 6; } else if (c < 18) { off = WS_VA; ldc = 1536; lc = c - 12; }
        else if (c < 22) { off = WS_QB; ldc = 1024; lc = c - 18; } else if (c == 22) { off = WS_KB; ldc = 256; lc = 0; } else if (c == 23) { off = WS_VB; ldc = 256; lc = 0; }
        else if (c < 28) { off = WS_QC; ldc = 1024; lc = c - 24; } else if (c < 32) { off = WS_KC; ldc = 1024; lc = c - 28; } else if (c < 36) { off = WS_VC; ldc = 1024; lc = c - 32; }
        else { off = WS_G; ldc = 6144; lc = c - 36; gate = true; }
        bf16* dst = (bf16*)(ws + off);
        const int row0 = u.pm * 256 + wr * 64 + fr, col0 = lc * 256 + wc * 32 + 8 * fq;
#pragma unroll
        for (int ai = 0; ai < 2; ++ai)
#pragma unroll
            for (int m = 0; m < 4; ++m) {
                const int row = row0 + ai * 128 + m * 16; const float rs = rstd_row(rsq, row);
#pragma unroll
                for (int bj = 0; bj < 2; ++bj) {
                    f32x4 a = acc[ai][bj][m][0] * rs, b = acc[ai][bj][m][1] * rs;
                    if (gate) {
#pragma unroll
                        for (int j = 0; j < 4; ++j) { a[j] = fmaxf(sigmoidf_(a[j]), 1e-30f); b[j] = fmaxf(sigmoidf_(b[j]), 1e-30f); }
                    }
                    u32x4 w; w.x = pg8::cvt_pk_bf16(a[0], a[1]); w.y = pg8::cvt_pk_bf16(a[2], a[3]); w.z = pg8::cvt_pk_bf16(b[0], b[1]); w.w = pg8::cvt_pk_bf16(b[2], b[3]);
                    *(u32x4*)(dst + (size_t)row * ldc + col0 + bj * 128) = w;
                }
            }
    }
};
struct EpiBr {
    static constexpr bool PERM = true, MID = true; static constexpr int MID_T0 = 8, MID_T1 = 24;
    const bf16* G; bf16* z;
    __device__ __forceinline__ void mid(f32x4 (&acc)[2][2][4][2], const pg8::Unit& u, int t, int wr, int wc, int fr, int fq) const {
        const bf16* ga = G + (t == MID_T0 ? 0 : 2048);
        int frx = fr, fqx = fq; asm volatile("" : "+v"(frx), "+v"(fqx));
        const int row0 = u.pm * 256 + wr * 64 + frx, col0 = u.pn * 256 + wc * 32 + 8 * fqx;
#pragma unroll
        for (int ai = 0; ai < 2; ++ai)
#pragma unroll
            for (int m = 0; m < 4; ++m) {
                const int row = row0 + ai * 128 + m * 16;
#pragma unroll
                for (int bj = 0; bj < 2; ++bj) {
                    const bf16* p = ga + (size_t)row * 6144 + col0 + bj * 128;
                    const u32x4 na = *(const u32x4*)p, nb = *(const u32x4*)(p + 2048);
#pragma unroll
                    for (int j = 0; j < 2; ++j) {
                        acc[ai][bj][m][0][2 * j]     *= bf_lo(na[j]) / bf_lo(nb[j]);
                        acc[ai][bj][m][0][2 * j + 1] *= bf_hi(na[j]) / bf_hi(nb[j]);
                        acc[ai][bj][m][1][2 * j]     *= bf_lo(na[2 + j]) / bf_lo(nb[2 + j]);
                        acc[ai][bj][m][1][2 * j + 1] *= bf_hi(na[2 + j]) / bf_hi(nb[2 + j]);
                    }
                    asm volatile("" : "+v"(acc[ai][bj][m][0]), "+v"(acc[ai][bj][m][1]) :: "memory");
                }
            }
    }
    __device__ __forceinline__ void operator()(const f32x4 (&acc)[2][2][4][2], const pg8::Unit& u, int wr, int wc, int fr, int fq) const {
        const int row0 = u.pm * 256 + wr * 64 + fr, col0 = u.pn * 256 + wc * 32 + 8 * fq;
#pragma unroll
        for (int ai = 0; ai < 2; ++ai)
#pragma unroll
            for (int m = 0; m < 4; ++m) {
                const int row = row0 + ai * 128 + m * 16;
#pragma unroll
                for (int bj = 0; bj < 2; ++bj) {
                    const u32x4 ng = *(const u32x4*)(G + (size_t)row * 6144 + 4096 + col0 + bj * 128);
                    const f32x4 a = acc[ai][bj][m][0], b = acc[ai][bj][m][1];
                    u32x4 w; w.x = pg8::cvt_pk_bf16(a[0] * bf_lo(ng[0]), a[1] * bf_hi(ng[0])); w.y = pg8::cvt_pk_bf16(a[2] * bf_lo(ng[1]), a[3] * bf_hi(ng[1]));
                    w.z = pg8::cvt_pk_bf16(b[0] * bf_lo(ng[2]), b[1] * bf_hi(ng[2])); w.w = pg8::cvt_pk_bf16(b[2] * bf_lo(ng[3]), b[3] * bf_hi(ng[3]));
                    *(u32x4*)(z + (size_t)row * D + col0 + bj * 128) = w;
                }
            }
    }
};

__device__ __forceinline__ void cvt_item(const float* __restrict__ W, int N, const float* __restrict__ scale, bf16* dst, int dpitch, int dcol, int mode, int kb, int nb, LAS unsigned* T, int lane) {
    const int k0 = kb * 64, n0 = nb * 64, kpl = lane >> 4, n4 = (lane & 15) * 4;
    f32x4 r0[8], r1[8];
#pragma unroll
    for (int i = 0; i < 8; ++i) { const int k = k0 + 2 * (4 * i + kpl); r0[i] = *(const f32x4*)(W + (size_t)k * N + n0 + n4); r1[i] = *(const f32x4*)(W + (size_t)(k + 1) * N + n0 + n4); }
#pragma unroll
    for (int i = 0; i < 8; ++i) { const int kp = 4 * i + kpl, k = k0 + 2 * kp; const float s0 = scale ? scale[k] : 1.f, s1 = scale ? scale[k + 1] : 1.f;
#pragma unroll
        for (int j = 0; j < 4; ++j) T[(n4 + j) * 33 + kp] = pk2(r0[i][j] * s0, r1[i][j] * s1); }
    LDS_WAIT(); asm volatile("" ::: "memory");
    const int q = lane & 7;
#pragma unroll
    for (int i = 0; i < 8; ++i) { const int n = 8 * i + (lane >> 3); const LAS unsigned* s = T + n * 33 + 4 * q;
        u32x4 o; o.x = s[0]; o.y = s[1]; o.z = s[2]; o.w = s[3];
        const int c = n0 + n; int drow = c;
        if (mode == 1) { drow = (c < FF) ? (256 * (c >> 7) + (c & 127)) : (256 * ((c - FF) >> 7) + 128 + ((c - FF) & 127)); }
        *(u32x4*)(dst + (size_t)drow * dpitch + dcol + k0 + 8 * q) = o; }
    LDS_WAIT(); asm volatile("" ::: "memory");
}

struct Args { const float* in[18]; float* out; unsigned char* ws; int ph_lo, ph_hi; };
typedef const __attribute__((address_space(4))) Args* KArgs;

__device__ __forceinline__ void prologue(KArgs a, LAS unsigned char* lds, int gw, int NGW, int wave, int lane) {
    LAS unsigned* T = (LAS unsigned*)(lds + wave * 16384);
    constexpr int I0 = 32 * 176, I1 = 88 * 32, I2 = 32 * 240, I3 = 8 * 32, I4 = 16 * 32, I5 = 16 * 32, I6 = 32 * 32, PER = 2 * I0 + 2 * I1 + I2 + I3 + I4 + I5 + I6;
    for (int it = gw; it < DEPTH * PER; it += NGW) {
        const int l = it / PER; int r = it % PER; unsigned char* wl = a->ws + WS_W + (size_t)l * W_LAYER;
        if (r < I0) { cvt_item(a->in[4] + (size_t)l * D * 2 * FF, 2 * FF, a->in[3] + l * D, (bf16*)(wl + W_1A), D, 0, 1, r / 176, r % 176, T, lane); continue; } r -= I0;
        if (r < I1) { cvt_item(a->in[5] + (size_t)l * FF * D, D, nullptr, (bf16*)(wl + W_1B), FF, 0, 0, r / 32, r % 32, T, lane); continue; } r -= I1;
        if (r < I2) { cvt_item(a->in[7] + (size_t)l * D * NIN, NIN, a->in[6] + l * D, (bf16*)(wl + W_IN), D, 0, 0, r / 240, r % 240, T, lane); continue; } r -= I2;
        if (r < I3) { cvt_item(a->in[11] + (size_t)l * 512 * D, D, nullptr, (bf16*)(wl + W_BR), KBR, 0, 0, r / 32, r % 32, T, lane); continue; } r -= I3;
        if (r < I4) { cvt_item(a->in[12] + (size_t)l * 1024 * D, D, nullptr, (bf16*)(wl + W_BR), KBR, 512, 0, r / 32, r % 32, T, lane); continue; } r -= I4;
        if (r < I5) { cvt_item(a->in[13] + (size_t)l * 1024 * D, D, nullptr, (bf16*)(wl + W_BR), KBR, 1536, 0, r / 32, r % 32, T, lane); continue; } r -= I5;
        if (r < I6) { cvt_item(a->in[14] + (size_t)l * D * D, D, nullptr, (bf16*)(wl + W_O), D, 0, 0, r / 32, r % 32, T, lane); continue; } r -= I6;
        if (r < I0) { cvt_item(a->in[16] + (size_t)l * D * 2 * FF, 2 * FF, a->in[15] + l * D, (bf16*)(wl + W_2A), D, 0, 1, r / 176, r % 176, T, lane); continue; } r -= I0;
        cvt_item(a->in[17] + (size_t)l * FF * D, D, nullptr, (bf16*)(wl + W_2B), FF, 0, 0, r / 32, r % 32, T, lane);
    }
    u64* rsq0 = (u64*)(a->ws + WS_RSQ); bf16* xb = (bf16*)(a->ws + WS_XB);
    for (int row = gw; row < M; row += NGW) {
        const float* src = row < 8192 ? a->in[0] + (size_t)row * D : a->in[1] + (size_t)(row - 8192) * D;
        f32x4 v[8]; float s = 0.f;
#pragma unroll
        for (int j = 0; j < 8; ++j) { v[j] = *(const f32x4*)(src + 256 * j + 4 * lane); s += (v[j][0] * v[j][0] + v[j][1] * v[j][1]) + (v[j][2] * v[j][2] + v[j][3] * v[j][3]); }
#pragma unroll
        for (int j = 0; j < 8; ++j) { *(f32x4*)(a->out + (size_t)row * D + 256 * j + 4 * lane) = v[j];
            u32x2 w; w.x = pk2(v[j][0], v[j][1]); w.y = pk2(v[j][2], v[j][3]); *(u32x2*)(xb + (size_t)row * D + 256 * j + 4 * lane) = w; }
        s = wave_sum(s);
        if (lane == 0) rsq0[row] = (u64)(s * SSQ_SCALE);
    }
}

__device__ __forceinline__ int t5_bucket_dev(int rel) {
    const int n = rel < 0 ? -rel : rel; int b;
    if (n < 8) b = n; else b = 8 + (n >= 15) + (n >= 27) + (n >= 50) + (n >= 91) + (n >= 166) + (n >= 305) + (n >= 559);
    return b + (rel > 0 ? 16 : 0);
}
__device__ __forceinline__ void seq_of(int row, int& base, int& L) { if (row < 8192) { base = 0; L = 8192; } else if (row < 12288) { base = 8192; L = 4096; } else { base = 12288; L = 4096; } }

__device__ __forceinline__ void qknorm_phase(unsigned char* ws, const float* qk_norm, int l, int gw, int NGW, int lane) {
    const float* qkg = qk_norm + (size_t)l * 6 * 128;
    for (int it = gw; it < M * 50; it += NGW) {
        const int row = it / 50, s = it % 50; size_t off; int ldc, h, gi;
        if (s < 12) { off = WS_QA; ldc = 1536; h = s; gi = 0; } else if (s < 24) { off = WS_KA; ldc = 1536; h = s - 12; gi = 1; }
        else if (s < 32) { off = WS_QB; ldc = 1024; h = s - 24; gi = 2; } else if (s < 34) { off = WS_KB; ldc = 256; h = s - 32; gi = 3; }
        else if (s < 42) { off = WS_QC; ldc = 1024; h = s - 34; gi = 4; } else { off = WS_KC; ldc = 1024; h = s - 42; gi = 5; }
        unsigned* p = (unsigned*)((bf16*)(ws + off) + (size_t)row * ldc + h * 128) + lane;
        const unsigned w = *p; const float v0 = bf_lo(w), v1 = bf_hi(w);
        const float ss = wave_sum(v0 * v0 + v1 * v1);
        const float r = rsqrtf(ss * (1.0f / 128.0f) + EPS);
        *p = pk2(v0 * r * qkg[gi * 128 + 2 * lane], v1 * r * qkg[gi * 128 + 2 * lane + 1]);
    }
}

__device__ __forceinline__ void attn_naive_phase(unsigned char* ws, const float* relb, const float* sink_all, const float* rpb_all, int l, LAS unsigned char* lds, int gw, int NGW, int wave, int lane) {
    LAS unsigned char* tab = lds + 8192;
    for (int n = wave * 64 + lane; n <= 1024; n += NWAVES * 64) tab[n] = (unsigned char)t5_bucket_dev(-n);
    __syncthreads();
    LAS float* pl = (LAS float*)(lds + wave * 16384); LAS int* tl = (LAS int*)(lds + wave * 16384 + 2048);
    const float* sink = sink_all + l * 8; const float* rpb = rpb_all + (size_t)l * 8 * 15 * 31;
    for (int it = gw; it < 28 * M; it += NGW) {
        const int h28 = it / M, row = it % M; int base, L; seq_of(row, base, L); const int t = row - base;
        if ((FAST_MASK >> (h28 < 12 ? 0 : (h28 < 20 ? 1 : 2))) & 1) continue;
        const bf16 *Q, *Kp, *Vp; int ldq, ldk, qoff, koff, nslots, type, g = 0, hh = 0, d = 1;
        if (h28 < 12) { type = 0; g = h28 >> 2; hh = h28 & 3; d = (g == 0) ? 1 : (g == 1 ? 4 : 16); Q = (const bf16*)(ws + WS_QA); Kp = (const bf16*)(ws + WS_KA); Vp = (const bf16*)(ws + WS_VA); ldq = 1536; ldk = 1536; qoff = h28 * 128; koff = h28 * 128; nslots = 129; }
        else if (h28 < 20) { type = 1; hh = h28 - 12; Q = (const bf16*)(ws + WS_QB); Kp = (const bf16*)(ws + WS_KB); Vp = (const bf16*)(ws + WS_VB); ldq = 1024; ldk = 256; qoff = hh * 128; koff = (hh >> 2) * 128; nslots = 257; }
        else { type = 2; hh = h28 - 20; Q = (const bf16*)(ws + WS_QC); Kp = (const bf16*)(ws + WS_KC); Vp = (const bf16*)(ws + WS_VC); ldq = 1024; ldk = 1024; qoff = hh * 128; koff = hh * 128; nslots = 128; }
        const int rows = L >> 6, r = t >> 6, c = t & 63; int rs = r - 4; rs = rs < 0 ? 0 : (rs > rows - 8 ? rows - 8 : rs); int qs = c - 8; qs = qs < 0 ? 0 : (qs > 48 ? 48 : qs);
        const bf16* qp = Q + (size_t)row * ldq + qoff;
        float mx = -1e30f;
#pragma unroll 1
        for (int j = lane; j < nslots; j += 64) {
            bool valid = true; int tk = t; float bias = 0.f;
            if (type == 0) { const int rel = (j - 64) * d; tk = t + rel; valid = tk >= 0 && tk < L; const int n = rel < 0 ? -rel : rel; bias = relb[((int)tab[n] + (rel > 0 ? 16 : 0)) * 20 + h28]; }
            else if (type == 1) { const int rel = j - 128; tk = t + rel; valid = tk >= 0 && tk < L; const int n = rel < 0 ? -rel : rel; bias = relb[((int)tab[n] + (rel > 0 ? 16 : 0)) * 20 + 12 + hh]; }
            else { const int kr = rs + (j >> 4), kc = qs + (j & 15); tk = kr * 64 + kc; bias = rpb[(hh * 15 + (kr - r + 7)) * 31 + (kc - c + 15)]; }
            if (!valid) tk = t;
            float dot = 0.f; const bf16* kp = Kp + (size_t)(base + tk) * ldk + koff;
#pragma unroll 4
            for (int ch = 0; ch < 16; ++ch) { const u32x4 kv = *(const u32x4*)(kp + 8 * ch); const u32x4 qv = *(const u32x4*)(qp + 8 * ch);
#pragma unroll
                for (int e = 0; e < 4; ++e) dot += bf_lo(qv[e]) * bf_lo(kv[e]) + bf_hi(qv[e]) * bf_hi(kv[e]); }
            const float sc = valid ? dot * 0.08838834764831845f + bias : -1e30f;
            mx = fmaxf(mx, sc);
            pl[j] = sc; tl[j] = tk;
        }
        mx = wave_max(mx);
        if (type == 1) mx = fmaxf(mx, sink[hh]);
        float den = 0.f;
#pragma unroll 1
        for (int j = lane; j < nslots; j += 64) { const float sc = pl[j]; const float p = (sc > -1e29f) ? __expf(sc - mx) : 0.f; den += p; pl[j] = p; }
        den = wave_sum(den);
        if (type == 1) den += __expf(sink[hh] - mx);
        LDS_WAIT(); asm volatile("" ::: "memory");
        float o0 = 0.f, o1 = 0.f;
#pragma unroll 4
        for (int j = 0; j < nslots; ++j) { const float p = pl[j]; const int tk = tl[j];
            const unsigned w = *(const unsigned*)(Vp + (size_t)(base + tk) * ldk + koff + 2 * lane); o0 += p * bf_lo(w); o1 += p * bf_hi(w); }
        const float inv = 1.0f / den; o0 *= inv; o1 *= inv;
        if (type == 0) { *(unsigned*)((bf16*)(ws + WS_OAG) + ((size_t)g * M + row) * 512 + hh * 128 + 2 * lane) = pk2(o0, o1);
            if (lane == 0) ((float*)(ws + WS_LSE))[((size_t)g * M + row) * 4 + hh] = mx + __logf(den); }
        else { *(unsigned*)((bf16*)(ws + WS_O) + (size_t)row * KBR + (type == 1 ? 512 : 1536) + hh * 128 + 2 * lane) = pk2(o0, o1); }
        LDS_WAIT(); asm volatile("" ::: "memory");
    }
}
__device__ __forceinline__ void combine_phase(unsigned char* ws, int gw, int NGW, int lane) {
    const float* lse = (const float*)(ws + WS_LSE); const bf16* oag = (const bf16*)(ws + WS_OAG); bf16* O = (bf16*)(ws + WS_O);
    for (int it = gw; it < M * 4; it += NGW) {
        const int row = it >> 2, hh = it & 3;
        const float l0 = lse[((size_t)0 * M + row) * 4 + hh], l1 = lse[((size_t)1 * M + row) * 4 + hh], l2 = lse[((size_t)2 * M + row) * 4 + hh];
        const float mx = fmaxf(l0, fmaxf(l1, l2)); float w0 = __expf(l0 - mx), w1 = __expf(l1 - mx), w2 = __expf(l2 - mx); const float inv = 1.0f / (w0 + w1 + w2); w0 *= inv; w1 *= inv; w2 *= inv;
        const unsigned a0 = *(const unsigned*)(oag + ((size_t)0 * M + row) * 512 + hh * 128 + 2 * lane), a1 = *(const unsigned*)(oag + ((size_t)1 * M + row) * 512 + hh * 128 + 2 * lane), a2 = *(const unsigned*)(oag + ((size_t)2 * M + row) * 512 + hh * 128 + 2 * lane);
        *(unsigned*)(O + (size_t)row * KBR + hh * 128 + 2 * lane) = pk2(w0 * bf_lo(a0) + w1 * bf_lo(a1) + w2 * bf_lo(a2), w0 * bf_hi(a0) + w1 * bf_hi(a1) + w2 * bf_hi(a2));
    }
}

__device__ __forceinline__ int vcu_of() { const int G = gridDim.x, bx = blockIdx.x; return (G % 8 == 0) ? (bx % 8) * (G / 8) + bx / 8 : bx; }
__device__ __forceinline__ int tid_of(int wave_s) { int t = wave_s * 64 + (int)__builtin_amdgcn_mbcnt_hi(~0u, __builtin_amdgcn_mbcnt_lo(~0u, 0u)); asm volatile("" : "+v"(t)); return t; }
typedef short v4i16_t __attribute__((ext_vector_type(4)));
typedef pg8::bf16x8 bf16x8;
constexpr int AT_TAB_OFF = RING_BYTES + 512;
constexpr int AT_BIAS_OFF = RING_BYTES + 2048;
static_assert(AT_BIAS_OFF + 1152 * 4 <= LDS_BYTES, "attention LDS map");
__device__ __forceinline__ unsigned off_b(unsigned row, unsigned ch) { return 256u * row + 16u * (ch ^ (((row & 3u) << 2) | ((row >> 2) & 3u))); }
__device__ __forceinline__ int clampi(int v, int lo, int hi) { return v < lo ? lo : (v > hi ? hi : v); }

struct TokLin { int base, pos0, d, r, lim; __device__ __forceinline__ bool operator()(int s, int& row) const { const int p = pos0 + s; row = base + p * d + r; return p >= 0 && p < lim; } };
struct TokGrid { int base, rlo, cs; __device__ __forceinline__ bool operator()(int s, int& row) const { row = base + (rlo + (s >> 5)) * 64 + cs + (s & 31); return true; } };

template <int NPASS, bool NORM, class TokF>
__device__ __forceinline__ void stage_slots(LAS unsigned char* lds, const bf16* P, int ld, int npass, const float* gain, int tid, const TokF tokf) {
    const int ch = tid & 15, sl = tid >> 4;
    u32x4 v[NPASS];
#pragma unroll
    for (int i = 0; i < NPASS; ++i) { v[i] = (u32x4){0u, 0u, 0u, 0u}; if (i < npass) { int row; const bool ok = tokf(sl + 32 * i, row); row = ok ? row : tokf.base;
            const u32x4 t = *(const u32x4*)(P + (size_t)row * ld + 8 * ch); v[i].x = ok ? t.x : 0u; v[i].y = ok ? t.y : 0u; v[i].z = ok ? t.z : 0u; v[i].w = ok ? t.w : 0u; } }
    float gn[8];
    if (NORM) { const f32x4 a = *(const f32x4*)(gain + 8 * ch), b = *(const f32x4*)(gain + 8 * ch + 4); gn[0] = a[0]; gn[1] = a[1]; gn[2] = a[2]; gn[3] = a[3]; gn[4] = b[0]; gn[5] = b[1]; gn[6] = b[2]; gn[7] = b[3]; }
#pragma unroll
    for (int i = 0; i < NPASS; ++i) if (i < npass) {
        u32x4 w = v[i];
        if (NORM) {
            float f[8]; float ss = 0.f;
#pragma unroll
            for (int e = 0; e < 4; ++e) { f[2 * e] = bf_lo(w[e]); f[2 * e + 1] = bf_hi(w[e]); ss += f[2 * e] * f[2 * e] + f[2 * e + 1] * f[2 * e + 1]; }
            ss += __shfl_xor(ss, 1); ss += __shfl_xor(ss, 2); ss += __shfl_xor(ss, 4); ss += __shfl_xor(ss, 8);
            const float rs = rsqrtf(ss * (1.0f / 128.0f) + EPS);
#pragma unroll
            for (int e = 0; e < 4; ++e) w[e] = pg8::cvt_pk_bf16(f[2 * e] * rs * gn[2 * e], f[2 * e + 1] * rs * gn[2 * e + 1]);
        }
        *(LAS u32x4*)(lds + off_b((unsigned)(sl + 32 * i), (unsigned)ch)) = w;
    }
}
template <bool NORM>
__device__ __forceinline__ void load_qfrags(const bf16* qrow, const float* gq, int g4, bf16x8 (&qf)[4]) {
    u32x4 raw[4];
#pragma unroll
    for (int ks = 0; ks < 4; ++ks) raw[ks] = *(const u32x4*)(qrow + 32 * ks + 8 * g4);
    if (NORM) {
        float ss = 0.f;
#pragma unroll
        for (int ks = 0; ks < 4; ++ks)
#pragma unroll
            for (int e = 0; e < 4; ++e) { const float a = bf_lo(raw[ks][e]), b = bf_hi(raw[ks][e]); ss += a * a + b * b; }
        ss += __shfl_xor(ss, 16); ss += __shfl_xor(ss, 32);
        const float rs = rsqrtf(ss * (1.0f / 128.0f) + EPS);
#pragma unroll
        for (int ks = 0; ks < 4; ++ks) { const f32x4 ga = *(const f32x4*)(gq + 32 * ks + 8 * g4), gb = *(const f32x4*)(gq + 32 * ks + 8 * g4 + 4);
            raw[ks][0] = pg8::cvt_pk_bf16(bf_lo(raw[ks][0]) * rs * ga[0], bf_hi(raw[ks][0]) * rs * ga[1]); raw[ks][1] = pg8::cvt_pk_bf16(bf_lo(raw[ks][1]) * rs * ga[2], bf_hi(raw[ks][1]) * rs * ga[3]);
            raw[ks][2] = pg8::cvt_pk_bf16(bf_lo(raw[ks][2]) * rs * gb[0], bf_hi(raw[ks][2]) * rs * gb[1]); raw[ks][3] = pg8::cvt_pk_bf16(bf_lo(raw[ks][3]) * rs * gb[2], bf_hi(raw[ks][3]) * rs * gb[3]); }
    }
#pragma unroll
    for (int ks = 0; ks < 4; ++ks) qf[ks] = __builtin_bit_cast(bf16x8, raw[ks]);
}
template <int NT>
__device__ __forceinline__ void st_tiles(LAS unsigned char* lds, int slot0, const bf16x8 (&qf)[4], int lane, f32x4 (&S)[NT]) {
    const unsigned i = lane & 15, g4 = lane >> 4;
    unsigned ko[4];
#pragma unroll
    for (int ks = 0; ks < 4; ++ks) ko[ks] = off_b(i, 4u * ks + g4);
    LAS unsigned char* base = lds + 256 * slot0;
#pragma unroll
    for (int kk = 0; kk < NT; ++kk) {
        f32x4 acc = (f32x4){0.f, 0.f, 0.f, 0.f};
#pragma unroll
        for (int ks = 0; ks < 4; ++ks) { const bf16x8 a = *(const LAS bf16x8*)(base + 4096 * kk + ko[ks]); acc = __builtin_amdgcn_mfma_f32_16x16x32_bf16(a, qf[ks], acc, 0, 0, 0); }
        S[kk] = acc;
    }
}
template <int NT>
__device__ __forceinline__ void softmax_pack(f32x4 (&S)[NT], float extra, bf16x8 (&P)[(NT + 1) / 2], float& inv_l, float& lse) {
    float m = extra;
#pragma unroll
    for (int kk = 0; kk < NT; ++kk) m = fmaxf(m, fmaxf(fmaxf(S[kk][0], S[kk][1]), fmaxf(S[kk][2], S[kk][3])));
    m = fmaxf(m, __shfl_xor(m, 16)); m = fmaxf(m, __shfl_xor(m, 32));
    float l = 0.f;
#pragma unroll
    for (int kk = 0; kk < NT; ++kk)
#pragma unroll
        for (int r = 0; r < 4; ++r) { const float p = __expf(S[kk][r] - m); S[kk][r] = p; l += p; }
    l += __shfl_xor(l, 16); l += __shfl_xor(l, 32);
    l += __expf(extra - m);
    inv_l = 1.0f / l; lse = m + __logf(l);
#pragma unroll
    for (int s = 0; s < (NT + 1) / 2; ++s) {
        u32x4 w; w.x = pg8::cvt_pk_bf16(S[2 * s][0], S[2 * s][1]); w.y = pg8::cvt_pk_bf16(S[2 * s][2], S[2 * s][3]);
        if (2 * s + 1 < NT) { w.z = pg8::cvt_pk_bf16(S[2 * s + 1][0], S[2 * s + 1][1]); w.w = pg8::cvt_pk_bf16(S[2 * s + 1][2], S[2 * s + 1][3]); } else { w.z = 0u; w.w = 0u; }
        P[s] = __builtin_bit_cast(bf16x8, w);
    }
}
template <int NT>
__device__ __forceinline__ void pv_tile(LAS unsigned char* lds, int slot0, const bf16x8 (&P)[(NT + 1) / 2], int lane, f32x4 (&O)[8]) {
    const unsigned g4 = lane >> 4, qq = (lane & 15) >> 2, p = lane & 3, rl = 4 * g4 + qq;
    unsigned vo[8];
#pragma unroll
    for (int c = 0; c < 8; ++c) vo[c] = off_b(rl, 2u * c + (p >> 1)) + 8u * (p & 1);
    LAS unsigned char* base = lds + 256 * slot0;
#pragma unroll
    for (int c = 0; c < 8; ++c) O[c] = (f32x4){0.f, 0.f, 0.f, 0.f};
#pragma unroll
    for (int s = 0; s < (NT + 1) / 2; ++s) {
        const int t0 = 2 * s, t1 = (2 * s + 1 < NT) ? 2 * s + 1 : NT - 1;
#pragma unroll
        for (int c = 0; c < 8; ++c) {
            const v4i16_t lo = __builtin_amdgcn_ds_read_tr16_b64_v4i16((LAS v4i16_t*)(base + 4096 * t0 + vo[c]));
            const v4i16_t hi = __builtin_amdgcn_ds_read_tr16_b64_v4i16((LAS v4i16_t*)(base + 4096 * t1 + vo[c]));
            const bf16x8 a = __builtin_shufflevector(lo, hi, 0, 1, 2, 3, 4, 5, 6, 7);
            O[c] = __builtin_amdgcn_mfma_f32_16x16x32_bf16(a, P[s], O[c], 0, 0, 0);
        }
    }
}
__device__ __forceinline__ void store_o(bf16* orow, const f32x4 (&O)[8], float inv_l, int g4) {
#pragma unroll
    for (int c = 0; c < 8; ++c) { u32x2 w; w.x = pg8::cvt_pk_bf16(O[c][0] * inv_l, O[c][1] * inv_l); w.y = pg8::cvt_pk_bf16(O[c][2] * inv_l, O[c][3] * inv_l); *(u32x2*)(orow + 16 * c + 4 * g4) = w; }
}

constexpr float QK_SCALE = 0.08838834764831845f;
constexpr int NU_A = 1536, NU_B = 512, NU_C = 1024;

__device__ __forceinline__ void attn_unit_A(unsigned char* ws, const float* relb, const float* qkg, LAS unsigned char* lds, int u, int wave_s) {
    const int tid = tid_of(wave_s);
    const int lane = tid & 63, wave = __builtin_amdgcn_readfirstlane(tid >> 6), q = lane & 15, g4 = lane >> 4;
    const int part = u >= 768, uu = part ? u - 768 : u, head12 = uu >> 6; int rem = uu & 63;
    const int g = head12 >> 2, hh = head12 & 3, d = (g == 0) ? 1 : (g == 1 ? 4 : 16);
    int base = 0, L = 8192, nbq = 64 / d;
    if (part) { const int seq = rem >> 5; rem &= 31; base = 8192 + 4096 * seq; L = 4096; nbq = 32 / d; }
    const int r = rem / nbq, qb = rem % nbq, Ls = L / d, pos0 = 128 * qb - 64;
    LAS float* bv = (LAS float*)(lds + AT_BIAS_OFF); LAS unsigned char* tab = lds + AT_TAB_OFF;
    if (tid < 160) { const int dl = tid - 80; float b = 0.f; if (dl >= -64 && dl <= 64) { const int rel = dl * d, n = rel < 0 ? -rel : rel; b = relb[((int)tab[n] + (rel > 0 ? 16 : 0)) * 20 + head12]; } bv[tid] = b; }
    const TokLin tokf{base, pos0, d, r, Ls};
    stage_slots<8, NORM_ON_LOAD != 0>(lds, (const bf16*)(ws + WS_KA) + head12 * 128, 1536, 8, qkg + 128, tid, tokf);
    __syncthreads();
    const int qrow = base + (128 * qb + 16 * wave + q) * d + r;
    bf16x8 qf[4]; load_qfrags<NORM_ON_LOAD != 0>((const bf16*)(ws + WS_QA) + (size_t)qrow * 1536 + head12 * 128, qkg, g4, qf);
    f32x4 S[9]; st_tiles<9>(lds, 16 * wave, qf, lane, S);
    const LAS float* bvq = bv + (4 * g4 - q + 16);
#pragma unroll
    for (int kk = 0; kk < 9; ++kk)
#pragma unroll
        for (int rr = 0; rr < 4; ++rr) {
            const int delta = 16 * kk + 4 * g4 + rr - q - 64, p = pos0 + 16 * (wave + kk) + 4 * g4 + rr;
            const bool ok = delta >= -64 && delta <= 64 && p >= 0 && p < Ls;
            S[kk][rr] = ok ? S[kk][rr] * QK_SCALE + bvq[16 * kk + rr] : -1e30f;
        }
    bf16x8 P[5]; float inv_l, lse; softmax_pack<9>(S, -1e30f, P, inv_l, lse);
    __syncthreads();
    stage_slots<8, false>(lds, (const bf16*)(ws + WS_VA) + head12 * 128, 1536, 8, nullptr, tid, tokf);
    __syncthreads();
    f32x4 O[8]; pv_tile<9>(lds, 16 * wave, P, lane, O);
    store_o((bf16*)(ws + WS_OAG) + ((size_t)g * M + qrow) * 512 + hh * 128, O, inv_l, g4);
    if (g4 == 0) ((float*)(ws + WS_LSE))[((size_t)g * M + qrow) * 4 + hh] = lse;
    __syncthreads();
}
__device__ __forceinline__ void attn_unit_B(unsigned char* ws, const float* relb, const float* qkg, const float* sinkl, LAS unsigned char* lds, int u, int wave_s) {
    const int tid = tid_of(wave_s);
    const int lane = tid & 63, wave = __builtin_amdgcn_readfirstlane(tid >> 6), q = lane & 15, g4 = lane >> 4;
    const int part = u >= 256, uu = part ? u - 256 : u, kvh = uu >> 7; const int rem = uu & 127;
    int base = 0, L = 8192, qb = rem;
    if (part) { const int seq = rem >> 6; qb = rem & 63; base = 8192 + 4096 * seq; L = 4096; }
    const int pos0 = 64 * qb - 128, hl = wave & 3, hq = 4 * kvh + hl;
    LAS float* bv = (LAS float*)(lds + AT_BIAS_OFF); LAS unsigned char* tab = lds + AT_TAB_OFF;
    for (int e = tid; e < 1152; e += NWAVES * 64) { const int h = e / 288, dl = e % 288 - 144; float b = 0.f; if (dl >= -128 && dl <= 128) { const int n = dl < 0 ? -dl : dl; b = relb[((int)tab[n] + (dl > 0 ? 16 : 0)) * 20 + 12 + 4 * kvh + h]; } bv[e] = b; }
    const TokLin tokf{base, pos0, 1, 0, L};
    stage_slots<10, NORM_ON_LOAD != 0>(lds, (const bf16*)(ws + WS_KB) + kvh * 128, 256, 10, qkg + 3 * 128, tid, tokf);
    __syncthreads();
    bf16x8 P[2][9]; float inv_l[2]; const float snk = sinkl[hq];
#pragma unroll
    for (int tt = 0; tt < 2; ++tt) {
        const int tq = 2 * (wave >> 2) + tt, qrow = base + 64 * qb + 16 * tq + q;
        bf16x8 qf[4]; load_qfrags<NORM_ON_LOAD != 0>((const bf16*)(ws + WS_QB) + (size_t)qrow * 1024 + hq * 128, qkg + 2 * 128, g4, qf);
        f32x4 S[17]; st_tiles<17>(lds, 16 * tq, qf, lane, S);
        const LAS float* bvq = bv + hl * 288 + (4 * g4 - q + 16);
#pragma unroll
        for (int kk = 0; kk < 17; ++kk)
#pragma unroll
            for (int rr = 0; rr < 4; ++rr) {
                const int delta = 16 * kk + 4 * g4 + rr - q - 128, p = pos0 + 16 * (tq + kk) + 4 * g4 + rr;
                const bool ok = delta >= -128 && delta <= 128 && p >= 0 && p < L;
                S[kk][rr] = ok ? S[kk][rr] * QK_SCALE + bvq[16 * kk + rr] : -1e30f;
            }
        float lse; softmax_pack<17>(S, snk, P[tt], inv_l[tt], lse);
    }
    __syncthreads();
    stage_slots<10, false>(lds, (const bf16*)(ws + WS_VB) + kvh * 128, 256, 10, nullptr, tid, tokf);
    __syncthreads();
#pragma unroll
    for (int tt = 0; tt < 2; ++tt) {
        const int tq = 2 * (wave >> 2) + tt, qrow = base + 64 * qb + 16 * tq + q;
        f32x4 O[8]; pv_tile<17>(lds, 16 * tq, P[tt], lane, O);
        store_o((bf16*)(ws + WS_O) + (size_t)qrow * KBR + 512 + hq * 128, O, inv_l[tt], g4);
    }
    __syncthreads();
}
__device__ __forceinline__ void attn_unit_C(unsigned char* ws, const float* qkg, const float* rpbl, LAS unsigned char* lds, int u, int wave_s) {
    const int tid = tid_of(wave_s);
    const int lane = tid & 63, wave = __builtin_amdgcn_readfirstlane(tid >> 6), q = lane & 15, g4 = lane >> 4;
    const int part = u >= 512, uu = part ? u - 512 : u, h = uu >> 6; int rem = uu & 63;
    int base = 0, rows = 128, cb = rem >> 4, rb = rem & 15;
    if (part) { const int seq = rem >> 5; rem &= 31; base = 8192 + 4096 * seq; rows = 64; cb = rem >> 3; rb = rem & 7; }
    const int r0 = 8 * rb, rlo = clampi(r0 - 4, 0, rows - 8), rhi = clampi(r0 + 3, 0, rows - 8) + 7, nrows = rhi - rlo + 1, cs = clampi(16 * cb - 8, 0, 32);
    LAS float* bv = (LAS float*)(lds + AT_BIAS_OFF);
    if (tid < 465) bv[tid] = rpbl[h * 465 + tid];
    const TokGrid tokf{base, rlo, cs};
    stage_slots<15, NORM_ON_LOAD != 0>(lds, (const bf16*)(ws + WS_KC) + h * 128, 1024, nrows, qkg + 5 * 128, tid, tokf);
    __syncthreads();
    const int r = r0 + wave, rsw = clampi(r - 4, 0, rows - 8), c = 16 * cb + q, qs = clampi(c - 8, 0, 48), qrow = base + r * 64 + c;
    bf16x8 qf[4]; load_qfrags<NORM_ON_LOAD != 0>((const bf16*)(ws + WS_QC) + (size_t)qrow * 1024 + h * 128, qkg + 4 * 128, g4, qf);
    f32x4 S[16]; st_tiles<16>(lds, 32 * (rsw - rlo), qf, lane, S);
#pragma unroll
    for (int kk = 0; kk < 16; ++kk)
#pragma unroll
        for (int rr = 0; rr < 4; ++rr) {
            const int kc = cs + 16 * (kk & 1) + 4 * g4 + rr, dr = rsw + (kk >> 1) - r, dc = kc - c;
            const bool ok = kc >= qs && kc < qs + 16;
            S[kk][rr] = ok ? S[kk][rr] * QK_SCALE + bv[(dr + 7) * 31 + clampi(dc + 15, 0, 30)] : -1e30f;
        }
    bf16x8 P[8]; float inv_l, lse; softmax_pack<16>(S, -1e30f, P, inv_l, lse);
    __syncthreads();
    stage_slots<15, false>(lds, (const bf16*)(ws + WS_VC) + h * 128, 1024, nrows, nullptr, tid, tokf);
    __syncthreads();
    f32x4 O[8]; pv_tile<16>(lds, 32 * (rsw - rlo), P, lane, O);
    store_o((bf16*)(ws + WS_O) + (size_t)qrow * KBR + 1536 + h * 128, O, inv_l, g4);
    __syncthreads();
}
__device__ __forceinline__ void attn_fast_phase(unsigned char* ws, const float* relb, const float* qk_norm, const float* sink_all, const float* rpb_all, int l, LAS unsigned char* lds, int wave_s) {
    LAS unsigned char* tab = lds + AT_TAB_OFF;
    for (int n = tid_of(wave_s); n <= 1024; n += NWAVES * 64) tab[n] = (unsigned char)t5_bucket_dev(-n);
    __syncthreads();
    const float* qkg = qk_norm + (size_t)l * 6 * 128; const float* sinkl = sink_all + l * 8; const float* rpbl = rpb_all + (size_t)l * 8 * 465;
    const int G = gridDim.x, vcu = vcu_of();
    if (FAST_MASK & 1) { const int per = (NU_A + G - 1) / G; for (int u = vcu * per; u < (vcu + 1) * per && u < NU_A; ++u) attn_unit_A(ws, relb, qkg, lds, u, wave_s); }
    if (FAST_MASK & 2) { const int per = (NU_B + G - 1) / G; for (int u = vcu * per; u < (vcu + 1) * per && u < NU_B; ++u) attn_unit_B(ws, relb, qkg, sinkl, lds, u, wave_s); }
    if (FAST_MASK & 4) { const int per = (NU_C + G - 1) / G; for (int u = vcu * per; u < (vcu + 1) * per && u < NU_C; ++u) attn_unit_C(ws, qkg, rpbl, lds, u, wave_s); }
}

constexpr int NP = 10;
enum { PH_UP1 = 0, PH_DN1, PH_IN, PH_QKN, PH_ATT, PH_CMB, PH_BR, PH_OUT, PH_UP2, PH_DN2 };
constexpr int NPH = 1 + DEPTH * NP;

__device__ __forceinline__ KArgs kargs() { u64 p = (u64)__builtin_amdgcn_kernarg_segment_ptr(); asm volatile("" : "+s"(p)); return (KArgs)p; }

__global__ void __launch_bounds__(NWAVES * 64, 2) fwd(Args args) {
    extern __shared__ __attribute__((aligned(16))) unsigned char lds_raw[];
    LAS unsigned char* lds = (LAS unsigned char*)lds_raw;
    const int wave_s = __builtin_amdgcn_readfirstlane((int)threadIdx.x >> 6);
#define OTID() tid_of(wave_s)
    { const int tid = OTID(); for (int u = tid; u < (LDS_BYTES - RING_BYTES) / 4; u += NWAVES * 64) ((LAS unsigned*)(lds + RING_BYTES))[u] = 0u; }
    __syncthreads();
    if (ONE_LAUNCH) (void)xcd_barrier_post((unsigned*)(kargs()->ws + WS_CTL) + CW_BAR, (volatile LAS unsigned*)(lds + MISC_OFF) + 8, OTID());
    const int lo = args.ph_lo, hi = args.ph_hi;
#define IN(k) (lo <= (k) && (k) < hi)
#define SEAM(k) do { if (ONE_LAUNCH && IN(k) && IN((k) + 1)) { XcdBarrier b_; b_.bar = (unsigned*)(kargs()->ws + WS_CTL) + CW_BAR; b_.x = xb_xcc_id(); b_.st = (volatile LAS unsigned*)(lds + MISC_OFF) + 8; xcd_barrier(b_, OTID()); } } while (0)
#define TIDS() const int tid = OTID(), lane = tid & 63, wave = __builtin_amdgcn_readfirstlane(tid >> 6); const int gw = vcu_of() * NWAVES + wave, NGW = (int)gridDim.x * NWAVES; (void)lane; (void)gw; (void)NGW

    if (IN(0)) { KArgs ka = kargs(); TIDS(); prologue(ka, lds, gw, NGW, wave, lane); __syncthreads(); }
    SEAM(0);
    for (int l = 0; l < DEPTH; ++l) {
        const int g0 = 1 + l * NP;
        if (IN(g0 + PH_UP1)) {
            KArgs ka = kargs(); unsigned char* ws = ka->ws; unsigned char* wl = ws + WS_W + (size_t)l * W_LAYER;
            pg8::Gemm g{(const bf16*)(ws + WS_XB), (const bf16*)(wl + W_1A), M, 2 * FF, D}; pg8::StaticOrder S; S.init(M, 2 * FF, (int)gridDim.x, (int)blockIdx.x);
            EpiUp E{(bf16*)(ws + WS_ACT), (const u64*)(ws + WS_RSQ) + (size_t)(3 * l + 0) * M};
            pg8::gemm_phase<EpiUp, pg8::StaticOrder, true, true>(lds, g, S, E, OTID());
        }
        SEAM(g0 + PH_UP1);
        if (IN(g0 + PH_DN1)) {
            KArgs ka = kargs(); unsigned char* ws = ka->ws; unsigned char* wl = ws + WS_W + (size_t)l * W_LAYER;
            pg8::Gemm g{(const bf16*)(ws + WS_ACT), (const bf16*)(wl + W_1B), M, D, FF}; pg8::StaticOrder S; S.init(M, D, (int)gridDim.x, (int)blockIdx.x);
            EpiRes<1> E{ka->out, (bf16*)(ws + WS_XB), (u64*)(ws + WS_RSQ) + (size_t)(3 * l + 1) * M};
            pg8::gemm_phase<EpiRes<1>, pg8::StaticOrder, true, true>(lds, g, S, E, OTID());
        }
        SEAM(g0 + PH_DN1);
        if (IN(g0 + PH_IN)) {
            KArgs ka = kargs(); unsigned char* ws = ka->ws; unsigned char* wl = ws + WS_W + (size_t)l * W_LAYER;
            pg8::Gemm g{(const bf16*)(ws + WS_XB), (const bf16*)(wl + W_IN), M, NIN, D}; pg8::StaticOrder S; S.init(M, NIN, (int)gridDim.x, (int)blockIdx.x);
            EpiIn E{ws, (const u64*)(ws + WS_RSQ) + (size_t)(3 * l + 1) * M};
            pg8::gemm_phase<EpiIn, pg8::StaticOrder, true, true>(lds, g, S, E, OTID());
        }
        SEAM(g0 + PH_IN);
        if (!NORM_ON_LOAD && IN(g0 + PH_QKN)) { KArgs ka = kargs(); TIDS(); qknorm_phase(ka->ws, ka->in[8], l, gw, NGW, lane); }
        SEAM(g0 + PH_QKN);
        if (IN(g0 + PH_ATT)) {
            if (FAST_MASK != 0) { KArgs ka = kargs(); attn_fast_phase(ka->ws, ka->in[2], ka->in[8], ka->in[9], ka->in[10], l, lds, wave_s); __syncthreads(); }
            if (FAST_MASK != 7) { KArgs ka = kargs(); TIDS(); attn_naive_phase(ka->ws, ka->in[2], ka->in[9], ka->in[10], l, lds, gw, NGW, wave, lane); __syncthreads(); }
        }
        SEAM(g0 + PH_ATT);
        if (IN(g0 + PH_CMB)) { KArgs ka = kargs(); TIDS(); combine_phase(ka->ws, gw, NGW, lane); }
        SEAM(g0 + PH_CMB);
        if (IN(g0 + PH_BR)) {
            KArgs ka = kargs(); unsigned char* ws = ka->ws; unsigned char* wl = ws + WS_W + (size_t)l * W_LAYER;
            pg8::Gemm g{(const bf16*)(ws + WS_O), (const bf16*)(wl + W_BR), M, D, KBR}; pg8::StaticOrder S; S.init(M, D, (int)gridDim.x, (int)blockIdx.x);
            EpiBr E{(const bf16*)(ws + WS_G), (bf16*)(ws + WS_Z)};
            pg8::gemm_phase<EpiBr, pg8::StaticOrder, true, true>(lds, g, S, E, OTID());
        }
        SEAM(g0 + PH_BR);
        if (IN(g0 + PH_OUT)) {
            KArgs ka = kargs(); unsigned char* ws = ka->ws; unsigned char* wl = ws + WS_W + (size_t)l * W_LAYER;
            pg8::Gemm g{(const bf16*)(ws + WS_Z), (const bf16*)(wl + W_O), M, D, D}; pg8::StaticOrder S; S.init(M, D, (int)gridDim.x, (int)blockIdx.x);
            EpiRes<0> E{ka->out, (bf16*)(ws + WS_XB), (u64*)(ws + WS_RSQ) + (size_t)(3 * l + 2) * M};
            pg8::gemm_phase<EpiRes<0>, pg8::StaticOrder, true, true>(lds, g, S, E, OTID());
        }
        SEAM(g0 + PH_OUT);
        if (IN(g0 + PH_UP2)) {
            KArgs ka = kargs(); unsigned char* ws = ka->ws; unsigned char* wl = ws + WS_W + (size_t)l * W_LAYER;
            pg8::Gemm g{(const bf16*)(ws + WS_XB), (const bf16*)(wl + W_2A), M, 2 * FF, D}; pg8::StaticOrder S; S.init(M, 2 * FF, (int)gridDim.x, (int)blockIdx.x);
            EpiUp E{(bf16*)(ws + WS_ACT), (const u64*)(ws + WS_RSQ) + (size_t)(3 * l + 2) * M};
            pg8::gemm_phase<EpiUp, pg8::StaticOrder, true, true>(lds, g, S, E, OTID());
        }
        SEAM(g0 + PH_UP2);
        if (IN(g0 + PH_DN2)) {
            KArgs ka = kargs(); unsigned char* ws = ka->ws; unsigned char* wl = ws + WS_W + (size_t)l * W_LAYER;
            pg8::Gemm g{(const bf16*)(ws + WS_ACT), (const bf16*)(wl + W_2B), M, D, FF}; pg8::StaticOrder S; S.init(M, D, (int)gridDim.x, (int)blockIdx.x);
            EpiRes<1> E{ka->out, (bf16*)(ws + WS_XB), (u64*)(ws + WS_RSQ) + (size_t)(3 * l + 3) * M};
            pg8::gemm_phase<EpiRes<1>, pg8::StaticOrder, true, true>(lds, g, S, E, OTID());
        }
        SEAM(g0 + PH_DN2);
    }
#undef IN
#undef SEAM
#undef TIDS
#undef OTID
}

extern "C" void kernel_launch(void* const* d_in, const int* in_sizes, int n_in, void* d_out, int out_size, void* d_ws, size_t ws_size, hipStream_t stream) {
    static int grid = 0;
    if (grid == 0) {
        if (n_in != 18 || out_size != M * D || ws_size < WS_END) { fprintf(stderr, "kernel_launch: unexpected problem (n_in %d, out %d, ws %zu, need %zu); nothing launched\n", n_in, out_size, ws_size, (size_t)WS_END); grid = -1; return; }
        int dev = 0, cus = 0, per_cu = 0;
        if (hipGetDevice(&dev) != hipSuccess || hipDeviceGetAttribute(&cus, hipDeviceAttributeMultiprocessorCount, dev) != hipSuccess) { grid = -1; return; }
        if (hipFuncSetAttribute((const void*)fwd, hipFuncAttributeMaxDynamicSharedMemorySize, LDS_BYTES) != hipSuccess) { fprintf(stderr, "kernel_launch: hipFuncSetAttribute failed\n"); grid = -1; return; }
        if (hipOccupancyMaxActiveBlocksPerMultiprocessor(&per_cu, (const void*)fwd, NWAVES * 64, LDS_BYTES) != hipSuccess || per_cu < 1) { fprintf(stderr, "kernel_launch: occupancy query says %d\n", per_cu); }
        (void)hipGetLastError();
        grid = cus;
    }
    if (grid < 0) return;
    (void)hipMemsetAsync((char*)d_ws + WS_CTL, 0, CTL_ZERO_BYTES, stream);
    Args a{};
    for (int i = 0; i < 18; ++i) a.in[i] = (const float*)d_in[i];
    a.out = (float*)d_out; a.ws = (unsigned char*)d_ws;
    if (ONE_LAUNCH) { a.ph_lo = 0; a.ph_hi = NPH; hipLaunchKernelGGL(fwd, dim3(grid), dim3(NWAVES * 64), LDS_BYTES, stream, a); }
    else for (int p = 0; p < NPH; ++p) { a.ph_lo = p; a.ph_hi = p + 1; hipLaunchKernelGGL(fwd, dim3(grid), dim3(NWAVES * 64), LDS_BYTES, stream, a); }
}
```

```cpp
#include <hip/hip_runtime.h>
#include <cstdio>
#include <cstdint>

#ifndef PROBE_DUP
#define PROBE_DUP 0
#endif
#ifndef ONE_LAUNCH
#define ONE_LAUNCH 1
#endif

#ifndef FAST_MASK
#define FAST_MASK 7
#endif
#ifndef GEMM_ALIGN
#define GEMM_ALIGN true
#endif
#ifndef GEMM_SP2
#define GEMM_SP2 true
#endif
#ifndef QKN_IN_EPI
#define QKN_IN_EPI 1
#endif
#ifndef NORM_ON_LOAD
#define NORM_ON_LOAD 0
#endif
typedef unsigned long long u64;
namespace pg8 {
#define PG8_LAS __attribute__((address_space(3)))
typedef unsigned short bf16_t;
typedef short bf16x8 __attribute__((ext_vector_type(8)));
typedef float f32x4 __attribute__((ext_vector_type(4)));
typedef unsigned u32x4 __attribute__((ext_vector_type(4)));
typedef unsigned u32x2 __attribute__((ext_vector_type(2)));
constexpr int BM = 256, BK = 64, HALF = 128, HTB = HALF * BK * 2, STAGE_BYTES = 8 * HTB, NXCD = 8, WGM = 8;

__host__ __device__ __forceinline__ int lds_byte(int r, int c) { const int st = (r >> 4) * 2 + (c >> 5), rr = r & 15, cc = c & 31, ob = rr * 64 + cc * 2; return st * 1024 + (ob ^ (((ob >> 9) & 1) << 5)); }
__host__ __device__ __forceinline__ void stage_rc(int b, int& R, int& C) { const int st = b / 1024, sb = b % 1024, swz = sb ^ (((sb >> 9) & 1) << 5); R = (st >> 1) * 16 + swz / 64; C = (st & 1) * 32 + (swz % 64) / 2; }
__host__ __device__ __forceinline__ int perm32(int rho) { const int n = rho >> 4, i = rho & 15; return 8 * (i >> 2) + 4 * n + (i & 3); }

struct Unit { int pm, pn; };
struct Gemm { const bf16_t* A; const bf16_t* Bt; int M, N, K; bool ablk = false, bblk = false; };

struct StaticOrder {
    int nM, nN, nwg, G, c, r0 = 0, r1 = 1 << 30;
    __host__ __device__ void init(int M, int N, int G_, int c_) { nM = M / BM; nN = N / BM; nwg = nM * nN; G = G_; c = c_; }
    __host__ __device__ bool next(int i, Unit& u) const {
        if (i + r0 >= r1) return false;
        const long L = (long)(i + r0) * G + c; if (L >= nwg) return false;
        int wgid = (int)L; { const int q = nwg / NXCD, r = nwg % NXCD, xcd = wgid % NXCD, off = wgid / NXCD; wgid = (xcd < r ? xcd * (q + 1) : r * (q + 1) + (xcd - r) * q) + off; }
        const int nig = WGM * nN, gid = wgid / nig, fm = gid * WGM, gsz = (nM - fm) < WGM ? (nM - fm) : WGM;
        u.pm = fm + ((wgid % nig) % gsz); u.pn = (wgid % nig) / gsz; return true;
    }
    __device__ __forceinline__ void a_ready(const Unit&) const {}
    __device__ __forceinline__ void done(const Unit&) const {}
};

__device__ __forceinline__ unsigned cvt_pk_bf16(float lo, float hi) { unsigned r; asm volatile("v_cvt_pk_bf16_f32 %0, %1, %2" : "=v"(r) : "v"(lo), "v"(hi)); return r; }
__device__ __forceinline__ float bf_lo(unsigned w) { return __uint_as_float(w << 16); }
__device__ __forceinline__ float bf_hi(unsigned w) { return __uint_as_float(w & 0xffff0000u); }

template <class Epi, class Sched, bool ALIGN_EPI = false, bool SP2 = false>
__device__ __forceinline__ void gemm_phase(PG8_LAS unsigned char* lds, const Gemm g, const Sched& S, const Epi& E, const int tid  ) {
    const int wid = __builtin_amdgcn_readfirstlane(tid >> 6), lane = tid & 63, wr = wid >> 2, wc = wid & 3, fr = lane & 15, fq = lane >> 4;
    const int K = g.K, nt = K / BK;
    unsigned voffA[2], voffB[2];
#pragma unroll
    for (int i = 0; i < 2; ++i) { int R, C; stage_rc(tid * 16 + i * 8192, R, C); const int Rb = Epi::PERM ? ((R & ~31) + perm32(R & 31)) : R;
        voffA[i] = (unsigned)(R * (g.ablk ? BK : K) + C) * 2u; voffB[i] = (unsigned)(Rb * (g.bblk ? BK : K) + C) * 2u; }
    const size_t kstepA = g.ablk ? (size_t)(BM * BK * 2) : (size_t)(BK * 2), kstepB = g.bblk ? (size_t)(BM * BK * 2) : (size_t)(BK * 2);
    const size_t hstepA = g.ablk ? (size_t)(HALF * BK * 2) : (size_t)HALF * K * 2, hstepB = g.bblk ? (size_t)(HALF * BK * 2) : (size_t)HALF * K * 2;
    const size_t tstepA = (size_t)BM * K * 2, tstepB = (size_t)BM * K * 2;
    const unsigned ldsw = (unsigned)wid * 1024u;
    const int aoff = lds_byte(wr * 64 + fr, fq * 8), boff = lds_byte(wc * 32 + fr, fq * 8);
#define PG8_SA(b, h) (((b) * 2 + (h)) * HTB)
#define PG8_SB(b, h) ((4 + (b) * 2 + (h)) * HTB)
#define PG8_STAGE(bufoff, gbase, voff) do { _Pragma("unroll") for (int _i = 0; _i < 2; ++_i) \
        __builtin_amdgcn_global_load_lds((const unsigned*)((const char*)(gbase) + (voff)[_i]), (PG8_LAS unsigned*)(lds + (bufoff) + ldsw + _i * 8192), 16, 0, 0); } while (0)
#define PG8_LDA(dst, b, h) do { _Pragma("unroll") for (int m = 0; m < 4; ++m) _Pragma("unroll") for (int k = 0; k < 2; ++k) dst[m][k] = *(const PG8_LAS bf16x8*)(lds + PG8_SA(b, h) + aoff + m * 2048 + k * 1024); } while (0)
#define PG8_LDB(dst, b, h) do { _Pragma("unroll") for (int n = 0; n < 2; ++n) _Pragma("unroll") for (int k = 0; k < 2; ++k) dst[n][k] = *(const PG8_LAS bf16x8*)(lds + PG8_SB(b, h) + boff + n * 2048 + k * 1024); } while (0)
#define PG8_MMA(ai, bj, At, Bt) do { __builtin_amdgcn_s_setprio(1); _Pragma("unroll") for (int m = 0; m < 4; ++m) _Pragma("unroll") for (int n = 0; n < 2; ++n) _Pragma("unroll") for (int k = 0; k < 2; ++k) \
        acc[ai][bj][m][n] = __builtin_amdgcn_mfma_f32_16x16x32_bf16(Bt[n][k], At[m][k], acc[ai][bj][m][n], 0, 0, 0); __builtin_amdgcn_s_setprio(0); } while (0)
#define PG8_WAIT_V(n) asm volatile("s_waitcnt vmcnt(" #n ")" ::: "memory")
#define PG8_WAIT_L(n) asm volatile("s_waitcnt lgkmcnt(" #n ")" ::: "memory")
#define PG8_BAR __builtin_amdgcn_s_barrier()
#define PG8_SCHED __builtin_amdgcn_sched_barrier(0)
    Unit cur, nxt; int ui = 0;
    if (!S.next(0, cur)) return;
    f32x4 acc[2][2][4][2];
#pragma unroll
    for (int a = 0; a < 2; ++a)
#pragma unroll
        for (int b = 0; b < 2; ++b)
#pragma unroll
            for (int m = 0; m < 4; ++m)
#pragma unroll
                for (int n = 0; n < 2; ++n) acc[a][b][m][n] = (f32x4){0.f, 0.f, 0.f, 0.f};
    bf16x8 At[4][2], B0[2][2], B1[2][2];
    const char* cA = (const char*)g.A + (size_t)cur.pm * tstepA; const char* cB = (const char*)g.Bt + (size_t)cur.pn * tstepB;
    S.a_ready(cur);
    if constexpr (SP2) {
        PG8_STAGE(PG8_SB(0, 0), cB, voffB); PG8_STAGE(PG8_SB(0, 1), cB + hstepB, voffB); PG8_STAGE(PG8_SA(0, 0), cA, voffA); PG8_STAGE(PG8_SA(0, 1), cA + hstepA, voffA);
        if (wr == 1) PG8_BAR;
        PG8_WAIT_V(2); PG8_BAR;
        PG8_STAGE(PG8_SB(1, 0), cB + kstepB, voffB); PG8_STAGE(PG8_SA(1, 0), cA + kstepA, voffA); PG8_STAGE(PG8_SB(1, 1), cB + hstepB + kstepB, voffB);
        PG8_WAIT_V(6); PG8_BAR;
    } else {
        PG8_STAGE(PG8_SB(0, 0), cB, voffB); PG8_STAGE(PG8_SA(0, 0), cA, voffA); PG8_STAGE(PG8_SB(0, 1), cB + hstepB, voffB); PG8_STAGE(PG8_SA(0, 1), cA + hstepA, voffA);
        if (wr == 1) PG8_BAR;
        PG8_WAIT_V(4); PG8_BAR;
        PG8_STAGE(PG8_SB(1, 0), cB + kstepB, voffB); PG8_STAGE(PG8_SA(1, 0), cA + kstepA, voffA); PG8_STAGE(PG8_SB(1, 1), cB + hstepB + kstepB, voffB);
        PG8_WAIT_V(6); PG8_BAR;
    }
    for (;;) {
        const bool has_next = S.next(ui + 1, nxt);
        const char* nA = has_next ? (const char*)g.A + (size_t)nxt.pm * tstepA : cA; const char* nB = has_next ? (const char*)g.Bt + (size_t)nxt.pn * tstepB : cB;
        for (int t = 0; t < nt; t += 2) {
            const bool last = (t == nt - 2);
            const char* a1 = cA + (size_t)(t + 1) * kstepA;
            const char* a2 = last ? nA : cA + (size_t)(t + 2) * kstepA; const char* b2 = last ? nB : cB + (size_t)(t + 2) * kstepB;
            const char* a3 = a2 + kstepA; const char* b3 = b2 + kstepB;
            if (last && has_next) S.a_ready(nxt);
            if constexpr (Epi::MID) { if (t == Epi::MID_T0 || t == Epi::MID_T1) E.mid(acc, cur, t, wr, wc, fr, fq); }
            if constexpr (SP2) {
            PG8_LDB(B0, 0, 0); PG8_LDB(B1, 0, 1); PG8_SCHED; PG8_LDA(At, 0, 0); PG8_STAGE(PG8_SA(1, 1), a1 + hstepA, voffA);
            PG8_WAIT_V(8); PG8_WAIT_L(0); PG8_BAR; PG8_MMA(0, 0, At, B0); PG8_MMA(0, 1, At, B1); PG8_BAR; PG8_SCHED;
            PG8_LDA(At, 0, 1); PG8_STAGE(PG8_SB(0, 0), b2, voffB); PG8_STAGE(PG8_SB(0, 1), b2 + hstepB, voffB); PG8_STAGE(PG8_SA(0, 0), a2, voffA);
            PG8_WAIT_V(8); PG8_WAIT_L(0); PG8_BAR; PG8_MMA(1, 0, At, B0); PG8_MMA(1, 1, At, B1); PG8_BAR; PG8_SCHED;
            PG8_LDB(B0, 1, 0); PG8_LDB(B1, 1, 1); PG8_SCHED; PG8_LDA(At, 1, 0); PG8_STAGE(PG8_SA(0, 1), a2 + hstepA, voffA);
            PG8_WAIT_V(8); PG8_WAIT_L(0); PG8_BAR; PG8_MMA(0, 0, At, B0); PG8_MMA(0, 1, At, B1); PG8_BAR; PG8_SCHED;
            PG8_LDA(At, 1, 1); PG8_STAGE(PG8_SB(1, 0), b3, voffB); PG8_STAGE(PG8_SB(1, 1), b3 + hstepB, voffB); PG8_STAGE(PG8_SA(1, 0), a3, voffA);
            PG8_WAIT_V(8); PG8_WAIT_L(0); PG8_BAR; PG8_MMA(1, 0, At, B0); PG8_MMA(1, 1, At, B1); PG8_BAR; PG8_SCHED;
            } else {
            PG8_LDB(B0, 0, 0); PG8_SCHED; PG8_LDA(At, 0, 0); PG8_STAGE(PG8_SA(1, 1), a1 + hstepA, voffA);
            PG8_WAIT_L(8); PG8_BAR; PG8_WAIT_L(0); PG8_MMA(0, 0, At, B0); PG8_BAR; PG8_SCHED;
            PG8_LDB(B1, 0, 1); PG8_STAGE(PG8_SB(0, 0), b2, voffB);
            PG8_BAR; PG8_WAIT_L(0); PG8_MMA(0, 1, At, B1); PG8_BAR;
            PG8_LDA(At, 0, 1); PG8_STAGE(PG8_SA(0, 0), a2, voffA);
            PG8_BAR; PG8_WAIT_L(0); PG8_MMA(1, 0, At, B0); PG8_BAR; PG8_SCHED;
            PG8_STAGE(PG8_SB(0, 1), b2 + hstepB, voffB);
            PG8_WAIT_V(6); PG8_BAR; PG8_MMA(1, 1, At, B1); PG8_BAR;
            PG8_LDB(B0, 1, 0); PG8_SCHED; PG8_LDA(At, 1, 0); PG8_STAGE(PG8_SA(0, 1), a2 + hstepA, voffA);
            PG8_WAIT_L(8); PG8_BAR; PG8_WAIT_L(0); PG8_MMA(0, 0, At, B0); PG8_BAR; PG8_SCHED;
            PG8_LDB(B1, 1, 1); PG8_STAGE(PG8_SB(1, 0), b3, voffB);
            PG8_BAR; PG8_WAIT_L(0); PG8_MMA(0, 1, At, B1); PG8_BAR;
            PG8_LDA(At, 1, 1); PG8_STAGE(PG8_SA(1, 0), a3, voffA);
            PG8_BAR; PG8_WAIT_L(0); PG8_MMA(1, 0, At, B0); PG8_BAR; PG8_SCHED;
            PG8_STAGE(PG8_SB(1, 1), b3 + hstepB, voffB);
            PG8_WAIT_V(6); PG8_BAR; PG8_MMA(1, 1, At, B1); PG8_BAR;
            }
        }
        if constexpr (ALIGN_EPI) { if (wr == 0) PG8_BAR; }
        E(acc, cur, wr, wc, fr, fq); S.done(cur);
        if (!has_next) break;
#pragma unroll
        for (int a = 0; a < 2; ++a)
#pragma unroll
            for (int b = 0; b < 2; ++b)
#pragma unroll
                for (int m = 0; m < 4; ++m)
#pragma unroll
                    for (int n = 0; n < 2; ++n) acc[a][b][m][n] = (f32x4){0.f, 0.f, 0.f, 0.f};
        cur = nxt; cA = nA; cB = nB; ++ui;
        if constexpr (ALIGN_EPI) { if (wr == 1) PG8_BAR; }
    }
    PG8_WAIT_V(0);
    if constexpr (!ALIGN_EPI) { if (wr == 0) PG8_BAR; }
    PG8_BAR;
#undef PG8_SA
#undef PG8_SB
#undef PG8_STAGE
#undef PG8_LDA
#undef PG8_LDB
#undef PG8_MMA
#undef PG8_WAIT_V
#undef PG8_WAIT_L
#undef PG8_BAR
#undef PG8_SCHED
}
}

constexpr int M = 16384, D = 2048, FF = 5632, NIN = 15360, KBR = 2560, DEPTH = 4;
constexpr int NWAVES = 8;
constexpr float EPS = 1e-6f;
constexpr float SSQ_SCALE = 16777216.0f;
typedef unsigned short bf16;
typedef pg8::f32x4 f32x4;
typedef pg8::u32x4 u32x4;
typedef pg8::u32x2 u32x2;
#define LAS __attribute__((address_space(3)))

constexpr size_t MiB = 1u << 20;
constexpr size_t WS_CTL = 0, CTL_ZERO_BYTES = 4 * MiB;
constexpr size_t WS_RSQ = 1 * MiB;
constexpr size_t WS_W = 8 * MiB, W_LAYER = 210 * MiB;
constexpr size_t W_1A = 0, W_1B = 44 * MiB, W_IN = 66 * MiB, W_BR = 126 * MiB, W_O = 136 * MiB, W_2A = 144 * MiB, W_2B = 188 * MiB;
constexpr size_t WS_XB = 848 * MiB;
constexpr size_t WS_ACT = 912 * MiB;
constexpr size_t WS_QA = WS_ACT, WS_KA = WS_QA + 48 * MiB, WS_VA = WS_KA + 48 * MiB, WS_QB = WS_VA + 48 * MiB, WS_KB = WS_QB + 32 * MiB, WS_VB = WS_KB + 8 * MiB,
                 WS_QC = WS_VB + 8 * MiB, WS_KC = WS_QC + 32 * MiB, WS_VC = WS_KC + 32 * MiB, WS_G = WS_VC + 32 * MiB;
constexpr size_t WS_O = WS_ACT + 480 * MiB;
constexpr size_t WS_OAG = WS_O + 80 * MiB;
constexpr size_t WS_LSE = WS_OAG + 48 * MiB;
constexpr size_t WS_Z = WS_LSE + 1 * MiB;
constexpr size_t WS_END = WS_Z + 64 * MiB;
static_assert(WS_G + (size_t)M * 6144 * 2 == WS_O, "QKVG map");
static_assert(WS_W + 4 * W_LAYER == WS_XB, "weight map");
constexpr int CW_BAR = 4096;

constexpr int RING_BYTES = 131072, MISC_OFF = RING_BYTES + 320, LDS_BYTES = 147456;

#define XB_TMO      128
#define XB_XCNT(j)  (256  + 64 * (j))
#define XB_XSUB(j)  (1280 + 64 * (j))
#define XB_XGEN(j)  (2304 + 64 * (j))
#define XB_TOP      3328
#define XB_TOPGEN   3392
#define XCD_BAR_WORDS 3456
#define XB_SPIN_CAP (1u << 22)
__device__ __forceinline__ unsigned xb_ld(unsigned* p)              { return __hip_atomic_load(p, __ATOMIC_RELAXED, __HIP_MEMORY_SCOPE_AGENT); }
__device__ __forceinline__ unsigned xb_add(unsigned* p, unsigned v) { return __hip_atomic_fetch_add(p, v, __ATOMIC_RELAXED, __HIP_MEMORY_SCOPE_AGENT); }
__device__ __forceinline__ unsigned xb_xcc_id() { return (unsigned)__builtin_amdgcn_s_getreg((3 << 11) | 20) & 0xFu; }
#define XB_SPIN(cond, bar) do { unsigned _sp = 0; while (cond) { __builtin_amdgcn_s_sleep(1); \
    if ((++_sp & 255u) == 0u) { if (xb_ld(&(bar)[XB_TMO])) break; if (_sp > XB_SPIN_CAP) { atomicAdd(&(bar)[XB_TMO], 1u); break; } } } } while (0)
struct XcdBarrier { unsigned* bar; unsigned x; volatile LAS unsigned* st; };
__device__ __forceinline__ XcdBarrier xcd_barrier_post(unsigned* bar, volatile LAS unsigned* st, int tid) {
    XcdBarrier b; b.bar = bar; b.x = xb_xcc_id(); b.st = st;
    if (tid == 0) (void)xb_add(&bar[XB_XCNT(b.x)], 1u);
    return b;
}
__device__ __forceinline__ void xcd_barrier_complete(unsigned* bar, unsigned x, unsigned& nloc, unsigned& nx) {
    const unsigned G = gridDim.x * gridDim.y * gridDim.z;
    unsigned sum, cnt, mine, sp = 0u;
    for (;;) {
        sum = 0u; cnt = 0u; mine = 0u;
#pragma unroll
        for (unsigned j = 0; j < 16; ++j) { const unsigned c = xb_ld(&bar[XB_XCNT(j)]); sum += c; cnt += (c > 0u) ? 1u : 0u; mine = (j == x) ? c : mine; }
        if (sum == G) break;
        __builtin_amdgcn_s_sleep(1);
        if ((++sp & 255u) == 0u) { if (xb_ld(&bar[XB_TMO])) break; if (sp > XB_SPIN_CAP) { atomicAdd(&bar[XB_TMO], 1u); break; } }
    }
    nloc = mine > 0u ? mine : 1u; nx = cnt > 0u ? cnt : 1u;
}
__device__ __forceinline__ void xcd_barrier(const XcdBarrier& b, int tid) {
    asm volatile("s_waitcnt vmcnt(0)" ::: "memory");
    __syncthreads();
    if (tid == 0) {
        unsigned* bar = b.bar;
        __builtin_amdgcn_s_waitcnt(0);
        unsigned nloc = b.st[0], nx = b.st[1];
        if (nloc == 0u) { xcd_barrier_complete(bar, b.x, nloc, nx); b.st[0] = nloc; b.st[1] = nx; }
        const unsigned old = xb_add(&bar[XB_XSUB(b.x)], 1u);
        const unsigned gen = old / nloc;
        if (old + 1u == (gen + 1u) * nloc) {
            __builtin_amdgcn_fence(__ATOMIC_RELEASE, "agent");
            asm volatile("s_waitcnt vmcnt(0)" ::: "memory");
            const unsigned og = xb_add(&bar[XB_TOP], 1u);
            const unsigned tg = og / nx;
            if (og + 1u == (tg + 1u) * nx) xb_add(&bar[XB_TOPGEN], 1u);
            else XB_SPIN(xb_ld(&bar[XB_TOPGEN]) == tg, bar);
            __builtin_amdgcn_fence(__ATOMIC_ACQUIRE, "agent");
            xb_add(&bar[XB_XGEN(b.x)], 1u);
            asm volatile("s_waitcnt vmcnt(0)" ::: "memory");
        } else {
            XB_SPIN(xb_ld(&bar[XB_XGEN(b.x)]) == gen, bar);
            __builtin_amdgcn_fence(__ATOMIC_ACQUIRE, "agent");
            asm volatile("s_waitcnt vmcnt(0)" ::: "memory");
        }
    }
    __syncthreads();
}

#define LDS_WAIT() asm volatile("s_waitcnt lgkmcnt(0)" ::: "memory")
__device__ __forceinline__ unsigned f2bf(float f) { unsigned u = __builtin_bit_cast(unsigned, f); return (u + 0x7fffu + ((u >> 16) & 1u)) >> 16; }
__device__ __forceinline__ unsigned pk2(float lo, float hi) { return f2bf(lo) | (f2bf(hi) << 16); }
__device__ __forceinline__ float bf_lo(unsigned w) { return __uint_as_float(w << 16); }
__device__ __forceinline__ float bf_hi(unsigned w) { return __uint_as_float(w & 0xffff0000u); }
__device__ __forceinline__ float wave_sum(float v) {
#pragma unroll
    for (int o = 1; o < 64; o <<= 1) v += __shfl_xor(v, o);
    return v;
}
__device__ __forceinline__ float wave_max(float v) {
#pragma unroll
    for (int o = 1; o < 64; o <<= 1) v = fmaxf(v, __shfl_xor(v, o));
    return v;
}
__device__ __forceinline__ float rstd_row(const u64* rsq, int row) {
    const u64 v = rsq[row];
    return rsqrtf((float)v * (1.0f / (SSQ_SCALE * (float)D)) + EPS);
}
__device__ __forceinline__ float sigmoidf_(float x) { return __builtin_amdgcn_rcpf(1.0f + __expf(-x)); }

struct EpiUp {
    static constexpr bool PERM = true, MID = false; static constexpr int MID_T0 = -1, MID_T1 = -1;
    bf16* act; const u64* rsq;
    __device__ __forceinline__ void mid(f32x4 (&)[2][2][4][2], const pg8::Unit&, int, int, int, int, int) const {}
    __device__ __forceinline__ void operator()(const f32x4 (&acc)[2][2][4][2], const pg8::Unit& u, int wr, int wc, int fr, int fq) const {
        const int row0 = u.pm * 256 + wr * 64 + fr, col0 = u.pn * 128 + wc * 32 + 8 * fq;
#pragma unroll
        for (int ai = 0; ai < 2; ++ai)
#pragma unroll
            for (int m = 0; m < 4; ++m) {
                const int row = row0 + ai * 128 + m * 16; const float rs = rstd_row(rsq, row);
                float o[8];
#pragma unroll
                for (int n = 0; n < 2; ++n)
#pragma unroll
                    for (int j = 0; j < 4; ++j) { const float gt = acc[ai][0][m][n][j] * rs, up = acc[ai][1][m][n][j] * rs; o[4 * n + j] = gt * sigmoidf_(gt) * up; }
                u32x4 w; w.x = pg8::cvt_pk_bf16(o[0], o[1]); w.y = pg8::cvt_pk_bf16(o[2], o[3]); w.z = pg8::cvt_pk_bf16(o[4], o[5]); w.w = pg8::cvt_pk_bf16(o[6], o[7]);
                *(u32x4*)(act + (size_t)row * FF + col0) = w;
            }
    }
};
struct EpiNull {
    static constexpr bool PERM = true, MID = false; static constexpr int MID_T0 = -1, MID_T1 = -1;
    __device__ __forceinline__ void mid(f32x4 (&)[2][2][4][2], const pg8::Unit&, int, int, int, int, int) const {}
    __device__ __forceinline__ void operator()(const f32x4 (&acc)[2][2][4][2], const pg8::Unit&, int, int, int, int) const {
#pragma unroll
        for (int ai = 0; ai < 2; ++ai)
#pragma unroll
            for (int bj = 0; bj < 2; ++bj)
#pragma unroll
                for (int m = 0; m < 4; ++m) asm volatile("" :: "v"(acc[ai][bj][m][0]), "v"(acc[ai][bj][m][1]));
    }
};
template <int HALFSC> struct EpiRes {
    static constexpr bool PERM = true, MID = false; static constexpr int MID_T0 = -1, MID_T1 = -1;
    float* x; bf16* xb; u64* rsq_next;
    __device__ __forceinline__ void mid(f32x4 (&)[2][2][4][2], const pg8::Unit&, int, int, int, int, int) const {}
    __device__ __forceinline__ void operator()(const f32x4 (&acc)[2][2][4][2], const pg8::Unit& u, int wr, int wc, int fr, int fq) const {
        const float sc = HALFSC ? 0.5f : 1.0f;
        const int row0 = u.pm * 256 + wr * 64 + fr, col0 = u.pn * 256 + wc * 32 + 8 * fq;
#pragma unroll
        for (int ai = 0; ai < 2; ++ai) {
            f32x4 xa[4][2][2];
#pragma unroll
            for (int m = 0; m < 4; ++m)
#pragma unroll
                for (int bj = 0; bj < 2; ++bj) { const float* p = x + (size_t)(row0 + ai * 128 + m * 16) * D + col0 + bj * 128; xa[m][bj][0] = *(const f32x4*)p; xa[m][bj][1] = *(const f32x4*)(p + 4); }
#pragma unroll
            for (int m = 0; m < 4; ++m) {
                const int row = row0 + ai * 128 + m * 16; float ssq = 0.f;
#pragma unroll
                for (int bj = 0; bj < 2; ++bj) {
                    float* p = x + (size_t)row * D + col0 + bj * 128;
                    const f32x4 a = xa[m][bj][0] + acc[ai][bj][m][0] * sc, b = xa[m][bj][1] + acc[ai][bj][m][1] * sc;
                    *(f32x4*)p = a; *(f32x4*)(p + 4) = b;
                    ssq += (a[0] * a[0] + a[1] * a[1]) + (a[2] * a[2] + a[3] * a[3]) + (b[0] * b[0] + b[1] * b[1]) + (b[2] * b[2] + b[3] * b[3]);
                    u32x4 w; w.x = pg8::cvt_pk_bf16(a[0], a[1]); w.y = pg8::cvt_pk_bf16(a[2], a[3]); w.z = pg8::cvt_pk_bf16(b[0], b[1]); w.w = pg8::cvt_pk_bf16(b[2], b[3]);
                    *(u32x4*)(xb + (size_t)row * D + col0 + bj * 128) = w;
                }
                ssq += __shfl_xor(ssq, 16); ssq += __shfl_xor(ssq, 32);
                if (fq == 0) __hip_atomic_fetch_add(rsq_next + row, (u64)(ssq * SSQ_SCALE), __ATOMIC_RELAXED, __HIP_MEMORY_SCOPE_AGENT);
            }
        }
    }
};
struct EpiIn {
    static constexpr bool PERM = true, MID = false; static constexpr int MID_T0 = -1, MID_T1 = -1;
    unsigned char* ws; const u64* rsq; const float* qkg; LAS unsigned char* lds;
    __device__ __forceinline__ void mid(f32x4 (&)[2][2][4][2], const pg8::Unit&, int, int, int, int, int) const {}
    __device__ __forceinline__ void operator()(const f32x4 (&acc)[2][2][4][2], const pg8::Unit& u, int wr, int wc, int fr, int fq) const {
        const int c = u.pn; size_t off; int ldc, lc, gi = -1; bool gate = false;
        if (c < 6) { off = WS_QA; ldc = 1536; lc = c; gi = 0; } else if (c < 12) { off = WS_KA; ldc = 1536; lc = c - 6; gi = 1; } else if (c < 18) { off = WS_VA; ldc = 1536; lc = c - 12; }
        else if (c < 22) { off = WS_QB; ldc = 1024; lc = c - 18; gi = 2; } else if (c == 22) { off = WS_KB; ldc = 256; lc = 0; gi = 3; } else if (c == 23) { off = WS_VB; ldc = 256; lc = 0; }
        else if (c < 28) { off = WS_QC; ldc = 1024; lc = c - 24; gi = 4; } else if (c < 32) { off = WS_KC; ldc = 1024; lc = c - 28; gi = 5; } else if (c < 36) { off = WS_VC; ldc = 1024; lc = c - 32; }
        else { off = WS_G; ldc = 6144; lc = c - 36; gate = true; }
        bf16* dst = (bf16*)(ws + off);
        const int row0 = u.pm * 256 + wr * 64 + fr, col0 = lc * 256 + wc * 32 + 8 * fq;
        float rs[2][4];
#pragma unroll
        for (int ai = 0; ai < 2; ++ai)
#pragma unroll
            for (int m = 0; m < 4; ++m) rs[ai][m] = rstd_row(rsq, row0 + ai * 128 + m * 16);
        if (QKN_IN_EPI && gi >= 0) {
            LAS float* T = (LAS float*)(lds + RING_BYTES + 512);
#pragma unroll
            for (int ai = 0; ai < 2; ++ai)
#pragma unroll
                for (int m = 0; m < 4; ++m)
#pragma unroll
                    for (int bj = 0; bj < 2; ++bj) {
                        const f32x4 a = acc[ai][bj][m][0], b = acc[ai][bj][m][1];
                        float p = ((a[0] * a[0] + a[1] * a[1]) + (a[2] * a[2] + a[3] * a[3])) + ((b[0] * b[0] + b[1] * b[1]) + (b[2] * b[2] + b[3] * b[3]));
                        p *= rs[ai][m] * rs[ai][m];
                        p += __shfl_xor(p, 16); p += __shfl_xor(p, 32);
                        if (fq == 0) T[((ai * 128 + wr * 64 + m * 16 + fr) * 2 + bj) * 4 + wc] = p;
                    }
            asm volatile("s_waitcnt lgkmcnt(0)" ::: "memory"); __builtin_amdgcn_s_barrier(); asm volatile("" ::: "memory");
            const f32x4 g0 = *(const f32x4*)(qkg + gi * 128 + wc * 32 + 8 * fq), g1 = *(const f32x4*)(qkg + gi * 128 + wc * 32 + 8 * fq + 4);
#pragma unroll
            for (int ai = 0; ai < 2; ++ai)
#pragma unroll
                for (int m = 0; m < 4; ++m) {
                    const int row = row0 + ai * 128 + m * 16;
#pragma unroll
                    for (int bj = 0; bj < 2; ++bj) {
                        const f32x4 t = *(const LAS f32x4*)(T + ((ai * 128 + wr * 64 + m * 16 + fr) * 2 + bj) * 4);
                        const float sc = rs[ai][m] * rsqrtf(((t[0] + t[1]) + (t[2] + t[3])) * (1.0f / 128.0f) + EPS);
                        const f32x4 a = acc[ai][bj][m][0] * sc * g0, b = acc[ai][bj][m][1] * sc * g1;
                        u32x4 w; w.x = pg8::cvt_pk_bf16(a[0], a[1]); w.y = pg8::cvt_pk_bf16(a[2], a[3]); w.z = pg8::cvt_pk_bf16(b[0], b[1]); w.w = pg8::cvt_pk_bf16(b[2], b[3]);
                        *(u32x4*)(dst + (size_t)row * ldc + col0 + bj * 128) = w;
                    }
                }
            return;
        }
#pragma unroll
        for (int ai = 0; ai < 2; ++ai)
#pragma unroll
            for (int m = 0; m < 4; ++m) {
                const int row = row0 + ai * 128 + m * 16; const float r_ = rs[ai][m];
#pragma unroll
                for (int bj = 0; bj < 2; ++bj) {
                    f32x4 a = acc[ai][bj][m][0] * r_, b = acc[ai][bj][m][1] * r_;
                    if (gate) {
#pragma unroll
                        for (int j = 0; j < 4; ++j) { a[j] = fmaxf(sigmoidf_(a[j]), 1e-30f); b[j] = fmaxf(sigmoidf_(b[j]), 1e-30f); }
                    }
                    u32x4 w; w.x = pg8::cvt_pk_bf16(a[0], a[1]); w.y = pg8::cvt_pk_bf16(a[2], a[3]); w.z = pg8::cvt_pk_bf16(b[0], b[1]); w.w = pg8::cvt_pk_bf16(b[2], b[3]);
                    *(u32x4*)(dst + (size_t)row * ldc + col0 + bj * 128) = w;
                }
            }
    }
};
struct EpiBr {
    static constexpr bool PERM = true, MID = true; static constexpr int MID_T0 = 8, MID_T1 = 24;
    const bf16* G; bf16* z;
    __device__ __forceinline__ void mid(f32x4 (&acc)[2][2][4][2], const pg8::Unit& u, int t, int wr, int wc, int fr, int fq) const {
        const bf16* ga = G + (t == MID_T0 ? 0 : 2048);
        int frx = fr, fqx = fq; asm volatile("" : "+v"(frx), "+v"(fqx));
        const int row0 = u.pm * 256 + wr * 64 + frx, col0 = u.pn * 256 + wc * 32 + 8 * fqx;
#pragma unroll
        for (int ai = 0; ai < 2; ++ai) {
            u32x4 na[4][2], nb[4][2];
#pragma unroll
            for (int m = 0; m < 4; ++m)
#pragma unroll
                for (int bj = 0; bj < 2; ++bj) { const bf16* p = ga + (size_t)(row0 + ai * 128 + m * 16) * 6144 + col0 + bj * 128; na[m][bj] = *(const u32x4*)p; nb[m][bj] = *(const u32x4*)(p + 2048); }
#pragma unroll
            for (int m = 0; m < 4; ++m)
#pragma unroll
                for (int bj = 0; bj < 2; ++bj) {
#pragma unroll
                    for (int j = 0; j < 2; ++j) {
                        acc[ai][bj][m][0][2 * j]     *= bf_lo(na[m][bj][j]) * __builtin_amdgcn_rcpf(bf_lo(nb[m][bj][j]));
                        acc[ai][bj][m][0][2 * j + 1] *= bf_hi(na[m][bj][j]) * __builtin_amdgcn_rcpf(bf_hi(nb[m][bj][j]));
                        acc[ai][bj][m][1][2 * j]     *= bf_lo(na[m][bj][2 + j]) * __builtin_amdgcn_rcpf(bf_lo(nb[m][bj][2 + j]));
                        acc[ai][bj][m][1][2 * j + 1] *= bf_hi(na[m][bj][2 + j]) * __builtin_amdgcn_rcpf(bf_hi(nb[m][bj][2 + j]));
                    }
                }
            asm volatile("" : "+v"(acc[ai][0][0][0]), "+v"(acc[ai][1][3][1]) :: "memory");
        }
    }
    __device__ __forceinline__ void operator()(const f32x4 (&acc)[2][2][4][2], const pg8::Unit& u, int wr, int wc, int fr, int fq) const {
        const int row0 = u.pm * 256 + wr * 64 + fr, col0 = u.pn * 256 + wc * 32 + 8 * fq;
#pragma unroll
        for (int ai = 0; ai < 2; ++ai)
#pragma unroll
            for (int m = 0; m < 4; ++m) {
                const int row = row0 + ai * 128 + m * 16;
#pragma unroll
                for (int bj = 0; bj < 2; ++bj) {
                    const u32x4 ng = *(const u32x4*)(G + (size_t)row * 6144 + 4096 + col0 + bj * 128);
                    const f32x4 a = acc[ai][bj][m][0], b = acc[ai][bj][m][1];
                    u32x4 w; w.x = pg8::cvt_pk_bf16(a[0] * bf_lo(ng[0]), a[1] * bf_hi(ng[0])); w.y = pg8::cvt_pk_bf16(a[2] * bf_lo(ng[1]), a[3] * bf_hi(ng[1]));
                    w.z = pg8::cvt_pk_bf16(b[0] * bf_lo(ng[2]), b[1] * bf_hi(ng[2])); w.w = pg8::cvt_pk_bf16(b[2] * bf_lo(ng[3]), b[3] * bf_hi(ng[3]));
                    *(u32x4*)(z + (size_t)row * D + col0 + bj * 128) = w;
                }
            }
    }
};

__device__ __forceinline__ void cvt_item(const float* __restrict__ W, int N, const float* __restrict__ scale, bf16* dst, int dpitch, int dcol, int mode, int kb, int nb, LAS unsigned* T, int lane) {
    const int k0 = kb * 64, n0 = nb * 64, kpl = lane >> 4, n4 = (lane & 15) * 4;
    f32x4 r0[8], r1[8];
#pragma unroll
    for (int i = 0; i < 8; ++i) { const int k = k0 + 2 * (4 * i + kpl); r0[i] = *(const f32x4*)(W + (size_t)k * N + n0 + n4); r1[i] = *(const f32x4*)(W + (size_t)(k + 1) * N + n0 + n4); }
#pragma unroll
    for (int i = 0; i < 8; ++i) { const int kp = 4 * i + kpl, k = k0 + 2 * kp; const float s0 = scale ? scale[k] : 1.f, s1 = scale ? scale[k + 1] : 1.f;
#pragma unroll
        for (int j = 0; j < 4; ++j) T[(n4 + j) * 33 + kp] = pk2(r0[i][j] * s0, r1[i][j] * s1); }
    LDS_WAIT(); asm volatile("" ::: "memory");
    const int q = lane & 7;
#pragma unroll
    for (int i = 0; i < 8; ++i) { const int n = 8 * i + (lane >> 3); const LAS unsigned* s = T + n * 33 + 4 * q;
        u32x4 o; o.x = s[0]; o.y = s[1]; o.z = s[2]; o.w = s[3];
        const int c = n0 + n; int drow = c;
        if (mode == 1) { drow = (c < FF) ? (256 * (c >> 7) + (c & 127)) : (256 * ((c - FF) >> 7) + 128 + ((c - FF) & 127)); }
        *(u32x4*)(dst + (size_t)drow * dpitch + dcol + k0 + 8 * q) = o; }
    LDS_WAIT(); asm volatile("" ::: "memory");
}

struct Args { const float* in[18]; float* out; unsigned char* ws; int ph_lo, ph_hi; };
typedef const __attribute__((address_space(4))) Args* KArgs;

__device__ __forceinline__ void prologue(KArgs a, LAS unsigned char* lds, int gw, int NGW, int wave, int lane) {
    LAS unsigned* T = (LAS unsigned*)(lds + wave * 16384);
    constexpr int I0 = 32 * 176, I1 = 88 * 32, I2 = 32 * 240, I3 = 8 * 32, I4 = 16 * 32, I5 = 16 * 32, I6 = 32 * 32, PER = 2 * I0 + 2 * I1 + I2 + I3 + I4 + I5 + I6;
    for (int it = gw; it < DEPTH * PER; it += NGW) {
        const int l = it / PER; int r = it % PER; unsigned char* wl = a->ws + WS_W + (size_t)l * W_LAYER;
        if (r < I0) { cvt_item(a->in[4] + (size_t)l * D * 2 * FF, 2 * FF, a->in[3] + l * D, (bf16*)(wl + W_1A), D, 0, 1, r / 176, r % 176, T, lane); continue; } r -= I0;
        if (r < I1) { cvt_item(a->in[5] + (size_t)l * FF * D, D, nullptr, (bf16*)(wl + W_1B), FF, 0, 0, r / 32, r % 32, T, lane); continue; } r -= I1;
        if (r < I2) { cvt_item(a->in[7] + (size_t)l * D * NIN, NIN, a->in[6] + l * D, (bf16*)(wl + W_IN), D, 0, 0, r / 240, r % 240, T, lane); continue; } r -= I2;
        if (r < I3) { cvt_item(a->in[11] + (size_t)l * 512 * D, D, nullptr, (bf16*)(wl + W_BR), KBR, 0, 0, r / 32, r % 32, T, lane); continue; } r -= I3;
        if (r < I4) { cvt_item(a->in[12] + (size_t)l * 1024 * D, D, nullptr, (bf16*)(wl + W_BR), KBR, 512, 0, r / 32, r % 32, T, lane); continue; } r -= I4;
        if (r < I5) { cvt_item(a->in[13] + (size_t)l * 1024 * D, D, nullptr, (bf16*)(wl + W_BR), KBR, 1536, 0, r / 32, r % 32, T, lane); continue; } r -= I5;
        if (r < I6) { cvt_item(a->in[14] + (size_t)l * D * D, D, nullptr, (bf16*)(wl + W_O), D, 0, 0, r / 32, r % 32, T, lane); continue; } r -= I6;
        if (r < I0) { cvt_item(a->in[16] + (size_t)l * D * 2 * FF, 2 * FF, a->in[15] + l * D, (bf16*)(wl + W_2A), D, 0, 1, r / 176, r % 176, T, lane); continue; } r -= I0;
        cvt_item(a->in[17] + (size_t)l * FF * D, D, nullptr, (bf16*)(wl + W_2B), FF, 0, 0, r / 32, r % 32, T, lane);
    }
    u64* rsq0 = (u64*)(a->ws + WS_RSQ); bf16* xb = (bf16*)(a->ws + WS_XB);
    for (int row = gw; row < M; row += NGW) {
        const float* src = row < 8192 ? a->in[0] + (size_t)row * D : a->in[1] + (size_t)(row - 8192) * D;
        f32x4 v[8]; float s = 0.f;
#pragma unroll
        for (int j = 0; j < 8; ++j) { v[j] = *(const f32x4*)(src + 256 * j + 4 * lane); s += (v[j][0] * v[j][0] + v[j][1] * v[j][1]) + (v[j][2] * v[j][2] + v[j][3] * v[j][3]); }
#pragma unroll
        for (int j = 0; j < 8; ++j) { *(f32x4*)(a->out + (size_t)row * D + 256 * j + 4 * lane) = v[j];
            u32x2 w; w.x = pk2(v[j][0], v[j][1]); w.y = pk2(v[j][2], v[j][3]); *(u32x2*)(xb + (size_t)row * D + 256 * j + 4 * lane) = w; }
        s = wave_sum(s);
        if (lane == 0) rsq0[row] = (u64)(s * SSQ_SCALE);
    }
}

__device__ __forceinline__ int t5_bucket_dev(int rel) {
    const int n = rel < 0 ? -rel : rel; int b;
    if (n < 8) b = n; else b = 8 + (n >= 15) + (n >= 27) + (n >= 50) + (n >= 91) + (n >= 166) + (n >= 305) + (n >= 559);
    return b + (rel > 0 ? 16 : 0);
}
__device__ __forceinline__ void seq_of(int row, int& base, int& L) { if (row < 8192) { base = 0; L = 8192; } else if (row < 12288) { base = 8192; L = 4096; } else { base = 12288; L = 4096; } }

__device__ __forceinline__ void qknorm_phase(unsigned char* ws, const float* qk_norm, int l, int gw, int NGW, int lane) {
    const float* qkg = qk_norm + (size_t)l * 6 * 128;
    for (int it = gw; it < M * 50; it += NGW) {
        const int row = it / 50, s = it % 50; size_t off; int ldc, h, gi;
        if (s < 12) { off = WS_QA; ldc = 1536; h = s; gi = 0; } else if (s < 24) { off = WS_KA; ldc = 1536; h = s - 12; gi = 1; }
        else if (s < 32) { off = WS_QB; ldc = 1024; h = s - 24; gi = 2; } else if (s < 34) { off = WS_KB; ldc = 256; h = s - 32; gi = 3; }
        else if (s < 42) { off = WS_QC; ldc = 1024; h = s - 34; gi = 4; } else { off = WS_KC; ldc = 1024; h = s - 42; gi = 5; }
        unsigned* p = (unsigned*)((bf16*)(ws + off) + (size_t)row * ldc + h * 128) + lane;
        const unsigned w = *p; const float v0 = bf_lo(w), v1 = bf_hi(w);
        const float ss = wave_sum(v0 * v0 + v1 * v1);
        const float r = rsqrtf(ss * (1.0f / 128.0f) + EPS);
        *p = pk2(v0 * r * qkg[gi * 128 + 2 * lane], v1 * r * qkg[gi * 128 + 2 * lane + 1]);
    }
}

__device__ __forceinline__ void attn_naive_phase(unsigned char* ws, const float* relb, const float* sink_all, const float* rpb_all, int l, LAS unsigned char* lds, int gw, int NGW, int wave, int lane) {
    LAS unsigned char* tab = lds + 8192;
    for (int n = wave * 64 + lane; n <= 1024; n += NWAVES * 64) tab[n] = (unsigned char)t5_bucket_dev(-n);
    __syncthreads();
    LAS float* pl = (LAS float*)(lds + wave * 16384); LAS int* tl = (LAS int*)(lds + wave * 16384 + 2048);
    const float* sink = sink_all + l * 8; const float* rpb = rpb_all + (size_t)l * 8 * 15 * 31;
    for (int it = gw; it < 28 * M; it += NGW) {
        const int h28 = it / M, row = it % M; int base, L; seq_of(row, base, L); const int t = row - base;
        if ((FAST_MASK >> (h28 < 12 ? 0 : (h28 < 20 ? 1 : 2))) & 1) continue;
        const bf16 *Q, *Kp, *Vp; int ldq, ldk, qoff, koff, nslots, type, g = 0, hh = 0, d = 1;
        if (h28 < 12) { type = 0; g = h28 >> 2; hh = h28 & 3; d = (g == 0) ? 1 : (g == 1 ? 4 : 16); Q = (const bf16*)(ws + WS_QA); Kp = (const bf16*)(ws + WS_KA); Vp = (const bf16*)(ws + WS_VA); ldq = 1536; ldk = 1536; qoff = h28 * 128; koff = h28 * 128; nslots = 129; }
        else if (h28 < 20) { type = 1; hh = h28 - 12; Q = (const bf16*)(ws + WS_QB); Kp = (const bf16*)(ws + WS_KB); Vp = (const bf16*)(ws + WS_VB); ldq = 1024; ldk = 256; qoff = hh * 128; koff = (hh >> 2) * 128; nslots = 257; }
        else { type = 2; hh = h28 - 20; Q = (const bf16*)(ws + WS_QC); Kp = (const bf16*)(ws + WS_KC); Vp = (const bf16*)(ws + WS_VC); ldq = 1024; ldk = 1024; qoff = hh * 128; koff = hh * 128; nslots = 128; }
        const int rows = L >> 6, r = t >> 6, c = t & 63; int rs = r - 4; rs = rs < 0 ? 0 : (rs > rows - 8 ? rows - 8 : rs); int qs = c - 8; qs = qs < 0 ? 0 : (qs > 48 ? 48 : qs);
        const bf16* qp = Q + (size_t)row * ldq + qoff;
        float mx = -1e30f;
#pragma unroll 1
        for (int j = lane; j < nslots; j += 64) {
            bool valid = true; int tk = t; float bias = 0.f;
            if (type == 0) { const int rel = (j - 64) * d; tk = t + rel; valid = tk >= 0 && tk < L; const int n = rel < 0 ? -rel : rel; bias = relb[((int)tab[n] + (rel > 0 ? 16 : 0)) * 20 + h28]; }
            else if (type == 1) { const int rel = j - 128; tk = t + rel; valid = tk >= 0 && tk < L; const int n = rel < 0 ? -rel : rel; bias = relb[((int)tab[n] + (rel > 0 ? 16 : 0)) * 20 + 12 + hh]; }
            else { const int kr = rs + (j >> 4), kc = qs + (j & 15); tk = kr * 64 + kc; bias = rpb[(hh * 15 + (kr - r + 7)) * 31 + (kc - c + 15)]; }
            if (!valid) tk = t;
            float dot = 0.f; const bf16* kp = Kp + (size_t)(base + tk) * ldk + koff;
#pragma unroll 4
            for (int ch = 0; ch < 16; ++ch) { const u32x4 kv = *(const u32x4*)(kp + 8 * ch); const u32x4 qv = *(const u32x4*)(qp + 8 * ch);
#pragma unroll
                for (int e = 0; e < 4; ++e) dot += bf_lo(qv[e]) * bf_lo(kv[e]) + bf_hi(qv[e]) * bf_hi(kv[e]); }
            const float sc = valid ? dot * 0.08838834764831845f + bias : -1e30f;
            mx = fmaxf(mx, sc);
            pl[j] = sc; tl[j] = tk;
        }
        mx = wave_max(mx);
        if (type == 1) mx = fmaxf(mx, sink[hh]);
        float den = 0.f;
#pragma unroll 1
        for (int j = lane; j < nslots; j += 64) { const float sc = pl[j]; const float p = (sc > -1e29f) ? __expf(sc - mx) : 0.f; den += p; pl[j] = p; }
        den = wave_sum(den);
        if (type == 1) den += __expf(sink[hh] - mx);
        LDS_WAIT(); asm volatile("" ::: "memory");
        float o0 = 0.f, o1 = 0.f;
#pragma unroll 4
        for (int j = 0; j < nslots; ++j) { const float p = pl[j]; const int tk = tl[j];
            const unsigned w = *(const unsigned*)(Vp + (size_t)(base + tk) * ldk + koff + 2 * lane); o0 += p * bf_lo(w); o1 += p * bf_hi(w); }
        const float inv = 1.0f / den; o0 *= inv; o1 *= inv;
        if (type == 0) { *(unsigned*)((bf16*)(ws + WS_OAG) + ((size_t)g * M + row) * 512 + hh * 128 + 2 * lane) = pk2(o0, o1);
            if (lane == 0) ((float*)(ws + WS_LSE))[((size_t)g * M + row) * 4 + hh] = mx + __logf(den); }
        else { *(unsigned*)((bf16*)(ws + WS_O) + (size_t)row * KBR + (type == 1 ? 512 : 1536) + hh * 128 + 2 * lane) = pk2(o0, o1); }
        LDS_WAIT(); asm volatile("" ::: "memory");
    }
}
__device__ __forceinline__ void combine_phase(unsigned char* ws, int gw, int NGW, int lane) {
    const float* lse = (const float*)(ws + WS_LSE); const bf16* oag = (const bf16*)(ws + WS_OAG); bf16* O = (bf16*)(ws + WS_O);
    for (int it = gw; it < M * 4; it += NGW) {
        const int row = it >> 2, hh = it & 3;
        const float l0 = lse[((size_t)0 * M + row) * 4 + hh], l1 = lse[((size_t)1 * M + row) * 4 + hh], l2 = lse[((size_t)2 * M + row) * 4 + hh];
        const float mx = fmaxf(l0, fmaxf(l1, l2)); float w0 = __expf(l0 - mx), w1 = __expf(l1 - mx), w2 = __expf(l2 - mx); const float inv = 1.0f / (w0 + w1 + w2); w0 *= inv; w1 *= inv; w2 *= inv;
        const unsigned a0 = *(const unsigned*)(oag + ((size_t)0 * M + row) * 512 + hh * 128 + 2 * lane), a1 = *(const unsigned*)(oag + ((size_t)1 * M + row) * 512 + hh * 128 + 2 * lane), a2 = *(const unsigned*)(oag + ((size_t)2 * M + row) * 512 + hh * 128 + 2 * lane);
        *(unsigned*)(O + (size_t)row * KBR + hh * 128 + 2 * lane) = pk2(w0 * bf_lo(a0) + w1 * bf_lo(a1) + w2 * bf_lo(a2), w0 * bf_hi(a0) + w1 * bf_hi(a1) + w2 * bf_hi(a2));
    }
}

__device__ __forceinline__ int vcu_of() { const int G = gridDim.x, bx = blockIdx.x; return (G % 8 == 0) ? (bx % 8) * (G / 8) + bx / 8 : bx; }
__device__ __forceinline__ int tid_of(int wave_s) { int t = wave_s * 64 + (int)__builtin_amdgcn_mbcnt_hi(~0u, __builtin_amdgcn_mbcnt_lo(~0u, 0u)); asm volatile("" : "+v"(t)); return t; }
typedef short v4i16_t __attribute__((ext_vector_type(4)));
typedef pg8::bf16x8 bf16x8;
constexpr int AT_TAB_OFF = RING_BYTES + 512;
constexpr int AT_BIAS_OFF = RING_BYTES + 2048;
static_assert(AT_BIAS_OFF + 1152 * 4 <= LDS_BYTES, "attention LDS map");
__device__ __forceinline__ unsigned off_b(unsigned row, unsigned ch) { return 256u * row + 16u * (ch ^ (((row & 3u) << 2) | ((row >> 2) & 3u))); }
__device__ __forceinline__ int clampi(int v, int lo, int hi) { return v < lo ? lo : (v > hi ? hi : v); }

struct TokLin { int base, pos0, d, r, lim; __device__ __forceinline__ bool operator()(int s, int& row) const { const int p = pos0 + s; row = base + p * d + r; return p >= 0 && p < lim; } };
struct TokGrid { int base, rlo, cs; __device__ __forceinline__ bool operator()(int s, int& row) const { row = base + (rlo + (s >> 5)) * 64 + cs + (s & 31); return true; } };

#define WG_SYNC() do { asm volatile("s_waitcnt lgkmcnt(0)" ::: "memory"); __builtin_amdgcn_s_barrier(); asm volatile("" ::: "memory"); } while (0)
constexpr int AT_GAIN_OFF = AT_BIAS_OFF + 1152 * 4;
static_assert(AT_GAIN_OFF + 768 * 4 <= LDS_BYTES, "attention LDS map");
template <int NPASS, class TokF>
__device__ __forceinline__ unsigned stage_load(const bf16* P, int ld, int npass, int tid, const TokF tokf, u32x4 (&v)[NPASS]) {
    const int ch = tid & 15, sl = tid >> 4; unsigned okm = 0u;
#pragma unroll
    for (int i = 0; i < NPASS; ++i) { v[i] = (u32x4){0u, 0u, 0u, 0u}; if (i < npass) { int row; const bool ok = tokf(sl + 32 * i, row); row = ok ? row : tokf.base; okm |= ok ? (1u << i) : 0u;
            v[i] = *(const u32x4*)(P + (size_t)row * ld + 8 * ch); } }
    return okm;
}
template <int NPASS, bool NORM>
__device__ __forceinline__ void stage_store(LAS unsigned char* lds, int npass, const LAS float* gain, int tid, const u32x4 (&v)[NPASS], unsigned okm) {
    const int ch = tid & 15, sl = tid >> 4;
    float gn[8];
    if (NORM) { const f32x4 a = *(const LAS f32x4*)(gain + 8 * ch), b = *(const LAS f32x4*)(gain + 8 * ch + 4); gn[0] = a[0]; gn[1] = a[1]; gn[2] = a[2]; gn[3] = a[3]; gn[4] = b[0]; gn[5] = b[1]; gn[6] = b[2]; gn[7] = b[3]; }
#pragma unroll
    for (int i = 0; i < NPASS; ++i) if (i < npass) {
        const bool ok = (okm >> i) & 1u;
        u32x4 w; w.x = ok ? v[i].x : 0u; w.y = ok ? v[i].y : 0u; w.z = ok ? v[i].z : 0u; w.w = ok ? v[i].w : 0u;
        if (NORM) {
            float f[8]; float ss = 0.f;
#pragma unroll
            for (int e = 0; e < 4; ++e) { f[2 * e] = bf_lo(w[e]); f[2 * e + 1] = bf_hi(w[e]); ss += f[2 * e] * f[2 * e] + f[2 * e + 1] * f[2 * e + 1]; }
            ss += __shfl_xor(ss, 1); ss += __shfl_xor(ss, 2); ss += __shfl_xor(ss, 4); ss += __shfl_xor(ss, 8);
            const float rs = rsqrtf(ss * (1.0f / 128.0f) + EPS);
#pragma unroll
            for (int e = 0; e < 4; ++e) w[e] = pg8::cvt_pk_bf16(f[2 * e] * rs * gn[2 * e], f[2 * e + 1] * rs * gn[2 * e + 1]);
        }
        *(LAS u32x4*)(lds + off_b((unsigned)(sl + 32 * i), (unsigned)ch)) = w;
    }
}
__device__ __forceinline__ void q_issue(const bf16* qrow, int g4, u32x4 (&raw)[4]) {
#pragma unroll
    for (int ks = 0; ks < 4; ++ks) raw[ks] = *(const u32x4*)(qrow + 32 * ks + 8 * g4);
}
template <bool NORM>
__device__ __forceinline__ void q_finish(u32x4 (&raw)[4], const LAS float* gq, int g4, bf16x8 (&qf)[4]) {
    if (NORM) {
        float ss = 0.f;
#pragma unroll
        for (int ks = 0; ks < 4; ++ks)
#pragma unroll
            for (int e = 0; e < 4; ++e) { const float a = bf_lo(raw[ks][e]), b = bf_hi(raw[ks][e]); ss += a * a + b * b; }
        ss += __shfl_xor(ss, 16); ss += __shfl_xor(ss, 32);
        const float rs = rsqrtf(ss * (1.0f / 128.0f) + EPS);
#pragma unroll
        for (int ks = 0; ks < 4; ++ks) { const f32x4 ga = *(const LAS f32x4*)(gq + 32 * ks + 8 * g4), gb = *(const LAS f32x4*)(gq + 32 * ks + 8 * g4 + 4);
            raw[ks][0] = pg8::cvt_pk_bf16(bf_lo(raw[ks][0]) * rs * ga[0], bf_hi(raw[ks][0]) * rs * ga[1]); raw[ks][1] = pg8::cvt_pk_bf16(bf_lo(raw[ks][1]) * rs * ga[2], bf_hi(raw[ks][1]) * rs * ga[3]);
            raw[ks][2] = pg8::cvt_pk_bf16(bf_lo(raw[ks][2]) * rs * gb[0], bf_hi(raw[ks][2]) * rs * gb[1]); raw[ks][3] = pg8::cvt_pk_bf16(bf_lo(raw[ks][3]) * rs * gb[2], bf_hi(raw[ks][3]) * rs * gb[3]); }
    }
#pragma unroll
    for (int ks = 0; ks < 4; ++ks) qf[ks] = __builtin_bit_cast(bf16x8, raw[ks]);
}
template <int NT>
__device__ __forceinline__ void st_tiles(LAS unsigned char* lds, int slot0, const bf16x8 (&qf)[4], int lane, f32x4 (&S)[NT]) {
    const unsigned i = lane & 15, g4 = lane >> 4;
    unsigned ko[4];
#pragma unroll
    for (int ks = 0; ks < 4; ++ks) ko[ks] = off_b(i, 4u * ks + g4);
    LAS unsigned char* base = lds + 256 * slot0;
#pragma unroll
    for (int kk = 0; kk < NT; ++kk) {
        f32x4 acc = (f32x4){0.f, 0.f, 0.f, 0.f};
#pragma unroll
        for (int ks = 0; ks < 4; ++ks) { const bf16x8 a = *(const LAS bf16x8*)(base + 4096 * kk + ko[ks]); acc = __builtin_amdgcn_mfma_f32_16x16x32_bf16(a, qf[ks], acc, 0, 0, 0); }
        S[kk] = acc;
    }
}
template <int NT>
__device__ __forceinline__ void softmax_pack(f32x4 (&S)[NT], float extra, bf16x8 (&P)[(NT + 1) / 2], float& inv_l, float& lse) {
    float m = extra;
#pragma unroll
    for (int kk = 0; kk < NT; ++kk) m = fmaxf(m, fmaxf(fmaxf(S[kk][0], S[kk][1]), fmaxf(S[kk][2], S[kk][3])));
    m = fmaxf(m, __shfl_xor(m, 16)); m = fmaxf(m, __shfl_xor(m, 32));
    float l = 0.f;
#pragma unroll
    for (int kk = 0; kk < NT; ++kk)
#pragma unroll
        for (int r = 0; r < 4; ++r) { const float p = __expf(S[kk][r] - m); S[kk][r] = p; l += p; }
    l += __shfl_xor(l, 16); l += __shfl_xor(l, 32);
    l += __expf(extra - m);
    inv_l = 1.0f / l; lse = m + __logf(l);
#pragma unroll
    for (int s = 0; s < (NT + 1) / 2; ++s) {
        u32x4 w; w.x = pg8::cvt_pk_bf16(S[2 * s][0], S[2 * s][1]); w.y = pg8::cvt_pk_bf16(S[2 * s][2], S[2 * s][3]);
        if (2 * s + 1 < NT) { w.z = pg8::cvt_pk_bf16(S[2 * s + 1][0], S[2 * s + 1][1]); w.w = pg8::cvt_pk_bf16(S[2 * s + 1][2], S[2 * s + 1][3]); } else { w.z = 0u; w.w = 0u; }
        P[s] = __builtin_bit_cast(bf16x8, w);
    }
}
template <int NT>
__device__ __forceinline__ void pv_tile(LAS unsigned char* lds, int slot0, const bf16x8 (&P)[(NT + 1) / 2], int lane, f32x4 (&O)[8]) {
    const unsigned g4 = lane >> 4, qq = (lane & 15) >> 2, p = lane & 3, rl = 4 * g4 + qq;
    unsigned vo[8];
#pragma unroll
    for (int c = 0; c < 8; ++c) vo[c] = off_b(rl, 2u * c + (p >> 1)) + 8u * (p & 1);
    LAS unsigned char* base = lds + 256 * slot0;
#pragma unroll
    for (int c = 0; c < 8; ++c) O[c] = (f32x4){0.f, 0.f, 0.f, 0.f};
#pragma unroll
    for (int s = 0; s < (NT + 1) / 2; ++s) {
        const int t0 = 2 * s, t1 = (2 * s + 1 < NT) ? 2 * s + 1 : NT - 1;
#pragma unroll
        for (int c = 0; c < 8; ++c) {
            const v4i16_t lo = __builtin_amdgcn_ds_read_tr16_b64_v4i16((LAS v4i16_t*)(base + 4096 * t0 + vo[c]));
            const v4i16_t hi = __builtin_amdgcn_ds_read_tr16_b64_v4i16((LAS v4i16_t*)(base + 4096 * t1 + vo[c]));
            const bf16x8 a = __builtin_shufflevector(lo, hi, 0, 1, 2, 3, 4, 5, 6, 7);
            O[c] = __builtin_amdgcn_mfma_f32_16x16x32_bf16(a, P[s], O[c], 0, 0, 0);
        }
    }
}
__device__ __forceinline__ void store_o(bf16* orow, const f32x4 (&O)[8], float inv_l, int g4) {
#pragma unroll
    for (int c = 0; c < 8; ++c) { u32x2 w; w.x = pg8::cvt_pk_bf16(O[c][0] * inv_l, O[c][1] * inv_l); w.y = pg8::cvt_pk_bf16(O[c][2] * inv_l, O[c][3] * inv_l); *(u32x2*)(orow + 16 * c + 4 * g4) = w; }
}

constexpr float QK_SCALE = 0.08838834764831845f;
constexpr int NU_A = 1536, NU_B = 512, NU_C = 1024;

struct DescA { int head12, g, hh, d, base, Ls, r, qb, pos0; };
__device__ __forceinline__ DescA decode_A(int u) {
    DescA D_; const int part = u >= 768, uu = part ? u - 768 : u; D_.head12 = uu >> 6; int rem = uu & 63;
    D_.g = D_.head12 >> 2; D_.hh = D_.head12 & 3; D_.d = (D_.g == 0) ? 1 : (D_.g == 1 ? 4 : 16);
    int L = 8192, nbq = 64 / D_.d; D_.base = 0;
    if (part) { const int seq = rem >> 5; rem &= 31; D_.base = 8192 + 4096 * seq; L = 4096; nbq = 32 / D_.d; }
    D_.r = rem / nbq; D_.qb = rem % nbq; D_.Ls = L / D_.d; D_.pos0 = 128 * D_.qb - 64; return D_;
}
__device__ __forceinline__ void run_A(unsigned char* ws, const float* relb, LAS unsigned char* lds, int u0, int u1, int wave_s) {
    if (u0 >= u1) return;
    LAS float* bv = (LAS float*)(lds + AT_BIAS_OFF); LAS unsigned char* tab = lds + AT_TAB_OFF; const LAS float* gains = (const LAS float*)(lds + AT_GAIN_OFF);
    DescA d = decode_A(u0);
    u32x4 kreg[8]; unsigned kok;
    { const int tid = tid_of(wave_s); const TokLin tk{d.base, d.pos0, d.d, d.r, d.Ls}; kok = stage_load<8>((const bf16*)(ws + WS_KA) + d.head12 * 128, 1536, 8, tid, tk, kreg); }
    for (int u = u0; u < u1; ++u) {
        const int tid = tid_of(wave_s), lane = tid & 63, wave = __builtin_amdgcn_readfirstlane(tid >> 6), q = lane & 15, g4 = lane >> 4;
        const TokLin tokf{d.base, d.pos0, d.d, d.r, d.Ls};
        if (tid < 160) { const int dl = tid - 80; float b = 0.f; if (dl >= -64 && dl <= 64) { const int rel = dl * d.d, n = rel < 0 ? -rel : rel; b = relb[((int)tab[n] + (rel > 0 ? 16 : 0)) * 20 + d.head12]; } bv[tid] = b; }
        stage_store<8, NORM_ON_LOAD != 0>(lds, 8, gains + 128, tid, kreg, kok);
        const int qrow = d.base + (128 * d.qb + 16 * wave + q) * d.d + d.r;
        u32x4 qraw[4]; q_issue((const bf16*)(ws + WS_QA) + (size_t)qrow * 1536 + d.head12 * 128, g4, qraw);
        u32x4 vreg[8]; const unsigned vok = stage_load<8>((const bf16*)(ws + WS_VA) + d.head12 * 128, 1536, 8, tid, tokf, vreg);
        WG_SYNC();
        bf16x8 qf[4]; q_finish<NORM_ON_LOAD != 0>(qraw, gains, g4, qf);
        f32x4 S[9]; st_tiles<9>(lds, 16 * wave, qf, lane, S);
        const LAS float* bvq = bv + (4 * g4 - q + 16);
#pragma unroll
        for (int kk = 0; kk < 9; ++kk)
#pragma unroll
            for (int rr = 0; rr < 4; ++rr) {
                const int delta = 16 * kk + 4 * g4 + rr - q - 64, p = d.pos0 + 16 * (wave + kk) + 4 * g4 + rr;
                const bool ok = delta >= -64 && delta <= 64 && p >= 0 && p < d.Ls;
                { const float sb = S[kk][rr] * QK_SCALE + bvq[16 * kk + rr]; S[kk][rr] = ok ? sb : -1e30f; }
            }
        bf16x8 P[5]; float inv_l, lse; softmax_pack<9>(S, -1e30f, P, inv_l, lse);
        WG_SYNC();
        stage_store<8, false>(lds, 8, nullptr, tid, vreg, vok);
        DescA dn = d;
        if (u + 1 < u1) { dn = decode_A(u + 1); const TokLin tkn{dn.base, dn.pos0, dn.d, dn.r, dn.Ls}; kok = stage_load<8>((const bf16*)(ws + WS_KA) + dn.head12 * 128, 1536, 8, tid, tkn, kreg); }
        WG_SYNC();
        f32x4 O[8]; pv_tile<9>(lds, 16 * wave, P, lane, O);
        store_o((bf16*)(ws + WS_OAG) + ((size_t)d.g * M + qrow) * 512 + d.hh * 128, O, inv_l, g4);
        if (g4 == 0) ((float*)(ws + WS_LSE))[((size_t)d.g * M + qrow) * 4 + d.hh] = lse;
        WG_SYNC();
        d = dn;
    }
}
struct DescB { int kvh, base, L, qb, pos0; };
__device__ __forceinline__ DescB decode_B(int u) {
    DescB D_; const int part = u >= 256, uu = part ? u - 256 : u; D_.kvh = uu >> 7; const int rem = uu & 127;
    D_.base = 0; D_.L = 8192; D_.qb = rem;
    if (part) { const int seq = rem >> 6; D_.qb = rem & 63; D_.base = 8192 + 4096 * seq; D_.L = 4096; }
    D_.pos0 = 64 * D_.qb - 128; return D_;
}
__device__ __forceinline__ void run_B(unsigned char* ws, const float* relb, const float* sinkl, LAS unsigned char* lds, int u0, int u1, int wave_s) {
    if (u0 >= u1) return;
    LAS float* bv = (LAS float*)(lds + AT_BIAS_OFF); LAS unsigned char* tab = lds + AT_TAB_OFF; const LAS float* gains = (const LAS float*)(lds + AT_GAIN_OFF);
    DescB d = decode_B(u0);
    u32x4 kreg[10]; unsigned kok;
    { const int tid = tid_of(wave_s); const TokLin tk{d.base, d.pos0, 1, 0, d.L}; kok = stage_load<10>((const bf16*)(ws + WS_KB) + d.kvh * 128, 256, 10, tid, tk, kreg); }
    for (int u = u0; u < u1; ++u) {
        const int tid = tid_of(wave_s), lane = tid & 63, wave = __builtin_amdgcn_readfirstlane(tid >> 6), q = lane & 15, g4 = lane >> 4;
        const int hl = wave & 3, hq = 4 * d.kvh + hl;
        const TokLin tokf{d.base, d.pos0, 1, 0, d.L};
        for (int e = tid; e < 1152; e += NWAVES * 64) { const int h = e / 288, dl = e % 288 - 144; float b = 0.f; if (dl >= -128 && dl <= 128) { const int n = dl < 0 ? -dl : dl; b = relb[((int)tab[n] + (dl > 0 ? 16 : 0)) * 20 + 12 + 4 * d.kvh + h]; } bv[e] = b; }
        stage_store<10, NORM_ON_LOAD != 0>(lds, 10, gains + 3 * 128, tid, kreg, kok);
        const int tq0 = 2 * (wave >> 2), qrow0 = d.base + 64 * d.qb + 16 * tq0 + q;
        const bf16* qbase = (const bf16*)(ws + WS_QB) + hq * 128;
        u32x4 qraw0[4]; q_issue(qbase + (size_t)qrow0 * 1024, g4, qraw0);
        const float snk = sinkl[hq];
        u32x4 vreg[10]; const unsigned vok = stage_load<10>((const bf16*)(ws + WS_VB) + d.kvh * 128, 256, 10, tid, tokf, vreg);
        WG_SYNC();
        bf16x8 P[2][9]; float inv_l[2];
#pragma unroll
        for (int tt = 0; tt < 2; ++tt) {
            const int tq = tq0 + tt;
            u32x4 qraw[4];
            if (tt == 0) {
#pragma unroll
                for (int ks = 0; ks < 4; ++ks) qraw[ks] = qraw0[ks];
            } else q_issue(qbase + (size_t)(qrow0 + 16) * 1024, g4, qraw);
            bf16x8 qf[4]; q_finish<NORM_ON_LOAD != 0>(qraw, gains + 2 * 128, g4, qf);
            f32x4 S[17]; st_tiles<17>(lds, 16 * tq, qf, lane, S);
            const LAS float* bvq = bv + hl * 288 + (4 * g4 - q + 16);
#pragma unroll
            for (int kk = 0; kk < 17; ++kk)
#pragma unroll
                for (int rr = 0; rr < 4; ++rr) {
                    const int delta = 16 * kk + 4 * g4 + rr - q - 128, p = d.pos0 + 16 * (tq + kk) + 4 * g4 + rr;
                    const bool ok = delta >= -128 && delta <= 128 && p >= 0 && p < d.L;
                    { const float sb = S[kk][rr] * QK_SCALE + bvq[16 * kk + rr]; S[kk][rr] = ok ? sb : -1e30f; }
                }
            float lse; softmax_pack<17>(S, snk, P[tt], inv_l[tt], lse);
        }
        WG_SYNC();
        stage_store<10, false>(lds, 10, nullptr, tid, vreg, vok);
        DescB dn = d;
        if (u + 1 < u1) { dn = decode_B(u + 1); const TokLin tkn{dn.base, dn.pos0, 1, 0, dn.L}; kok = stage_load<10>((const bf16*)(ws + WS_KB) + dn.kvh * 128, 256, 10, tid, tkn, kreg); }
        WG_SYNC();
#pragma unroll
        for (int tt = 0; tt < 2; ++tt) {
            const int tq = tq0 + tt, qrow = qrow0 + 16 * tt;
            f32x4 O[8]; pv_tile<17>(lds, 16 * tq, P[tt], lane, O);
            store_o((bf16*)(ws + WS_O) + (size_t)qrow * KBR + 512 + hq * 128, O, inv_l[tt], g4);
        }
        WG_SYNC();
        d = dn;
    }
}
struct DescC { int h, base, rows, cb, r0, rlo, nrows, cs; };
__device__ __forceinline__ DescC decode_C(int u) {
    DescC D_; const int part = u >= 512, uu = part ? u - 512 : u; D_.h = uu >> 6; int rem = uu & 63;
    D_.base = 0; D_.rows = 128; D_.cb = rem >> 4; int rb = rem & 15;
    if (part) { const int seq = rem >> 5; rem &= 31; D_.base = 8192 + 4096 * seq; D_.rows = 64; D_.cb = rem >> 3; rb = rem & 7; }
    D_.r0 = 8 * rb; D_.rlo = clampi(D_.r0 - 4, 0, D_.rows - 8); const int rhi = clampi(D_.r0 + 3, 0, D_.rows - 8) + 7; D_.nrows = rhi - D_.rlo + 1; D_.cs = clampi(16 * D_.cb - 8, 0, 32); return D_;
}
__device__ __forceinline__ void run_C(unsigned char* ws, const float* rpbl, LAS unsigned char* lds, int u0, int u1, int wave_s) {
    if (u0 >= u1) return;
    LAS float* bv = (LAS float*)(lds + AT_BIAS_OFF); const LAS float* gains = (const LAS float*)(lds + AT_GAIN_OFF);
    DescC d = decode_C(u0);
    u32x4 kreg[15]; unsigned kok;
    { const int tid = tid_of(wave_s); const TokGrid tk{d.base, d.rlo, d.cs}; kok = stage_load<15>((const bf16*)(ws + WS_KC) + d.h * 128, 1024, d.nrows, tid, tk, kreg); }
    for (int u = u0; u < u1; ++u) {
        const int tid = tid_of(wave_s), lane = tid & 63, wave = __builtin_amdgcn_readfirstlane(tid >> 6), q = lane & 15, g4 = lane >> 4;
        const TokGrid tokf{d.base, d.rlo, d.cs};
        if (tid < 465) bv[tid] = rpbl[d.h * 465 + tid];
        stage_store<15, NORM_ON_LOAD != 0>(lds, d.nrows, gains + 5 * 128, tid, kreg, kok);
        const int r = d.r0 + wave, rsw = clampi(r - 4, 0, d.rows - 8), c = 16 * d.cb + q, qs = clampi(c - 8, 0, 48), qrow = d.base + r * 64 + c;
        u32x4 qraw[4]; q_issue((const bf16*)(ws + WS_QC) + (size_t)qrow * 1024 + d.h * 128, g4, qraw);
        u32x4 vreg[15]; const unsigned vok = stage_load<15>((const bf16*)(ws + WS_VC) + d.h * 128, 1024, d.nrows, tid, tokf, vreg);
        WG_SYNC();
        bf16x8 qf[4]; q_finish<NORM_ON_LOAD != 0>(qraw, gains + 4 * 128, g4, qf);
        f32x4 S[16]; st_tiles<16>(lds, 32 * (rsw - d.rlo), qf, lane, S);
#pragma unroll
        for (int kk = 0; kk < 16; ++kk)
#pragma unroll
            for (int rr = 0; rr < 4; ++rr) {
                const int kc = d.cs + 16 * (kk & 1) + 4 * g4 + rr, dr = rsw + (kk >> 1) - r, dc = kc - c;
                const bool ok = kc >= qs && kc < qs + 16;
                { const float sb = S[kk][rr] * QK_SCALE + bv[(dr + 7) * 31 + clampi(dc + 15, 0, 30)]; S[kk][rr] = ok ? sb : -1e30f; }
            }
        bf16x8 P[8]; float inv_l, lse; softmax_pack<16>(S, -1e30f, P, inv_l, lse);
        WG_SYNC();
        stage_store<15, false>(lds, d.nrows, nullptr, tid, vreg, vok);
        DescC dn = d;
        if (u + 1 < u1) { dn = decode_C(u + 1); const TokGrid tkn{dn.base, dn.rlo, dn.cs}; kok = stage_load<15>((const bf16*)(ws + WS_KC) + dn.h * 128, 1024, dn.nrows, tid, tkn, kreg); }
        WG_SYNC();
        f32x4 O[8]; pv_tile<16>(lds, 32 * (rsw - d.rlo), P, lane, O);
        store_o((bf16*)(ws + WS_O) + (size_t)qrow * KBR + 1536 + d.h * 128, O, inv_l, g4);
        WG_SYNC();
        d = dn;
    }
}
__device__ __forceinline__ void attn_fast_phase(unsigned char* ws, const float* relb, const float* qk_norm, const float* sink_all, const float* rpb_all, int l, LAS unsigned char* lds, int wave_s) {
    { const int tid = tid_of(wave_s); LAS unsigned char* tab = lds + AT_TAB_OFF; LAS float* gains = (LAS float*)(lds + AT_GAIN_OFF);
      for (int n = tid; n <= 1024; n += NWAVES * 64) tab[n] = (unsigned char)t5_bucket_dev(-n);
      for (int n = tid; n < 768; n += NWAVES * 64) gains[n] = qk_norm[(size_t)l * 768 + n]; }
    __syncthreads();
    const float* sinkl = sink_all + l * 8; const float* rpbl = rpb_all + (size_t)l * 8 * 465;
    const int G = gridDim.x, vcu = vcu_of();
    if (FAST_MASK & 1) { const int per = (NU_A + G - 1) / G, u0 = vcu * per, u1 = (u0 + per < NU_A) ? u0 + per : NU_A; run_A(ws, relb, lds, u0, u1, wave_s); }
    if (FAST_MASK & 2) { const int per = (NU_B + G - 1) / G, u0 = vcu * per, u1 = (u0 + per < NU_B) ? u0 + per : NU_B; run_B(ws, relb, sinkl, lds, u0, u1, wave_s); }
    if (FAST_MASK & 4) { const int per = (NU_C + G - 1) / G, u0 = vcu * per, u1 = (u0 + per < NU_C) ? u0 + per : NU_C; run_C(ws, rpbl, lds, u0, u1, wave_s); }
}

constexpr int NP = 10;
enum { PH_UP1 = 0, PH_DN1, PH_IN, PH_QKN, PH_ATT, PH_CMB, PH_BR, PH_OUT, PH_UP2, PH_DN2 };
constexpr int NPH = 1 + DEPTH * NP;

__device__ __forceinline__ KArgs kargs() { u64 p = (u64)__builtin_amdgcn_kernarg_segment_ptr(); asm volatile("" : "+s"(p)); return (KArgs)p; }

__global__ void __launch_bounds__(NWAVES * 64, 2) fwd(Args args) {
    extern __shared__ __attribute__((aligned(16))) unsigned char lds_raw[];
    LAS unsigned char* lds = (LAS unsigned char*)lds_raw;
    const int wave_s = __builtin_amdgcn_readfirstlane((int)threadIdx.x >> 6);
#define OTID() tid_of(wave_s)
    { const int tid = OTID(); for (int u = tid; u < (LDS_BYTES - RING_BYTES) / 4; u += NWAVES * 64) ((LAS unsigned*)(lds + RING_BYTES))[u] = 0u; }
    __syncthreads();
    if (ONE_LAUNCH) (void)xcd_barrier_post((unsigned*)(kargs()->ws + WS_CTL) + CW_BAR, (volatile LAS unsigned*)(lds + MISC_OFF) + 8, OTID());
    const int lo = args.ph_lo, hi = args.ph_hi;
#define IN(k) (lo <= (k) && (k) < hi)
#define SEAM(k) do { if (ONE_LAUNCH && IN(k) && IN((k) + 1)) { XcdBarrier b_; b_.bar = (unsigned*)(kargs()->ws + WS_CTL) + CW_BAR; b_.x = xb_xcc_id(); b_.st = (volatile LAS unsigned*)(lds + MISC_OFF) + 8; xcd_barrier(b_, OTID()); if ((PROBE_DUP >> 7) & 1) xcd_barrier(b_, OTID()); } } while (0)
#define TIDS() const int tid = OTID(), lane = tid & 63, wave = __builtin_amdgcn_readfirstlane(tid >> 6); const int gw = vcu_of() * NWAVES + wave, NGW = (int)gridDim.x * NWAVES; (void)lane; (void)gw; (void)NGW

    for (int rep = 0; rep <= (PROBE_DUP & 1); ++rep)
    if (IN(0)) { KArgs ka = kargs(); TIDS(); prologue(ka, lds, gw, NGW, wave, lane); __syncthreads(); }
    SEAM(0);
    for (int l = 0; l < DEPTH; ++l) {
        const int g0 = 1 + l * NP;
        for (int rep = 0; rep <= ((PROBE_DUP >> 1) & 1); ++rep)
        if (IN(g0 + PH_UP1)) {
            KArgs ka = kargs(); unsigned char* ws = ka->ws; unsigned char* wl = ws + WS_W + (size_t)l * W_LAYER;
            pg8::Gemm g{(const bf16*)(ws + WS_XB), (const bf16*)(wl + W_1A), M, 2 * FF, D}; pg8::StaticOrder S; S.init(M, 2 * FF, (int)gridDim.x, (int)blockIdx.x);
            EpiUp E{(bf16*)(ws + WS_ACT), (const u64*)(ws + WS_RSQ) + (size_t)(3 * l + 0) * M};
            if ((PROBE_DUP >> 8) & 1) { S.r1 = 5; pg8::gemm_phase<EpiUp, pg8::StaticOrder, GEMM_ALIGN, GEMM_SP2>(lds, g, S, E, OTID());
                { XcdBarrier b_; b_.bar = (unsigned*)(kargs()->ws + WS_CTL) + CW_BAR; b_.x = xb_xcc_id(); b_.st = (volatile LAS unsigned*)(lds + MISC_OFF) + 8; xcd_barrier(b_, OTID()); } S.r0 = 5; S.r1 = 1 << 30; }
            pg8::gemm_phase<EpiUp, pg8::StaticOrder, GEMM_ALIGN, GEMM_SP2>(lds, g, S, E, OTID());
        }
        if ((PROBE_DUP >> 6) & 1) if (IN(g0 + PH_UP1)) {
            KArgs ka = kargs(); unsigned char* ws = ka->ws; unsigned char* wl = ws + WS_W + (size_t)l * W_LAYER;
            pg8::Gemm g{(const bf16*)(ws + WS_XB), (const bf16*)(wl + W_1A), M, 2 * FF, D}; pg8::StaticOrder S; S.init(M, 2 * FF, (int)gridDim.x, (int)blockIdx.x);
            EpiNull E{};
            pg8::gemm_phase<EpiNull, pg8::StaticOrder, GEMM_ALIGN, GEMM_SP2>(lds, g, S, E, OTID());
        }
        SEAM(g0 + PH_UP1);
        if (IN(g0 + PH_DN1)) {
            KArgs ka = kargs(); unsigned char* ws = ka->ws; unsigned char* wl = ws + WS_W + (size_t)l * W_LAYER;
            pg8::Gemm g{(const bf16*)(ws + WS_ACT), (const bf16*)(wl + W_1B), M, D, FF}; pg8::StaticOrder S; S.init(M, D, (int)gridDim.x, (int)blockIdx.x);
            EpiRes<1> E{ka->out, (bf16*)(ws + WS_XB), (u64*)(ws + WS_RSQ) + (size_t)(3 * l + 1) * M};
            pg8::gemm_phase<EpiRes<1>, pg8::StaticOrder, GEMM_ALIGN, GEMM_SP2>(lds, g, S, E, OTID());
        }
        if ((PROBE_DUP >> 9) & 1) if (IN(g0 + PH_DN1)) {
            KArgs ka = kargs(); unsigned char* ws = ka->ws; unsigned char* wl = ws + WS_W + (size_t)l * W_LAYER;
            pg8::Gemm g{(const bf16*)(ws + WS_ACT), (const bf16*)(wl + W_1B), M, D, FF}; pg8::StaticOrder S; S.init(M, D, (int)gridDim.x, (int)blockIdx.x);
            if ((PROBE_DUP >> 10) & 1) { g.ablk = true; g.bblk = true; }
            EpiNull E{};
            pg8::gemm_phase<EpiNull, pg8::StaticOrder, GEMM_ALIGN, GEMM_SP2>(lds, g, S, E, OTID());
        }
        SEAM(g0 + PH_DN1);
        for (int rep = 0; rep <= ((PROBE_DUP >> 2) & 1); ++rep)
        if (IN(g0 + PH_IN)) {
            KArgs ka = kargs(); unsigned char* ws = ka->ws; unsigned char* wl = ws + WS_W + (size_t)l * W_LAYER;
            pg8::Gemm g{(const bf16*)(ws + WS_XB), (const bf16*)(wl + W_IN), M, NIN, D}; pg8::StaticOrder S; S.init(M, NIN, (int)gridDim.x, (int)blockIdx.x);
            EpiIn E{ws, (const u64*)(ws + WS_RSQ) + (size_t)(3 * l + 1) * M, ka->in[8] + (size_t)l * 768, lds};
            pg8::gemm_phase<EpiIn, pg8::StaticOrder, GEMM_ALIGN, GEMM_SP2>(lds, g, S, E, OTID());
        }
        SEAM(g0 + PH_IN);
        if (!NORM_ON_LOAD && !QKN_IN_EPI && IN(g0 + PH_QKN)) { KArgs ka = kargs(); TIDS(); qknorm_phase(ka->ws, ka->in[8], l, gw, NGW, lane); }
        SEAM(g0 + PH_QKN);
        for (int rep = 0; rep <= ((PROBE_DUP >> 3) & 1); ++rep)
        if (IN(g0 + PH_ATT)) {
            if (FAST_MASK != 0) { KArgs ka = kargs(); attn_fast_phase(ka->ws, ka->in[2], ka->in[8], ka->in[9], ka->in[10], l, lds, wave_s); __syncthreads(); }
            if (FAST_MASK != 7) { KArgs ka = kargs(); TIDS(); attn_naive_phase(ka->ws, ka->in[2], ka->in[9], ka->in[10], l, lds, gw, NGW, wave, lane); __syncthreads(); }
        }
        SEAM(g0 + PH_ATT);
        for (int rep = 0; rep <= ((PROBE_DUP >> 4) & 1); ++rep)
        if (IN(g0 + PH_CMB)) { KArgs ka = kargs(); TIDS(); combine_phase(ka->ws, gw, NGW, lane); }
        SEAM(g0 + PH_CMB);
        for (int rep = 0; rep <= ((PROBE_DUP >> 5) & 1); ++rep)
        if (IN(g0 + PH_BR)) {
            KArgs ka = kargs(); unsigned char* ws = ka->ws; unsigned char* wl = ws + WS_W + (size_t)l * W_LAYER;
            pg8::Gemm g{(const bf16*)(ws + WS_O), (const bf16*)(wl + W_BR), M, D, KBR}; pg8::StaticOrder S; S.init(M, D, (int)gridDim.x, (int)blockIdx.x);
            EpiBr E{(const bf16*)(ws + WS_G), (bf16*)(ws + WS_Z)};
            pg8::gemm_phase<EpiBr, pg8::StaticOrder, GEMM_ALIGN, GEMM_SP2>(lds, g, S, E, OTID());
        }
        SEAM(g0 + PH_BR);
        if (IN(g0 + PH_OUT)) {
            KArgs ka = kargs(); unsigned char* ws = ka->ws; unsigned char* wl = ws + WS_W + (size_t)l * W_LAYER;
            pg8::Gemm g{(const bf16*)(ws + WS_Z), (const bf16*)(wl + W_O), M, D, D}; pg8::StaticOrder S; S.init(M, D, (int)gridDim.x, (int)blockIdx.x);
            EpiRes<0> E{ka->out, (bf16*)(ws + WS_XB), (u64*)(ws + WS_RSQ) + (size_t)(3 * l + 2) * M};
            pg8::gemm_phase<EpiRes<0>, pg8::StaticOrder, GEMM_ALIGN, GEMM_SP2>(lds, g, S, E, OTID());
        }
        SEAM(g0 + PH_OUT);
        for (int rep = 0; rep <= ((PROBE_DUP >> 1) & 1); ++rep)
        if (IN(g0 + PH_UP2)) {
            KArgs ka = kargs(); unsigned char* ws = ka->ws; unsigned char* wl = ws + WS_W + (size_t)l * W_LAYER;
            pg8::Gemm g{(const bf16*)(ws + WS_XB), (const bf16*)(wl + W_2A), M, 2 * FF, D}; pg8::StaticOrder S; S.init(M, 2 * FF, (int)gridDim.x, (int)blockIdx.x);
            EpiUp E{(bf16*)(ws + WS_ACT), (const u64*)(ws + WS_RSQ) + (size_t)(3 * l + 2) * M};
            if ((PROBE_DUP >> 8) & 1) { S.r1 = 5; pg8::gemm_phase<EpiUp, pg8::StaticOrder, GEMM_ALIGN, GEMM_SP2>(lds, g, S, E, OTID());
                { XcdBarrier b_; b_.bar = (unsigned*)(kargs()->ws + WS_CTL) + CW_BAR; b_.x = xb_xcc_id(); b_.st = (volatile LAS unsigned*)(lds + MISC_OFF) + 8; xcd_barrier(b_, OTID()); } S.r0 = 5; S.r1 = 1 << 30; }
            pg8::gemm_phase<EpiUp, pg8::StaticOrder, GEMM_ALIGN, GEMM_SP2>(lds, g, S, E, OTID());
        }
        SEAM(g0 + PH_UP2);
        if (IN(g0 + PH_DN2)) {
            KArgs ka = kargs(); unsigned char* ws = ka->ws; unsigned char* wl = ws + WS_W + (size_t)l * W_LAYER;
            pg8::Gemm g{(const bf16*)(ws + WS_ACT), (const bf16*)(wl + W_2B), M, D, FF}; pg8::StaticOrder S; S.init(M, D, (int)gridDim.x, (int)blockIdx.x);
            EpiRes<1> E{ka->out, (bf16*)(ws + WS_XB), (u64*)(ws + WS_RSQ) + (size_t)(3 * l + 3) * M};
            pg8::gemm_phase<EpiRes<1>, pg8::StaticOrder, GEMM_ALIGN, GEMM_SP2>(lds, g, S, E, OTID());
        }
        SEAM(g0 + PH_DN2);
    }
#undef IN
#undef SEAM
#undef TIDS
#undef OTID
}

extern "C" void kernel_launch(void* const* d_in, const int* in_sizes, int n_in, void* d_out, int out_size, void* d_ws, size_t ws_size, hipStream_t stream) {
    static int grid = 0;
    if (grid == 0) {
        if (n_in != 18 || out_size != M * D || ws_size < WS_END) { fprintf(stderr, "kernel_launch: unexpected problem (n_in %d, out %d, ws %zu, need %zu); nothing launched\n", n_in, out_size, ws_size, (size_t)WS_END); grid = -1; return; }
        int dev = 0, cus = 0, per_cu = 0;
        if (hipGetDevice(&dev) != hipSuccess || hipDeviceGetAttribute(&cus, hipDeviceAttributeMultiprocessorCount, dev) != hipSuccess) { grid = -1; return; }
        if (hipFuncSetAttribute((const void*)fwd, hipFuncAttributeMaxDynamicSharedMemorySize, LDS_BYTES) != hipSuccess) { fprintf(stderr, "kernel_launch: hipFuncSetAttribute failed\n"); grid = -1; return; }
        if (hipOccupancyMaxActiveBlocksPerMultiprocessor(&per_cu, (const void*)fwd, NWAVES * 64, LDS_BYTES) != hipSuccess || per_cu < 1) { fprintf(stderr, "kernel_launch: occupancy query says %d\n", per_cu); }
        (void)hipGetLastError();
        grid = cus;
    }
    if (grid < 0) return;
    (void)hipMemsetAsync((char*)d_ws + WS_CTL, 0, CTL_ZERO_BYTES, stream);
    Args a{};
    for (int i = 0; i < 18; ++i) a.in[i] = (const float*)d_in[i];
    a.out = (float*)d_out; a.ws = (unsigned char*)d_ws;
    if (ONE_LAUNCH) { a.ph_lo = 0; a.ph_hi = NPH; hipLaunchKernelGGL(fwd, dim3(grid), dim3(NWAVES * 64), LDS_BYTES, stream, a); }
    else for (int p = 0; p < NPH; ++p) { a.ph_lo = p; a.ph_hi = p + 1; hipLaunchKernelGGL(fwd, dim3(grid), dim3(NWAVES * 64), LDS_BYTES, stream, a); }
}
```

```cpp
#include <hip/hip_runtime.h>
#include <cstdio>
#include <cstdint>

#ifndef PROBE_DUP
#define LOCAL_SEAMS 1
#define PROBE_DUP 0
#endif
#ifndef ONE_LAUNCH
#define ONE_LAUNCH 1
#endif

#ifndef FAST_MASK
#define FAST_MASK 7
#endif
#ifndef GEMM_ALIGN
#define GEMM_ALIGN true
#endif
#ifndef GEMM_SP2
#define GEMM_SP2 true
#endif
#ifndef GEMM_BAL
#define GEMM_BAL false
#endif
#ifndef FP8_GATES
#define FP8_GATES 1
#endif
#ifndef UNROLL_LAYERS
#define UNROLL_LAYERS 1
#endif
#ifndef FP8_QA
#define FP8_QA 2
#endif
#ifndef FP8_QK
#define FP8_QK 0
#endif
#ifndef STATIC_PRIO
#define STATIC_PRIO 0
#endif
#ifndef QKN_IN_EPI
#define QKN_IN_EPI 1
#endif
#ifndef NORM_ON_LOAD
#define NORM_ON_LOAD 0
#endif
typedef unsigned long long u64;
__device__ __forceinline__ int tid_of(int wave_s) { int t; asm volatile("v_mbcnt_lo_u32_b32 %0, -1, 0\n\tv_mbcnt_hi_u32_b32 %0, -1, %0\n\tv_lshl_add_u32 %0, %1, 6, %0" : "=&v"(t) : "s"(wave_s)); return t; }
namespace pg8 {
#define PG8_LAS __attribute__((address_space(3)))
typedef unsigned short bf16_t;
typedef short bf16x8 __attribute__((ext_vector_type(8)));
typedef float f32x4 __attribute__((ext_vector_type(4)));
typedef unsigned u32x4 __attribute__((ext_vector_type(4)));
typedef unsigned u32x2 __attribute__((ext_vector_type(2)));
constexpr int BM = 256, BK = 64, HALF = 128, HTB = HALF * BK * 2, STAGE_BYTES = 8 * HTB, NXCD = 8, WGM = 8;

__host__ __device__ __forceinline__ int lds_byte(int r, int c) { const int st = (r >> 4) * 2 + (c >> 5), rr = r & 15, cc = c & 31, ob = rr * 64 + cc * 2; return st * 1024 + (ob ^ (((ob >> 9) & 1) << 5)); }
__host__ __device__ __forceinline__ void stage_rc(int b, int& R, int& C) { const int st = b / 1024, sb = b % 1024, swz = sb ^ (((sb >> 9) & 1) << 5); R = (st >> 1) * 16 + swz / 64; C = (st & 1) * 32 + (swz % 64) / 2; }
__host__ __device__ __forceinline__ int perm32(int rho) { const int n = rho >> 4, i = rho & 15; return 8 * (i >> 2) + 4 * n + (i & 3); }

struct Unit { int pm, pn; };
struct Gemm { const bf16_t* A; const bf16_t* Bt; int M, N, K; bool ablk = false, bblk = false; };

struct StaticOrder {
    int nM, nN, nwg, G, c, r0 = 0, r1 = 1 << 30;
    __host__ __device__ void init(int M, int N, int G_, int c_) { nM = M / BM; nN = N / BM; nwg = nM * nN; G = G_; c = c_; }
    __host__ __device__ bool next(int i, Unit& u) const {
        if (i + r0 >= r1) return false;
        const long L = (long)(i + r0) * G + c; if (L >= nwg) return false;
        int wgid = (int)L; { const int q = nwg / NXCD, r = nwg % NXCD, xcd = wgid % NXCD, off = wgid / NXCD; wgid = (xcd < r ? xcd * (q + 1) : r * (q + 1) + (xcd - r) * q) + off; }
        const int nig = WGM * nN, gid = wgid / nig, fm = gid * WGM, gsz = (nM - fm) < WGM ? (nM - fm) : WGM;
        u.pm = fm + ((wgid % nig) % gsz); u.pn = (wgid % nig) / gsz; return true;
    }
    __device__ __forceinline__ void a_ready(const Unit&) const {}
    __device__ __forceinline__ void done(const Unit&) const {}
};

typedef int i32x8 __attribute__((ext_vector_type(8)));
typedef int i32x4 __attribute__((ext_vector_type(4)));
__device__ __forceinline__ i32x8 cat8(bf16x8 a, bf16x8 b) { return __builtin_shufflevector(__builtin_bit_cast(i32x4, a), __builtin_bit_cast(i32x4, b), 0, 1, 2, 3, 4, 5, 6, 7); }
__device__ __forceinline__ unsigned cvt_pk_bf16(float lo, float hi) { unsigned r; asm volatile("v_cvt_pk_bf16_f32 %0, %1, %2" : "=v"(r) : "v"(lo), "v"(hi)); return r; }
__device__ __forceinline__ float bf_lo(unsigned w) { return __uint_as_float(w << 16); }
__device__ __forceinline__ float bf_hi(unsigned w) { return __uint_as_float(w & 0xffff0000u); }

template <class Epi, class Sched, bool ALIGN_EPI = false, bool SP2 = false, bool FP8 = false>
__device__ __forceinline__ void gemm_phase(PG8_LAS unsigned char* lds, const Gemm g, const Sched& S, const Epi& E, const int wave_s  ) {
    const int tid = tid_of(wave_s);
    const int wid = __builtin_amdgcn_readfirstlane(tid >> 6), lane = tid & 63, wr = wid >> 2, wc = wid & 3, fr = lane & 15, fq = lane >> 4;
    const int K = g.K, nt = K / BK;
    unsigned voffA[2], voffB[2];
#pragma unroll
    for (int i = 0; i < 2; ++i) { int R, C; stage_rc(tid * 16 + i * 8192, R, C); const int Rb = Epi::PERM ? ((R & ~31) + perm32(R & 31)) : R;
        voffA[i] = (unsigned)(R * (g.ablk ? BK : K) + C) * 2u; voffB[i] = (unsigned)(Rb * (g.bblk ? BK : K) + C) * 2u; }
    const size_t kstepA = g.ablk ? (size_t)(BM * BK * 2) : (size_t)(BK * 2), kstepB = g.bblk ? (size_t)(BM * BK * 2) : (size_t)(BK * 2);
    const size_t hstepA = g.ablk ? (size_t)(HALF * BK * 2) : (size_t)HALF * K * 2, hstepB = g.bblk ? (size_t)(HALF * BK * 2) : (size_t)HALF * K * 2;
    const size_t tstepA = (size_t)BM * K * 2, tstepB = (size_t)BM * K * 2;
    const unsigned ldsw = (unsigned)wid * 1024u;
    const int aoff = lds_byte(wr * 64 + fr, fq * 8), boff = lds_byte(wc * 32 + fr, fq * 8);
#define PG8_SA(b, h) (((b) * 2 + (h)) * HTB)
#define PG8_SB(b, h) ((4 + (b) * 2 + (h)) * HTB)
#define PG8_STAGE(bufoff, gbase, voff) do { const char* _gb = (const char*)(gbase); asm volatile("" : "+s"(_gb));     \
        _Pragma("unroll") for (int _i = 0; _i < 2; ++_i) \
        __builtin_amdgcn_global_load_lds((const unsigned*)(_gb + (voff)[_i]), (PG8_LAS unsigned*)(lds + (bufoff) + ldsw + _i * 8192), 16, 0, 0); } while (0)
#define PG8_LDA(dst, b, h) do { _Pragma("unroll") for (int m = 0; m < 4; ++m) _Pragma("unroll") for (int k = 0; k < 2; ++k) dst[m][k] = *(const PG8_LAS bf16x8*)(lds + PG8_SA(b, h) + aoff + m * 2048 + k * 1024); } while (0)
#define PG8_LDB(dst, b, h) do { _Pragma("unroll") for (int n = 0; n < 2; ++n) _Pragma("unroll") for (int k = 0; k < 2; ++k) dst[n][k] = *(const PG8_LAS bf16x8*)(lds + PG8_SB(b, h) + boff + n * 2048 + k * 1024); } while (0)
#define PG8_MMA(ai, bj, At, Bt) do { if (!STATIC_PRIO) __builtin_amdgcn_s_setprio(1); _Pragma("unroll") for (int m = 0; m < 4; ++m) _Pragma("unroll") for (int n = 0; n < 2; ++n) { \
        if constexpr (FP8) { acc[ai][bj][m][n] = __builtin_amdgcn_mfma_scale_f32_16x16x128_f8f6f4(cat8(Bt[n][0], Bt[n][1]), cat8(At[m][0], At[m][1]), acc[ai][bj][m][n], 0, 0, 0, 0, 0, 0); }   \
        else { _Pragma("unroll") for (int k = 0; k < 2; ++k) acc[ai][bj][m][n] = __builtin_amdgcn_mfma_f32_16x16x32_bf16(Bt[n][k], At[m][k], acc[ai][bj][m][n], 0, 0, 0); } } \
        if (!STATIC_PRIO) __builtin_amdgcn_s_setprio(0); } while (0)
#define PG8_WAIT_V(n) asm volatile("s_waitcnt vmcnt(" #n ")" ::: "memory")
#define PG8_WAIT_L(n) asm volatile("s_waitcnt lgkmcnt(" #n ")" ::: "memory")
#define PG8_BAR __builtin_amdgcn_s_barrier()
#define PG8_SCHED __builtin_amdgcn_sched_barrier(0)
    Unit cur, nxt; int ui = 0;
    if (!S.next(0, cur)) return;
    if (STATIC_PRIO && wr == 1) __builtin_amdgcn_s_setprio(1);
    f32x4 acc[2][2][4][2];
#pragma unroll
    for (int a = 0; a < 2; ++a)
#pragma unroll
        for (int b = 0; b < 2; ++b)
#pragma unroll
            for (int m = 0; m < 4; ++m)
#pragma unroll
                for (int n = 0; n < 2; ++n) acc[a][b][m][n] = (f32x4){0.f, 0.f, 0.f, 0.f};
    bf16x8 At[4][2], B0[2][2], B1[2][2];
    const char* cA = (const char*)g.A + (size_t)cur.pm * tstepA; const char* cB = (const char*)g.Bt + (size_t)cur.pn * tstepB;
    S.a_ready(cur);
    if constexpr (SP2 && GEMM_BAL) {
        PG8_STAGE(PG8_SB(0, 0), cB, voffB); PG8_STAGE(PG8_SB(0, 1), cB + hstepB, voffB); PG8_STAGE(PG8_SA(0, 0), cA, voffA); PG8_STAGE(PG8_SA(0, 1), cA + hstepA, voffA);
        if (wr == 1) PG8_BAR;
        PG8_WAIT_V(0); PG8_BAR;
        PG8_STAGE(PG8_SB(1, 0), cB + kstepB, voffB); PG8_STAGE(PG8_SB(1, 1), cB + hstepB + kstepB, voffB);
        PG8_BAR;
    } else if constexpr (SP2) {
        PG8_STAGE(PG8_SB(0, 0), cB, voffB); PG8_STAGE(PG8_SB(0, 1), cB + hstepB, voffB); PG8_STAGE(PG8_SA(0, 0), cA, voffA); PG8_STAGE(PG8_SA(0, 1), cA + hstepA, voffA);
        if (wr == 1) PG8_BAR;
        PG8_WAIT_V(2); PG8_BAR;
        PG8_STAGE(PG8_SB(1, 0), cB + kstepB, voffB); PG8_STAGE(PG8_SA(1, 0), cA + kstepA, voffA); PG8_STAGE(PG8_SB(1, 1), cB + hstepB + kstepB, voffB);
        PG8_WAIT_V(6); PG8_BAR;
    } else {
        PG8_STAGE(PG8_SB(0, 0), cB, voffB); PG8_STAGE(PG8_SA(0, 0), cA, voffA); PG8_STAGE(PG8_SB(0, 1), cB + hstepB, voffB); PG8_STAGE(PG8_SA(0, 1), cA + hstepA, voffA);
        if (wr == 1) PG8_BAR;
        PG8_WAIT_V(4); PG8_BAR;
        PG8_STAGE(PG8_SB(1, 0), cB + kstepB, voffB); PG8_STAGE(PG8_SA(1, 0), cA + kstepA, voffA); PG8_STAGE(PG8_SB(1, 1), cB + hstepB + kstepB, voffB);
        PG8_WAIT_V(6); PG8_BAR;
    }
    for (;;) {
        const bool has_next = S.next(ui + 1, nxt);
        const char* nA = has_next ? (const char*)g.A + (size_t)nxt.pm * tstepA : cA; const char* nB = has_next ? (const char*)g.Bt + (size_t)nxt.pn * tstepB : cB;
        for (int t = 0; t < nt; t += 2) {
            const bool last = (t == nt - 2);
            const char* a1 = cA + (size_t)(t + 1) * kstepA;
            const char* a2 = last ? nA : cA + (size_t)(t + 2) * kstepA; const char* b2 = last ? nB : cB + (size_t)(t + 2) * kstepB;
            const char* a3 = a2 + kstepA; const char* b3 = b2 + kstepB;
            if (last && has_next) S.a_ready(nxt);
            if constexpr (Epi::MID) { if (t == Epi::MID_T0 || t == Epi::MID_T1) { const int t2 = tid_of(wave_s) & 63; E.mid(acc, cur, t, wr, wc, t2 & 15, t2 >> 4); } }
            if constexpr (SP2 && GEMM_BAL) {
            PG8_LDB(B0, 0, 0); PG8_LDB(B1, 0, 1); PG8_SCHED; PG8_LDA(At, 0, 0); PG8_STAGE(PG8_SA(1, 0), a1, voffA); PG8_STAGE(PG8_SA(1, 1), a1 + hstepA, voffA);
            PG8_WAIT_V(4); PG8_WAIT_L(0); PG8_BAR; PG8_MMA(0, 0, At, B0); PG8_MMA(0, 1, At, B1); PG8_BAR; PG8_SCHED;
            PG8_LDA(At, 0, 1); PG8_STAGE(PG8_SB(0, 0), b2, voffB); PG8_STAGE(PG8_SB(0, 1), b2 + hstepB, voffB);
            PG8_WAIT_V(4); PG8_WAIT_L(0); PG8_BAR; PG8_MMA(1, 0, At, B0); PG8_MMA(1, 1, At, B1); PG8_BAR; PG8_SCHED;
            PG8_LDB(B0, 1, 0); PG8_LDB(B1, 1, 1); PG8_SCHED; PG8_LDA(At, 1, 0); PG8_STAGE(PG8_SA(0, 0), a2, voffA); PG8_STAGE(PG8_SA(0, 1), a2 + hstepA, voffA);
            PG8_WAIT_V(4); PG8_WAIT_L(0); PG8_BAR; PG8_MMA(0, 0, At, B0); PG8_MMA(0, 1, At, B1); PG8_BAR; PG8_SCHED;
            PG8_LDA(At, 1, 1); PG8_STAGE(PG8_SB(1, 0), b3, voffB); PG8_STAGE(PG8_SB(1, 1), b3 + hstepB, voffB);
            PG8_WAIT_V(4); PG8_WAIT_L(0); PG8_BAR; PG8_MMA(1, 0, At, B0); PG8_MMA(1, 1, At, B1); PG8_BAR; PG8_SCHED;
            } else if constexpr (SP2) {
            PG8_LDB(B0, 0, 0); PG8_LDB(B1, 0, 1); PG8_SCHED; PG8_LDA(At, 0, 0); PG8_STAGE(PG8_SA(1, 1), a1 + hstepA, voffA);
            PG8_WAIT_V(8); PG8_WAIT_L(0); PG8_BAR; PG8_MMA(0, 0, At, B0); PG8_MMA(0, 1, At, B1); PG8_BAR; PG8_SCHED;
            PG8_LDA(At, 0, 1); PG8_STAGE(PG8_SB(0, 0), b2, voffB); PG8_STAGE(PG8_SB(0, 1), b2 + hstepB, voffB); PG8_STAGE(PG8_SA(0, 0), a2, voffA);
            PG8_WAIT_V(8); PG8_WAIT_L(0); PG8_BAR; PG8_MMA(1, 0, At, B0); PG8_MMA(1, 1, At, B1); PG8_BAR; PG8_SCHED;
            PG8_LDB(B0, 1, 0); PG8_LDB(B1, 1, 1); PG8_SCHED; PG8_LDA(At, 1, 0); PG8_STAGE(PG8_SA(0, 1), a2 + hstepA, voffA);
            PG8_WAIT_V(8); PG8_WAIT_L(0); PG8_BAR; PG8_MMA(0, 0, At, B0); PG8_MMA(0, 1, At, B1); PG8_BAR; PG8_SCHED;
            PG8_LDA(At, 1, 1); PG8_STAGE(PG8_SB(1, 0), b3, voffB); PG8_STAGE(PG8_SB(1, 1), b3 + hstepB, voffB); PG8_STAGE(PG8_SA(1, 0), a3, voffA);
            PG8_WAIT_V(8); PG8_WAIT_L(0); PG8_BAR; PG8_MMA(1, 0, At, B0); PG8_MMA(1, 1, At, B1); PG8_BAR; PG8_SCHED;
            } else {
            PG8_LDB(B0, 0, 0); PG8_SCHED; PG8_LDA(At, 0, 0); PG8_STAGE(PG8_SA(1, 1), a1 + hstepA, voffA);
            PG8_WAIT_L(8); PG8_BAR; PG8_WAIT_L(0); PG8_MMA(0, 0, At, B0); PG8_BAR; PG8_SCHED;
            PG8_LDB(B1, 0, 1); PG8_STAGE(PG8_SB(0, 0), b2, voffB);
            PG8_BAR; PG8_WAIT_L(0); PG8_MMA(0, 1, At, B1); PG8_BAR;
            PG8_LDA(At, 0, 1); PG8_STAGE(PG8_SA(0, 0), a2, voffA);
            PG8_BAR; PG8_WAIT_L(0); PG8_MMA(1, 0, At, B0); PG8_BAR; PG8_SCHED;
            PG8_STAGE(PG8_SB(0, 1), b2 + hstepB, voffB);
            PG8_WAIT_V(6); PG8_BAR; PG8_MMA(1, 1, At, B1); PG8_BAR;
            PG8_LDB(B0, 1, 0); PG8_SCHED; PG8_LDA(At, 1, 0); PG8_STAGE(PG8_SA(0, 1), a2 + hstepA, voffA);
            PG8_WAIT_L(8); PG8_BAR; PG8_WAIT_L(0); PG8_MMA(0, 0, At, B0); PG8_BAR; PG8_SCHED;
            PG8_LDB(B1, 1, 1); PG8_STAGE(PG8_SB(1, 0), b3, voffB);
            PG8_BAR; PG8_WAIT_L(0); PG8_MMA(0, 1, At, B1); PG8_BAR;
            PG8_LDA(At, 1, 1); PG8_STAGE(PG8_SA(1, 0), a3, voffA);
            PG8_BAR; PG8_WAIT_L(0); PG8_MMA(1, 0, At, B0); PG8_BAR; PG8_SCHED;
            PG8_STAGE(PG8_SB(1, 1), b3 + hstepB, voffB);
            PG8_WAIT_V(6); PG8_BAR; PG8_MMA(1, 1, At, B1); PG8_BAR;
            }
        }
        if constexpr (ALIGN_EPI) { if (wr == 0) PG8_BAR; }
        { const int t2 = tid_of(wave_s) & 63; E(acc, cur, wr, wc, t2 & 15, t2 >> 4); } S.done(cur);
        if (!has_next) break;
#pragma unroll
        for (int a = 0; a < 2; ++a)
#pragma unroll
            for (int b = 0; b < 2; ++b)
#pragma unroll
                for (int m = 0; m < 4; ++m)
#pragma unroll
                    for (int n = 0; n < 2; ++n) acc[a][b][m][n] = (f32x4){0.f, 0.f, 0.f, 0.f};
        cur = nxt; cA = nA; cB = nB; ++ui;
        if constexpr (ALIGN_EPI) { if (wr == 1) PG8_BAR; }
    }
    PG8_WAIT_V(0);
    if constexpr (!ALIGN_EPI) { if (wr == 0) PG8_BAR; }
    PG8_BAR;
    if (STATIC_PRIO) __builtin_amdgcn_s_setprio(0);
#undef PG8_SA
#undef PG8_SB
#undef PG8_STAGE
#undef PG8_LDA
#undef PG8_LDB
#undef PG8_MMA
#undef PG8_WAIT_V
#undef PG8_WAIT_L
#undef PG8_BAR
#undef PG8_SCHED
}
}

constexpr int M = 16384, D = 2048, FF = 5632, NIN = 15360, KBR = 2560, DEPTH = 4;
constexpr int NWAVES = 8;
constexpr float EPS = 1e-6f;
constexpr float SSQ_SCALE = 16777216.0f;
typedef unsigned short bf16;
typedef pg8::f32x4 f32x4;
typedef pg8::u32x4 u32x4;
typedef pg8::u32x2 u32x2;
typedef float f32x2v __attribute__((ext_vector_type(2)));
#define LAS __attribute__((address_space(3)))

constexpr size_t MiB = 1u << 20;
constexpr size_t WS_CTL = 0, CTL_ZERO_BYTES = 4 * MiB;
constexpr size_t WS_RSQ = 1 * MiB;
constexpr size_t WS_W = 8 * MiB, W_LAYER = 210 * MiB;
constexpr size_t W_IN8 = FP8_QK ? 66 * MiB + 12 * MiB : 66 * MiB + 36 * MiB;
constexpr float W8_SCALE = 256.0f;
constexpr size_t W_1A = 0, W_1B = 44 * MiB, W_IN = 66 * MiB, W_BR = 126 * MiB, W_O = 136 * MiB, W_2A = 144 * MiB, W_2B = 188 * MiB;
constexpr size_t WS_XB = 848 * MiB;
constexpr size_t WS_QA = 912 * MiB, WS_KA = WS_QA + 48 * MiB, WS_VA = WS_KA + 48 * MiB, WS_QB = WS_VA + 48 * MiB, WS_KB = WS_QB + 32 * MiB, WS_VB = WS_KB + 8 * MiB,
                 WS_QC = WS_VB + 8 * MiB, WS_KC = WS_QC + 32 * MiB, WS_VC = WS_KC + 32 * MiB, WS_G = WS_VC + 32 * MiB;
constexpr size_t WS_O = WS_G + (FP8_GATES ? 96 : 192) * MiB;
constexpr size_t WS_OAG = WS_O + 80 * MiB;
constexpr size_t WS_LSE = WS_OAG + 48 * MiB;
constexpr size_t WS_Z = WS_LSE + 1 * MiB;
constexpr size_t WS_XL = WS_Z + 64 * MiB;
constexpr size_t WS_XB8 = WS_XL + 64 * MiB;
constexpr size_t WS_ACT = WS_XB8 + 32 * MiB;
constexpr size_t WS_END = WS_ACT + 176 * MiB;
static_assert((size_t)M * FF * 2 == 176 * MiB, "act size");
static_assert(WS_W + 4 * W_LAYER == WS_XB, "weight map");
constexpr int CW_BAR = 4096;

constexpr int RING_BYTES = 131072, MISC_OFF = RING_BYTES + 320, LDS_BYTES = 147456;

#define XB_TMO      128
#define XB_XCNT(j)  (256  + 64 * (j))
#define XB_XSUB(j)  (1280 + 64 * (j))
#define XB_XGEN(j)  (2304 + 64 * (j))
#define XB_TOP      3328
#define XB_TOPGEN   3392
#define XCD_BAR_WORDS 3456
#define XB_SPIN_CAP (1u << 22)
__device__ __forceinline__ unsigned xb_ld(unsigned* p)              { return __hip_atomic_load(p, __ATOMIC_RELAXED, __HIP_MEMORY_SCOPE_AGENT); }
__device__ __forceinline__ unsigned xb_add(unsigned* p, unsigned v) { return __hip_atomic_fetch_add(p, v, __ATOMIC_RELAXED, __HIP_MEMORY_SCOPE_AGENT); }
__device__ __forceinline__ unsigned xb_xcc_id() { return (unsigned)__builtin_amdgcn_s_getreg((3 << 11) | 20) & 0xFu; }
#define XB_SPIN(cond, bar) do { unsigned _sp = 0; while (cond) { __builtin_amdgcn_s_sleep(1); \
    if ((++_sp & 255u) == 0u) { if (xb_ld(&(bar)[XB_TMO])) break; if (_sp > XB_SPIN_CAP) { atomicAdd(&(bar)[XB_TMO], 1u); break; } } } } while (0)
struct XcdBarrier { unsigned* bar; unsigned x; volatile LAS unsigned* st; };
__device__ __forceinline__ XcdBarrier xcd_barrier_post(unsigned* bar, volatile LAS unsigned* st, int tid) {
    XcdBarrier b; b.bar = bar; b.x = xb_xcc_id(); b.st = st;
    if (tid == 0) (void)xb_add(&bar[XB_XCNT(b.x)], 1u);
    return b;
}
__device__ __forceinline__ void xcd_barrier_complete(unsigned* bar, unsigned x, unsigned& nloc, unsigned& nx) {
    const unsigned G = gridDim.x * gridDim.y * gridDim.z;
    unsigned sum, cnt, mine, sp = 0u;
    for (;;) {
        sum = 0u; cnt = 0u; mine = 0u;
#pragma unroll
        for (unsigned j = 0; j < 16; ++j) { const unsigned c = xb_ld(&bar[XB_XCNT(j)]); sum += c; cnt += (c > 0u) ? 1u : 0u; mine = (j == x) ? c : mine; }
        if (sum == G) break;
        __builtin_amdgcn_s_sleep(1);
        if ((++sp & 255u) == 0u) { if (xb_ld(&bar[XB_TMO])) break; if (sp > XB_SPIN_CAP) { atomicAdd(&bar[XB_TMO], 1u); break; } }
    }
    nloc = mine > 0u ? mine : 1u; nx = cnt > 0u ? cnt : 1u;
}
__device__ __forceinline__ void xcd_barrier(const XcdBarrier& b, int tid) {
    asm volatile("s_waitcnt vmcnt(0)" ::: "memory");
    __syncthreads();
    if (tid == 0) {
        unsigned* bar = b.bar;
        __builtin_amdgcn_s_waitcnt(0);
        unsigned nloc = b.st[0], nx = b.st[1];
        if (nloc == 0u) { xcd_barrier_complete(bar, b.x, nloc, nx); b.st[0] = nloc; b.st[1] = nx; }
        const unsigned old = xb_add(&bar[XB_XSUB(b.x)], 1u);
        const unsigned gen = old / nloc;
        if (old + 1u == (gen + 1u) * nloc) {
            __builtin_amdgcn_fence(__ATOMIC_RELEASE, "agent");
            asm volatile("s_waitcnt vmcnt(0)" ::: "memory");
            const unsigned og = xb_add(&bar[XB_TOP], 1u);
            const unsigned tg = og / nx;
            if (og + 1u == (tg + 1u) * nx) xb_add(&bar[XB_TOPGEN], 1u);
            else XB_SPIN(xb_ld(&bar[XB_TOPGEN]) == tg, bar);
            __builtin_amdgcn_fence(__ATOMIC_ACQUIRE, "agent");
            xb_add(&bar[XB_XGEN(b.x)], 1u);
            asm volatile("s_waitcnt vmcnt(0)" ::: "memory");
        } else {
            XB_SPIN(xb_ld(&bar[XB_XGEN(b.x)]) == gen, bar);
            __builtin_amdgcn_fence(__ATOMIC_ACQUIRE, "agent");
            asm volatile("s_waitcnt vmcnt(0)" ::: "memory");
        }
    }
    __syncthreads();
}

#define XB_GRP      4096
#define XB_XTAB     12288
__device__ __forceinline__ void grp_barrier(unsigned* bar, int tid) {
    asm volatile("s_waitcnt vmcnt(0)" ::: "memory");
    __syncthreads();
    if (tid == 0) {
        unsigned* ctr = bar + XB_GRP + 64u * (blockIdx.x & 63u);
        const unsigned old = xb_add(ctr, 1u);
        const unsigned target = (old & ~3u) + 4u;
        XB_SPIN(xb_ld(ctr) < target, bar);
        __builtin_amdgcn_fence(__ATOMIC_ACQUIRE, "agent");
        asm volatile("s_waitcnt vmcnt(0)" ::: "memory");
    }
    __syncthreads();
}

#define LDS_WAIT() asm volatile("s_waitcnt lgkmcnt(0)" ::: "memory")
__device__ __forceinline__ unsigned f2bf(float f) { unsigned u = __builtin_bit_cast(unsigned, f); return (u + 0x7fffu + ((u >> 16) & 1u)) >> 16; }
__device__ __forceinline__ unsigned pk2(float lo, float hi) { return f2bf(lo) | (f2bf(hi) << 16); }
__device__ __forceinline__ float bf_lo(unsigned w) { return __uint_as_float(w << 16); }
__device__ __forceinline__ float bf_hi(unsigned w) { return __uint_as_float(w & 0xffff0000u); }
__device__ __forceinline__ float xrow16_sum(float x) {
    auto s = __builtin_amdgcn_permlane16_swap(__float_as_uint(x), __float_as_uint(x), false, false);
    x = __uint_as_float(s[0]) + __uint_as_float(s[1]);
    auto t = __builtin_amdgcn_permlane32_swap(__float_as_uint(x), __float_as_uint(x), false, false);
    return __uint_as_float(t[0]) + __uint_as_float(t[1]);
}
__device__ __forceinline__ float xrow16_max(float x) {
    auto s = __builtin_amdgcn_permlane16_swap(__float_as_uint(x), __float_as_uint(x), false, false);
    x = fmaxf(__uint_as_float(s[0]), __uint_as_float(s[1]));
    auto t = __builtin_amdgcn_permlane32_swap(__float_as_uint(x), __float_as_uint(x), false, false);
    return fmaxf(__uint_as_float(t[0]), __uint_as_float(t[1]));
}
__device__ __forceinline__ float wave_sum(float v) {
#pragma unroll
    for (int o = 1; o < 64; o <<= 1) v += __shfl_xor(v, o);
    return v;
}
__device__ __forceinline__ float wave_max(float v) {
#pragma unroll
    for (int o = 1; o < 64; o <<= 1) v = fmaxf(v, __shfl_xor(v, o));
    return v;
}
__device__ __forceinline__ float rstd_row(const u64* rsq, int row) {
    const u64 v = rsq[row];
    return rsqrtf((float)v * (1.0f / (SSQ_SCALE * (float)D)) + EPS);
}
__device__ __forceinline__ float sconst(unsigned bits) { unsigned r; asm volatile("s_mov_b32 %0, %1" : "=s"(r) : "s"(bits)); return __builtin_bit_cast(float, r); }
__device__ __forceinline__ float sigmoidf_(float x) { return __builtin_amdgcn_rcpf(1.0f + __expf(-x)); }

constexpr int RTAB_OFF = RING_BYTES + 9216, RTAG_OFF = RTAB_OFF + 4096;
static_assert(RTAG_OFF + 64 <= LDS_BYTES, "rstd cache LDS map");
__device__ __forceinline__ void rstd_cache_reset(LAS unsigned char* lds, int tid) { if ((tid & 63) == 0) ((LAS int*)(lds + RTAG_OFF))[tid >> 6] = -1; }
__device__ __forceinline__ void rstd8(const u64* rsq, LAS unsigned char* lds, int pm, int wr, int wc, int fr, int fq, float scale, float (&rs)[2][4]) {
    const int wid = wr * 4 + wc;
    LAS float* tab = (LAS float*)(lds + RTAB_OFF) + wid * 128; LAS int* tag = (LAS int*)(lds + RTAG_OFF) + wid;
    const int have = __builtin_amdgcn_readfirstlane(*tag);
    if (have == pm) {
#pragma unroll
        for (int ai = 0; ai < 2; ++ai)
#pragma unroll
            for (int m = 0; m < 4; ++m) rs[ai][m] = tab[(ai * 4 + m) * 16 + fr];
    } else {
#pragma unroll
        for (int ai = 0; ai < 2; ++ai)
#pragma unroll
            for (int m = 0; m < 4; ++m) { rs[ai][m] = rstd_row(rsq, pm * 256 + wr * 64 + fr + ai * 128 + m * 16) * scale; if (fq == 0) tab[(ai * 4 + m) * 16 + fr] = rs[ai][m]; }
        if (fq == 0 && fr == 0) *tag = pm;
    }
}

struct EpiUp {
    static constexpr bool PERM = true, MID = false; static constexpr int MID_T0 = -1, MID_T1 = -1;
    bf16* act; const u64* rsq; LAS unsigned char* lds;
    __device__ __forceinline__ void mid(f32x4 (&)[2][2][4][2], const pg8::Unit&, int, int, int, int, int) const {}
    __device__ __forceinline__ void operator()(const f32x4 (&acc)[2][2][4][2], const pg8::Unit& u, int wr, int wc, int fr, int fq) const {
        const int row0 = u.pm * 256 + wr * 64 + fr, col0 = u.pn * 128 + wc * 32 + 8 * fq;
        float rs8[2][4]; rstd8(rsq, lds, u.pm, wr, wc, fr, fq, 1.0f, rs8);
#pragma unroll
        for (int ai = 0; ai < 2; ++ai)
#pragma unroll
            for (int m = 0; m < 4; ++m) {
                const int row = row0 + ai * 128 + m * 16; const float rs = rs8[ai][m], rsl = rs * -1.44269504f, rs2 = rs * rs;
                unsigned wq[4];
#pragma unroll
                for (int n = 0; n < 2; ++n)
#pragma unroll
                    for (int j = 0; j < 4; j += 2) {
                        const f32x2v g2 = (f32x2v){acc[ai][0][m][n][j], acc[ai][0][m][n][j + 1]}, u2 = (f32x2v){acc[ai][1][m][n][j], acc[ai][1][m][n][j + 1]};
                        const f32x2v t2 = g2 * rsl; f32x2v e2 = (f32x2v){__builtin_amdgcn_exp2f(t2[0]), __builtin_amdgcn_exp2f(t2[1])}; e2 = e2 + 1.0f;
                        const f32x2v r2 = (f32x2v){__builtin_amdgcn_rcpf(e2[0]), __builtin_amdgcn_rcpf(e2[1])}; const f32x2v o2 = ((g2 * u2) * rs2) * r2;
                        wq[2 * n + (j >> 1)] = pg8::cvt_pk_bf16(o2[0], o2[1]);
                    }
                u32x4 w; w.x = wq[0]; w.y = wq[1]; w.z = wq[2]; w.w = wq[3];
                *(u32x4*)(act + (size_t)row * FF + col0) = w;
            }
    }
};
struct EpiNull {
    static constexpr bool PERM = true, MID = false; static constexpr int MID_T0 = -1, MID_T1 = -1;
    __device__ __forceinline__ void mid(f32x4 (&)[2][2][4][2], const pg8::Unit&, int, int, int, int, int) const {}
    __device__ __forceinline__ void operator()(const f32x4 (&acc)[2][2][4][2], const pg8::Unit&, int, int, int, int) const {
#pragma unroll
        for (int ai = 0; ai < 2; ++ai)
#pragma unroll
            for (int bj = 0; bj < 2; ++bj)
#pragma unroll
                for (int m = 0; m < 4; ++m) asm volatile("" :: "v"(acc[ai][bj][m][0]), "v"(acc[ai][bj][m][1]));
    }
};
template <int HALFSC, bool LAST = false, bool F8 = false> struct EpiRes {
    static constexpr bool PERM = true, MID = false; static constexpr int MID_T0 = -1, MID_T1 = -1;
    bf16* xh; unsigned char* xl; float* out; u64* rsq_next; unsigned char* x8 = nullptr;
    __device__ __forceinline__ void mid(f32x4 (&)[2][2][4][2], const pg8::Unit&, int, int, int, int, int) const {}
    __device__ __forceinline__ void operator()(const f32x4 (&acc)[2][2][4][2], const pg8::Unit& u, int wr, int wc, int fr, int fq) const {
        const float sc = HALFSC ? 0.5f : 1.0f;
        const int row0 = u.pm * 256 + wr * 64 + fr, col0 = u.pn * 256 + wc * 32 + 8 * fq;
        const char* xhb = (const char*)xh; const char* xlb = (const char*)xl; asm volatile("" : "+s"(xhb), "+s"(xlb));
        const unsigned e0 = (unsigned)row0 * (unsigned)D + (unsigned)col0;
        u32x4 xab[3][2][2]; u32x2 xcb[3][2][2];
#define EPIRES_ISSUE(ab_) do { _Pragma("unroll") for (int mm = 0; mm < 2; ++mm) _Pragma("unroll") for (int bj = 0; bj < 2; ++bj) { \
            const unsigned eo = e0 + (unsigned)((((ab_) >> 1) * 128 + (2 * ((ab_) & 1) + mm) * 16) * D + bj * 128); xab[(ab_) % 3][mm][bj] = *(const u32x4*)(xhb + (size_t)(2u * eo)); xcb[(ab_) % 3][mm][bj] = *(const u32x2*)(xlb + (size_t)eo); } } while (0)
        EPIRES_ISSUE(0); EPIRES_ISSUE(1);
#pragma unroll
        for (int ab = 0; ab < 4; ++ab) {
            const int ai = ab >> 1, m0 = 2 * (ab & 1);
            if (ab + 2 < 4) EPIRES_ISSUE(ab + 2);
            const u32x4 (&xa)[2][2] = xab[ab % 3]; const u32x2 (&xc)[2][2] = xcb[ab % 3];
#pragma unroll
            for (int mm = 0; mm < 2; ++mm) {
                const int m = m0 + mm, row = row0 + ai * 128 + m * 16; f32x2v ssq2 = (f32x2v){0.f, 0.f};
#pragma unroll
                for (int bj = 0; bj < 2; ++bj) {
                    const unsigned eo = e0 + (unsigned)((ai * 128 + m * 16) * D + bj * 128); const size_t o = (size_t)eo;
                    f32x2v v2[4];
                    { const f32x2v l2[4] = {__builtin_amdgcn_cvt_pk_f32_fp8((int)xc[mm][bj].x, false), __builtin_amdgcn_cvt_pk_f32_fp8((int)xc[mm][bj].x, true),
                                            __builtin_amdgcn_cvt_pk_f32_fp8((int)xc[mm][bj].y, false), __builtin_amdgcn_cvt_pk_f32_fp8((int)xc[mm][bj].y, true)};
#pragma unroll
                      for (int e = 0; e < 4; ++e) { const f32x2v a2 = (f32x2v){acc[ai][bj][m][e >> 1][2 * (e & 1)], acc[ai][bj][m][e >> 1][2 * (e & 1) + 1]}, h2 = (f32x2v){bf_lo(xa[mm][bj][e]), bf_hi(xa[mm][bj][e])};
                          v2[e] = a2 * sc + h2; v2[e] = l2[e] * (1.0f / 512.0f) + v2[e]; } }
                    if constexpr (LAST) { __builtin_nontemporal_store((f32x4){v2[0][0], v2[0][1], v2[1][0], v2[1][1]}, (f32x4*)(out + o)); __builtin_nontemporal_store((f32x4){v2[2][0], v2[2][1], v2[3][0], v2[3][1]}, (f32x4*)(out + o + 4)); }
                    else {
                        u32x4 wh; f32x2v lw2[4];
#pragma unroll
                        for (int e = 0; e < 4; ++e) { wh[e] = pg8::cvt_pk_bf16(v2[e][0], v2[e][1]); ssq2 = v2[e] * v2[e] + ssq2;
                            const f32x2v hn2 = (f32x2v){bf_lo(wh[e]), bf_hi(wh[e])}; lw2[e] = (v2[e] - hn2) * 512.0f; }
                        int wl0 = 0, wl1 = 0;
                        wl0 = __builtin_amdgcn_cvt_pk_fp8_f32(lw2[0][0], lw2[0][1], wl0, false); wl0 = __builtin_amdgcn_cvt_pk_fp8_f32(lw2[1][0], lw2[1][1], wl0, true);
                        wl1 = __builtin_amdgcn_cvt_pk_fp8_f32(lw2[2][0], lw2[2][1], wl1, false); wl1 = __builtin_amdgcn_cvt_pk_fp8_f32(lw2[3][0], lw2[3][1], wl1, true);
                        *(u32x4*)((char*)xhb + (size_t)(2u * eo)) = wh; { u32x2 wl; wl.x = (unsigned)wl0; wl.y = (unsigned)wl1; *(u32x2*)((char*)xlb + (size_t)eo) = wl; }
                        if constexpr (F8) { int w0 = 0, w1 = 0; w0 = __builtin_amdgcn_cvt_pk_fp8_f32(v2[0][0], v2[0][1], w0, false); w0 = __builtin_amdgcn_cvt_pk_fp8_f32(v2[1][0], v2[1][1], w0, true);
                            w1 = __builtin_amdgcn_cvt_pk_fp8_f32(v2[2][0], v2[2][1], w1, false); w1 = __builtin_amdgcn_cvt_pk_fp8_f32(v2[3][0], v2[3][1], w1, true); u32x2 w8; w8.x = (unsigned)w0; w8.y = (unsigned)w1; *(u32x2*)(x8 + o) = w8; }
                    }
                }
                if constexpr (!LAST) { float ssq = xrow16_sum(ssq2[0] + ssq2[1]);
                    if (fq == 0) __hip_atomic_fetch_add(rsq_next + row, (u64)(ssq * SSQ_SCALE), __ATOMIC_RELAXED, __HIP_MEMORY_SCOPE_AGENT); }
            }
        }
    }
};
#undef EPIRES_ISSUE
template <int MODE = 0> struct EpiInT {
    static constexpr bool PERM = true, MID = false; static constexpr int MID_T0 = -1, MID_T1 = -1;
    unsigned char* ws; const u64* rsq; const float* qkg; LAS unsigned char* lds;
    __device__ __forceinline__ void mid(f32x4 (&)[2][2][4][2], const pg8::Unit&, int, int, int, int, int) const {}
    __device__ __forceinline__ void operator()(const f32x4 (&acc)[2][2][4][2], const pg8::Unit& u, int wr, int wc, int fr, int fq) const {
        const int c = (MODE == 1) ? ((FP8_QA == 2 && u.pn >= 12) ? u.pn + 20 : u.pn + 12)
                    : (MODE == 2) ? (FP8_QA == 2 ? (u.pn < 24 ? u.pn + 36 : (u.pn < 36 ? u.pn - 24 : u.pn - 12)) : (u.pn >= 12 ? u.pn + 24 : u.pn)) : u.pn;
        size_t off; int ldc, lc, gi = -1; bool gate = false;
        if (c < 6) { off = WS_QA; ldc = 1536; lc = c; gi = 0; } else if (c < 12) { off = WS_KA; ldc = 1536; lc = c - 6; gi = 1; } else if (c < 18) { off = WS_VA; ldc = 1536; lc = c - 12; }
        else if (c < 22) { off = WS_QB; ldc = 1024; lc = c - 18; gi = 2; } else if (c == 22) { off = WS_KB; ldc = 256; lc = 0; gi = 3; } else if (c == 23) { off = WS_VB; ldc = 256; lc = 0; }
        else if (c < 28) { off = WS_QC; ldc = 1024; lc = c - 24; gi = 4; } else if (c < 32) { off = WS_KC; ldc = 1024; lc = c - 28; gi = 5; } else if (c < 36) { off = WS_VC; ldc = 1024; lc = c - 32; }
        else { off = WS_G; ldc = 6144; lc = c - 36; gate = true; }
        bf16* dst = (bf16*)(ws + off);
        const int row0 = u.pm * 256 + wr * 64 + fr, col0 = lc * 256 + wc * 32 + 8 * fq;
        float rs[2][4]; rstd8(rsq, lds, u.pm, wr, wc, fr, fq, MODE == 2 ? 1.0f / W8_SCALE : 1.0f, rs);
        if (QKN_IN_EPI && gi >= 0) {
            LAS float* T = (LAS float*)(lds + RING_BYTES + 512);
#pragma unroll
            for (int ai = 0; ai < 2; ++ai)
#pragma unroll
                for (int mp = 0; mp < 2; ++mp) {
                    float pv[4];
#pragma unroll
                    for (int k = 0; k < 4; ++k) {
                        const f32x4 a = acc[ai][k & 1][2 * mp + (k >> 1)][0], b = acc[ai][k & 1][2 * mp + (k >> 1)][1];
                        f32x2v q2 = (f32x2v){a[0], a[1]} * (f32x2v){a[0], a[1]}; q2 = (f32x2v){a[2], a[3]} * (f32x2v){a[2], a[3]} + q2;
                        q2 = (f32x2v){b[0], b[1]} * (f32x2v){b[0], b[1]} + q2; q2 = (f32x2v){b[2], b[3]} * (f32x2v){b[2], b[3]} + q2;
                        pv[k] = q2[0] + q2[1];
                    }
                    auto s0 = __builtin_amdgcn_permlane16_swap(__float_as_uint(pv[0]), __float_as_uint(pv[1]), false, false);
                    const float t0 = __uint_as_float(s0[0]) + __uint_as_float(s0[1]);
                    auto s1 = __builtin_amdgcn_permlane16_swap(__float_as_uint(pv[2]), __float_as_uint(pv[3]), false, false);
                    const float t1 = __uint_as_float(s1[0]) + __uint_as_float(s1[1]);
                    auto s2 = __builtin_amdgcn_permlane32_swap(__float_as_uint(t0), __float_as_uint(t1), false, false);
                    const float tot = __uint_as_float(s2[0]) + __uint_as_float(s2[1]);
                    T[((ai * 128 + wr * 64 + (2 * mp + (fq >> 1)) * 16 + fr) * 2 + (fq & 1)) * 4 + wc] = tot;
                }
            asm volatile("s_waitcnt lgkmcnt(0)" ::: "memory"); __builtin_amdgcn_s_barrier(); asm volatile("" ::: "memory");
            const f32x4 g0 = *(const f32x4*)(qkg + gi * 128 + wc * 32 + 8 * fq), g1 = *(const f32x4*)(qkg + gi * 128 + wc * 32 + 8 * fq + 4);
#pragma unroll
            for (int ai = 0; ai < 2; ++ai)
#pragma unroll
                for (int m = 0; m < 4; ++m) {
                    const int row = row0 + ai * 128 + m * 16;
#pragma unroll
                    for (int bj = 0; bj < 2; ++bj) {
                        const f32x4 t = *(const LAS f32x4*)(T + ((ai * 128 + wr * 64 + m * 16 + fr) * 2 + bj) * 4);
                        const float sc = rs[ai][m] * rsqrtf(((t[0] + t[1]) + (t[2] + t[3])) * (rs[ai][m] * rs[ai][m] * (1.0f / 128.0f)) + EPS);
                        const f32x4 a = acc[ai][bj][m][0] * sc * g0, b = acc[ai][bj][m][1] * sc * g1;
                        u32x4 w; w.x = pg8::cvt_pk_bf16(a[0], a[1]); w.y = pg8::cvt_pk_bf16(a[2], a[3]); w.z = pg8::cvt_pk_bf16(b[0], b[1]); w.w = pg8::cvt_pk_bf16(b[2], b[3]);
                        *(u32x4*)(dst + (size_t)row * ldc + col0 + bj * 128) = w;
                    }
                }
            return;
        }
        if (gate) {
            unsigned char* g8 = ws + WS_G; const float C255 = sconst(0x437f0000u);
#pragma unroll
            for (int ai = 0; ai < 2; ++ai)
#pragma unroll
                for (int m = 0; m < 4; ++m) {
                    const int row = row0 + ai * 128 + m * 16; const float rl = rs[ai][m] * -1.44269504f;
#pragma unroll
                    for (int bj = 0; bj < 2; ++bj) {
                        unsigned wq[2];
#pragma unroll
                        for (int n = 0; n < 2; ++n) {
                            unsigned wv = 0u;
#pragma unroll
                            for (int j = 0; j < 4; j += 2) {
                                const f32x2v a2 = (f32x2v){acc[ai][bj][m][n][j], acc[ai][bj][m][n][j + 1]}; const f32x2v t2 = a2 * rl;
                                f32x2v e2 = (f32x2v){__builtin_amdgcn_exp2f(t2[0]), __builtin_amdgcn_exp2f(t2[1])}; e2 = e2 + 1.0f;
                                const f32x2v s2 = (f32x2v){__builtin_amdgcn_rcpf(e2[0]), __builtin_amdgcn_rcpf(e2[1])}; const f32x2v q2 = s2 * C255 + 0.5f;
                                wv |= (unsigned)fmaxf(q2[0], 1.0f) << (8 * j); wv |= (unsigned)fmaxf(q2[1], 1.0f) << (8 * j + 8);
                            }
                            wq[n] = wv;
                        }
                        u32x2 w; w.x = wq[0]; w.y = wq[1];
                        *(u32x2*)(g8 + (size_t)row * 6144 + col0 + bj * 128) = w;
                    }
                }
            return;
        }
#pragma unroll
        for (int ai = 0; ai < 2; ++ai)
#pragma unroll
            for (int m = 0; m < 4; ++m) {
                const int row = row0 + ai * 128 + m * 16; const float r_ = rs[ai][m];
#pragma unroll
                for (int bj = 0; bj < 2; ++bj) {
                    const f32x4 a = acc[ai][bj][m][0] * r_, b = acc[ai][bj][m][1] * r_;
                    u32x4 w; w.x = pg8::cvt_pk_bf16(a[0], a[1]); w.y = pg8::cvt_pk_bf16(a[2], a[3]); w.z = pg8::cvt_pk_bf16(b[0], b[1]); w.w = pg8::cvt_pk_bf16(b[2], b[3]);
                    *(u32x4*)(dst + (size_t)row * ldc + col0 + bj * 128) = w;
                }
            }
    }
};
typedef EpiInT<0> EpiIn;
struct EpiIn8 {
    static constexpr bool PERM = true, MID = false; static constexpr int MID_T0 = -1, MID_T1 = -1;
    unsigned char* ws; const u64* rsq; const float* qkg; LAS unsigned char* lds;
    __device__ __forceinline__ void mid(f32x4 (&)[2][2][4][2], const pg8::Unit&, int, int, int, int, int) const {}
    __device__ __forceinline__ void operator()(const f32x4 (&acc)[2][2][4][2], const pg8::Unit& u, int wr, int wc, int fr, int fq) const {
        const int c = u.pn; size_t off = WS_QA; int ldc = 1536, lc = c, gi = 0;
        if (c < 6) { off = WS_QA; ldc = 1536; lc = c; gi = 0; } else if (c < 12) { off = WS_KA; ldc = 1536; lc = c - 6; gi = 1; }
        else if (c < 16) { off = WS_QB; ldc = 1024; lc = c - 12; gi = 2; } else if (c == 16) { off = WS_KB; ldc = 256; lc = 0; gi = 3; }
        else if (c < 21) { off = WS_QC; ldc = 1024; lc = c - 17; gi = 4; } else if (c < 25) { off = WS_KC; ldc = 1024; lc = c - 21; gi = 5; }
        asm volatile("" : "+v"(fr), "+v"(fq));
        const int row0 = u.pm * 256 + wr * 64 + fr;
        float rs[2][4];
#pragma unroll
        for (int ai = 0; ai < 2; ++ai)
#pragma unroll
            for (int m = 0; m < 4; ++m) rs[ai][m] = rstd_row(rsq, row0 + ai * 128 + m * 16) * (1.0f / W8_SCALE);
        if (c >= 25) {
            unsigned char* g8 = ws + WS_G; const float C255 = sconst(0x437f0000u); const int col0 = (c - 25) * 256 + wc * 32 + 8 * fq;
#pragma unroll
            for (int ai = 0; ai < 2; ++ai)
#pragma unroll
                for (int m = 0; m < 4; ++m) {
                    const int row = row0 + ai * 128 + m * 16; const float r_ = rs[ai][m];
#pragma unroll
                    for (int bj = 0; bj < 2; ++bj) {
                        u32x2 w; w.x = 0u; w.y = 0u;
#pragma unroll
                        for (int j = 0; j < 4; ++j) {
                            const float qa = fminf(fmaxf(sigmoidf_(acc[ai][bj][m][0][j] * r_) * C255 + 0.5f, 1.0f), C255), qb = fminf(fmaxf(sigmoidf_(acc[ai][bj][m][1][j] * r_) * C255 + 0.5f, 1.0f), C255);
                            w.x |= (unsigned)qa << (8 * j); w.y |= (unsigned)qb << (8 * j);
                        }
                        *(u32x2*)(g8 + (size_t)row * 6144 + col0 + bj * 128) = w;
                    }
                }
            return;
        }
        bf16* dst = (bf16*)(ws + off); const int col0 = lc * 256 + wc * 32 + 8 * fq;
        LAS float* T = (LAS float*)(lds + RING_BYTES + 512);
#pragma unroll
        for (int ai = 0; ai < 2; ++ai)
#pragma unroll
            for (int m = 0; m < 4; ++m)
#pragma unroll
                for (int bj = 0; bj < 2; ++bj) {
                    const f32x4 a = acc[ai][bj][m][0], b = acc[ai][bj][m][1];
                    float p = ((a[0] * a[0] + a[1] * a[1]) + (a[2] * a[2] + a[3] * a[3])) + ((b[0] * b[0] + b[1] * b[1]) + (b[2] * b[2] + b[3] * b[3]));
                    p *= rs[ai][m] * rs[ai][m];
                    p = xrow16_sum(p);
                    if (fq == 0) T[((ai * 128 + wr * 64 + m * 16 + fr) * 2 + bj) * 4 + wc] = p;
                }
        asm volatile("s_waitcnt lgkmcnt(0)" ::: "memory"); __builtin_amdgcn_s_barrier(); asm volatile("" ::: "memory");
        const f32x4 g0 = *(const f32x4*)(qkg + gi * 128 + wc * 32 + 8 * fq), g1 = *(const f32x4*)(qkg + gi * 128 + wc * 32 + 8 * fq + 4);
#pragma unroll
        for (int ai = 0; ai < 2; ++ai)
#pragma unroll
            for (int m = 0; m < 4; ++m) {
                const int row = row0 + ai * 128 + m * 16;
#pragma unroll
                for (int bj = 0; bj < 2; ++bj) {
                    const f32x4 t = *(const LAS f32x4*)(T + ((ai * 128 + wr * 64 + m * 16 + fr) * 2 + bj) * 4);
                    const float sc = rs[ai][m] * rsqrtf(((t[0] + t[1]) + (t[2] + t[3])) * (1.0f / 128.0f) + EPS);
                    const f32x4 a = acc[ai][bj][m][0] * sc * g0, b = acc[ai][bj][m][1] * sc * g1;
                    u32x4 w; w.x = pg8::cvt_pk_bf16(a[0], a[1]); w.y = pg8::cvt_pk_bf16(a[2], a[3]); w.z = pg8::cvt_pk_bf16(b[0], b[1]); w.w = pg8::cvt_pk_bf16(b[2], b[3]);
                    *(u32x4*)(dst + (size_t)row * ldc + col0 + bj * 128) = w;
                }
            }
    }
};
struct EpiV {
    static constexpr bool PERM = true, MID = false; static constexpr int MID_T0 = -1, MID_T1 = -1;
    unsigned char* ws; const u64* rsq;
    __device__ __forceinline__ void mid(f32x4 (&)[2][2][4][2], const pg8::Unit&, int, int, int, int, int) const {}
    __device__ __forceinline__ void operator()(const f32x4 (&acc)[2][2][4][2], const pg8::Unit& u, int wr, int wc, int fr, int fq) const {
        const int c = u.pn; size_t off = WS_VA; int ldc = 1536, lc = c;
        if (c < 6) { off = WS_VA; ldc = 1536; lc = c; } else if (c == 6) { off = WS_VB; ldc = 256; lc = 0; } else { off = WS_VC; ldc = 1024; lc = c - 7; }
        bf16* dst = (bf16*)(ws + off);
        const int row0 = u.pm * 256 + wr * 64 + fr, col0 = lc * 256 + wc * 32 + 8 * fq;
#pragma unroll
        for (int ai = 0; ai < 2; ++ai)
#pragma unroll
            for (int m = 0; m < 4; ++m) {
                const int row = row0 + ai * 128 + m * 16; const float r_ = rstd_row(rsq, row);
#pragma unroll
                for (int bj = 0; bj < 2; ++bj) {
                    const f32x4 a = acc[ai][bj][m][0] * r_, b = acc[ai][bj][m][1] * r_;
                    u32x4 w; w.x = pg8::cvt_pk_bf16(a[0], a[1]); w.y = pg8::cvt_pk_bf16(a[2], a[3]); w.z = pg8::cvt_pk_bf16(b[0], b[1]); w.w = pg8::cvt_pk_bf16(b[2], b[3]);
                    *(u32x4*)(dst + (size_t)row * ldc + col0 + bj * 128) = w;
                }
            }
    }
};
struct EpiGate {
    static constexpr bool PERM = true, MID = false; static constexpr int MID_T0 = -1, MID_T1 = -1;
    unsigned char* g8; const u64* rsq; LAS unsigned char* lds;
    __device__ __forceinline__ void mid(f32x4 (&)[2][2][4][2], const pg8::Unit&, int, int, int, int, int) const {}
    __device__ __forceinline__ void operator()(const f32x4 (&acc)[2][2][4][2], const pg8::Unit& u, int wr, int wc, int fr, int fq) const {
        const int row0 = u.pm * 256 + wr * 64 + fr, col0 = u.pn * 256 + wc * 32 + 8 * fq; const float C255 = sconst(0x437f0000u);
        float rs8[2][4]; rstd8(rsq, lds, u.pm, wr, wc, fr, fq, 1.0f / W8_SCALE, rs8);
#pragma unroll
        for (int ai = 0; ai < 2; ++ai)
#pragma unroll
            for (int m = 0; m < 4; ++m) {
                const int row = row0 + ai * 128 + m * 16; const float rl = rs8[ai][m] * -1.44269504f;
#pragma unroll
                for (int bj = 0; bj < 2; ++bj) {
                    unsigned wq[2];
#pragma unroll
                    for (int n = 0; n < 2; ++n) {
                        unsigned wv = 0u;
#pragma unroll
                        for (int j = 0; j < 4; j += 2) {
                            const f32x2v a2 = (f32x2v){acc[ai][bj][m][n][j], acc[ai][bj][m][n][j + 1]}; const f32x2v t2 = a2 * rl;
                            f32x2v e2 = (f32x2v){__builtin_amdgcn_exp2f(t2[0]), __builtin_amdgcn_exp2f(t2[1])}; e2 = e2 + 1.0f;
                            const f32x2v s2 = (f32x2v){__builtin_amdgcn_rcpf(e2[0]), __builtin_amdgcn_rcpf(e2[1])}; const f32x2v q2 = s2 * C255 + 0.5f;
                            wv |= (unsigned)fmaxf(q2[0], 1.0f) << (8 * j); wv |= (unsigned)fmaxf(q2[1], 1.0f) << (8 * j + 8);
                        }
                        wq[n] = wv;
                    }
                    u32x2 w; w.x = wq[0]; w.y = wq[1];
                    *(u32x2*)(g8 + (size_t)row * 6144 + col0 + bj * 128) = w;
                }
            }
    }
};
struct EpiBr {
    static constexpr bool PERM = true, MID = true; static constexpr int MID_T0 = 8, MID_T1 = 24;
    const unsigned char* G; bf16* z;
    __device__ __forceinline__ void mid(f32x4 (&acc)[2][2][4][2], const pg8::Unit& u, int t, int wr, int wc, int fr, int fq) const {
        const unsigned char* ga = G + (t == MID_T0 ? 0 : 2048);
        int frx = fr, fqx = fq; asm volatile("" : "+v"(frx), "+v"(fqx));
        const int row0 = u.pm * 256 + wr * 64 + frx, col0 = u.pn * 256 + wc * 32 + 8 * fqx;
        const unsigned char* gab = ga; asm volatile("" : "+s"(gab));
        const unsigned o0 = (unsigned)row0 * 6144u + (unsigned)col0;
        u32x2 na[2][4][2], nb[2][4][2];
#pragma unroll
        for (int ai = 0; ai < 2; ++ai)
#pragma unroll
            for (int m = 0; m < 4; ++m)
#pragma unroll
                for (int bj = 0; bj < 2; ++bj) { const unsigned o = o0 + (unsigned)((ai * 128 + m * 16) * 6144 + bj * 128); na[ai][m][bj] = *(const u32x2*)(gab + (size_t)o); nb[ai][m][bj] = *(const u32x2*)(gab + (size_t)(o + 2048u)); }
#pragma unroll
        for (int ai = 0; ai < 2; ++ai)
#pragma unroll
            for (int m = 0; m < 4; ++m)
#pragma unroll
                for (int bj = 0; bj < 2; ++bj)
#pragma unroll
                    for (int n = 0; n < 2; ++n)
#pragma unroll
                        for (int j = 0; j < 4; ++j)
                            acc[ai][bj][m][n][j] *= (float)((na[ai][m][bj][n] >> (8 * j)) & 0xffu) * __builtin_amdgcn_rcpf((float)((nb[ai][m][bj][n] >> (8 * j)) & 0xffu));
    }
    __device__ __forceinline__ void operator()(const f32x4 (&acc)[2][2][4][2], const pg8::Unit& u, int wr, int wc, int fr, int fq) const {
        const int row0 = u.pm * 256 + wr * 64 + fr, col0 = u.pn * 256 + wc * 32 + 8 * fq;
#pragma unroll
        for (int ai = 0; ai < 2; ++ai)
#pragma unroll
            for (int m = 0; m < 4; ++m) {
                const int row = row0 + ai * 128 + m * 16;
#pragma unroll
                for (int bj = 0; bj < 2; ++bj) {
                    const u32x2 ng = *(const u32x2*)(G + (size_t)row * 6144 + 4096 + col0 + bj * 128);
                    float o[8];
#pragma unroll
                    for (int n = 0; n < 2; ++n)
#pragma unroll
                        for (int j = 0; j < 4; ++j) o[4 * n + j] = acc[ai][bj][m][n][j] * ((float)((ng[n] >> (8 * j)) & 0xffu) * (1.0f / 255.0f));
                    u32x4 w; w.x = pg8::cvt_pk_bf16(o[0], o[1]); w.y = pg8::cvt_pk_bf16(o[2], o[3]); w.z = pg8::cvt_pk_bf16(o[4], o[5]); w.w = pg8::cvt_pk_bf16(o[6], o[7]);
                    *(u32x4*)(z + (size_t)row * D + col0 + bj * 128) = w;
                }
            }
    }
};

__device__ __forceinline__ void cvt_item(const float* __restrict__ W, int N, const float* __restrict__ scale, bf16* dst, int dpitch, int dcol, int mode, int kb, int nb, LAS unsigned* T, int lane) {
    const int k0 = kb * 64, n0 = nb * 64, kpl = lane >> 4, n4 = (lane & 15) * 4;
    f32x4 r0[8], r1[8];
#pragma unroll
    for (int i = 0; i < 8; ++i) { const int k = k0 + 2 * (4 * i + kpl); r0[i] = __builtin_nontemporal_load((const f32x4*)(W + (size_t)k * N + n0 + n4)); r1[i] = __builtin_nontemporal_load((const f32x4*)(W + (size_t)(k + 1) * N + n0 + n4)); }
#pragma unroll
    for (int i = 0; i < 8; ++i) { const int kp = 4 * i + kpl, k = k0 + 2 * kp; const float s0 = scale ? scale[k] : 1.f, s1 = scale ? scale[k + 1] : 1.f;
#pragma unroll
        for (int j = 0; j < 4; ++j) T[(n4 + j) * 33 + kp] = pk2(r0[i][j] * s0, r1[i][j] * s1); }
    LDS_WAIT(); asm volatile("" ::: "memory");
    const int q = lane & 7;
#pragma unroll
    for (int i = 0; i < 8; ++i) { const int n = 8 * i + (lane >> 3); const LAS unsigned* s = T + n * 33 + 4 * q;
        u32x4 o; o.x = s[0]; o.y = s[1]; o.z = s[2]; o.w = s[3];
        const int c = n0 + n; int drow = c;
        if (mode == 1) { drow = (c < FF) ? (256 * (c >> 7) + (c & 127)) : (256 * ((c - FF) >> 7) + 128 + ((c - FF) & 127)); }
        __builtin_nontemporal_store(o, (u32x4*)(dst + (size_t)drow * dpitch + dcol + k0 + 8 * q)); }
    LDS_WAIT(); asm volatile("" ::: "memory");
}

__device__ __forceinline__ void cvt_item_fp8(const float* __restrict__ W, int N, const float* __restrict__ scale, unsigned char* dst, int K, int ncol0, int kb, int nb, LAS unsigned* T, int lane) {
    const int k0 = kb * 64, n0 = nb * 64, kql = lane >> 4, n4 = (lane & 15) * 4;
#pragma unroll
    for (int ih = 0; ih < 2; ++ih) {
        f32x4 r[2][4];
#pragma unroll
        for (int i = 0; i < 2; ++i)
#pragma unroll
            for (int e = 0; e < 4; ++e) r[i][e] = __builtin_nontemporal_load((const f32x4*)(W + (size_t)(k0 + 4 * (4 * (2 * ih + i) + kql) + e) * N + ncol0 + n0 + n4));
#pragma unroll
        for (int i = 0; i < 2; ++i) { const int kq = 4 * (2 * ih + i) + kql, k = k0 + 4 * kq; const f32x4 sc = *(const f32x4*)(scale + k) * W8_SCALE;
#pragma unroll
            for (int j = 0; j < 4; ++j) { int w = 0; w = __builtin_amdgcn_cvt_pk_fp8_f32(r[i][0][j] * sc[0], r[i][1][j] * sc[1], w, false); w = __builtin_amdgcn_cvt_pk_fp8_f32(r[i][2][j] * sc[2], r[i][3][j] * sc[3], w, true);
                T[(n4 + j) * 17 + kq] = (unsigned)w; } }
    }
    LDS_WAIT(); asm volatile("" ::: "memory");
    const int q = lane & 3;
#pragma unroll
    for (int i = 0; i < 4; ++i) { const int n = 16 * i + (lane >> 2); const LAS unsigned* sp = T + n * 17 + 4 * q;
        u32x4 o; o.x = sp[0]; o.y = sp[1]; o.z = sp[2]; o.w = sp[3];
        __builtin_nontemporal_store(o, (u32x4*)(dst + (size_t)(n0 + n) * K + k0 + 16 * q)); }
    LDS_WAIT(); asm volatile("" ::: "memory");
}

struct Args { const float* in[18]; float* out; unsigned char* ws; int ph_lo, ph_hi; };
typedef const __attribute__((address_space(4))) Args* KArgs;

__device__ __forceinline__ void prologue(KArgs a, LAS unsigned char* lds, int gw, int NGW, int wave, int lane) {
    LAS unsigned* T = (LAS unsigned*)(lds + wave * 16384);
    constexpr int I0 = 32 * 176, I1 = 88 * 32, I2Q = 32 * 144, I2 = FP8_GATES ? 32 * 144 + 32 * 96 : 32 * 240, I3 = 8 * 32, I4 = 16 * 32, I5 = 16 * 32, I6 = 32 * 32, PER = 2 * I0 + 2 * I1 + I2 + I3 + I4 + I5 + I6;
    for (int it = gw; it < DEPTH * PER; it += NGW) {
        const int l = it / PER; int r = it % PER; unsigned char* wl = a->ws + WS_W + (size_t)l * W_LAYER;
        if (r < I0) { cvt_item(a->in[4] + (size_t)l * D * 2 * FF, 2 * FF, a->in[3] + l * D, (bf16*)(wl + W_1A), D, 0, 1, r / 176, r % 176, T, lane); continue; } r -= I0;
        if (r < I1) { cvt_item(a->in[5] + (size_t)l * FF * D, D, nullptr, (bf16*)(wl + W_1B), FF, 0, 0, r / 32, r % 32, T, lane); continue; } r -= I1;
        if (FP8_GATES && FP8_QK) {
            if (r < 32 * 196) { const int kb = r / 196, nb = r % 196, d0 = 64 * nb; const int off = d0 < 3072 ? 0 : (d0 < 4352 ? 1536 : (d0 < 6400 ? 1792 : 2816));
                cvt_item_fp8(a->in[7] + (size_t)l * D * NIN, NIN, a->in[6] + l * D, wl + W_IN8, D, off, kb, nb, T, lane); continue; }
            if (r < I2) { const int rr = r - 32 * 196, kb = rr / 44, nb = rr % 44, d0 = 64 * nb; const int off = d0 < 1536 ? 3072 : (d0 < 1792 ? 4352 : 6400);
                cvt_item(a->in[7] + (size_t)l * D * NIN + off, NIN, a->in[6] + l * D, (bf16*)(wl + W_IN), D, 0, 0, kb, nb, T, lane); continue; }
            r -= I2;
        } else if (FP8_GATES) {
            if (FP8_QA) {
                if (FP8_QA == 2) {
                    if (r < 32 * 64) { const int nbl = r % 64; cvt_item(a->in[7] + (size_t)l * D * NIN + (nbl < 48 ? 0 : 2048), NIN, a->in[6] + l * D, (bf16*)(wl + W_IN), D, 0, 0, r / 64, 48 + nbl, T, lane); continue; }
                    if (r < I2) { const int rr = r - 32 * 64, nb = rr % 176; cvt_item_fp8(a->in[7] + (size_t)l * D * NIN, NIN, a->in[6] + l * D, wl + W_IN8, D, nb < 96 ? 9216 : (nb < 144 ? -6144 : -3072), rr / 176, nb, T, lane); continue; }
                }
                if (r < 32 * 96) { cvt_item(a->in[7] + (size_t)l * D * NIN, NIN, a->in[6] + l * D, (bf16*)(wl + W_IN), D, 0, 0, r / 96, 48 + r % 96, T, lane); continue; }
                if (r < I2) { const int rr = r - 32 * 96, nb = rr % 144; cvt_item_fp8(a->in[7] + (size_t)l * D * NIN, NIN, a->in[6] + l * D, wl + W_IN8, D, nb < 48 ? 0 : 6144, rr / 144, nb, T, lane); continue; }
            } else {
            if (r < I2Q) { cvt_item(a->in[7] + (size_t)l * D * NIN, NIN, a->in[6] + l * D, (bf16*)(wl + W_IN), D, 0, 0, r / 144, r % 144, T, lane); continue; }
            if (r < I2) { const int rr = r - I2Q; cvt_item_fp8(a->in[7] + (size_t)l * D * NIN, NIN, a->in[6] + l * D, wl + W_IN8, D, 9216, rr / 96, rr % 96, T, lane); continue; }
            }
            r -= I2;
        } else { if (r < I2) { cvt_item(a->in[7] + (size_t)l * D * NIN, NIN, a->in[6] + l * D, (bf16*)(wl + W_IN), D, 0, 0, r / 240, r % 240, T, lane); continue; } r -= I2; }
        if (r < I3) { cvt_item(a->in[11] + (size_t)l * 512 * D, D, nullptr, (bf16*)(wl + W_BR), KBR, 0, 0, r / 32, r % 32, T, lane); continue; } r -= I3;
        if (r < I4) { cvt_item(a->in[12] + (size_t)l * 1024 * D, D, nullptr, (bf16*)(wl + W_BR), KBR, 512, 0, r / 32, r % 32, T, lane); continue; } r -= I4;
        if (r < I5) { cvt_item(a->in[13] + (size_t)l * 1024 * D, D, nullptr, (bf16*)(wl + W_BR), KBR, 1536, 0, r / 32, r % 32, T, lane); continue; } r -= I5;
        if (r < I6) { cvt_item(a->in[14] + (size_t)l * D * D, D, nullptr, (bf16*)(wl + W_O), D, 0, 0, r / 32, r % 32, T, lane); continue; } r -= I6;
        if (r < I0) { cvt_item(a->in[16] + (size_t)l * D * 2 * FF, 2 * FF, a->in[15] + l * D, (bf16*)(wl + W_2A), D, 0, 1, r / 176, r % 176, T, lane); continue; } r -= I0;
        cvt_item(a->in[17] + (size_t)l * FF * D, D, nullptr, (bf16*)(wl + W_2B), FF, 0, 0, r / 32, r % 32, T, lane);
    }
    u64* rsq0 = (u64*)(a->ws + WS_RSQ); bf16* xb = (bf16*)(a->ws + WS_XB); unsigned char* xl = a->ws + WS_XL;
    for (int row = gw; row < M; row += NGW) {
        const float* src = row < 8192 ? a->in[0] + (size_t)row * D : a->in[1] + (size_t)(row - 8192) * D;
        f32x4 v[8]; float s = 0.f;
#pragma unroll
        for (int j = 0; j < 8; ++j) { v[j] = __builtin_nontemporal_load((const f32x4*)(src + 256 * j + 4 * lane)); s += (v[j][0] * v[j][0] + v[j][1] * v[j][1]) + (v[j][2] * v[j][2] + v[j][3] * v[j][3]); }
#pragma unroll
        for (int j = 0; j < 8; ++j) {
            u32x2 w; w.x = pk2(v[j][0], v[j][1]); w.y = pk2(v[j][2], v[j][3]); *(u32x2*)(xb + (size_t)row * D + 256 * j + 4 * lane) = w;
            int wl = 0; wl = __builtin_amdgcn_cvt_pk_fp8_f32((v[j][0] - bf_lo(w.x)) * 512.0f, (v[j][1] - bf_hi(w.x)) * 512.0f, wl, false); wl = __builtin_amdgcn_cvt_pk_fp8_f32((v[j][2] - bf_lo(w.y)) * 512.0f, (v[j][3] - bf_hi(w.y)) * 512.0f, wl, true);
            *(unsigned*)(xl + (size_t)row * D + 256 * j + 4 * lane) = (unsigned)wl; }
        s = wave_sum(s);
        if (lane == 0) rsq0[row] = (u64)(s * SSQ_SCALE);
    }
}

__device__ __forceinline__ int t5_bucket_dev(int rel) {
    const int n = rel < 0 ? -rel : rel; int b;
    if (n < 8) b = n; else b = 8 + (n >= 15) + (n >= 27) + (n >= 50) + (n >= 91) + (n >= 166) + (n >= 305) + (n >= 559);
    return b + (rel > 0 ? 16 : 0);
}
__device__ __forceinline__ void seq_of(int row, int& base, int& L) { if (row < 8192) { base = 0; L = 8192; } else if (row < 12288) { base = 8192; L = 4096; } else { base = 12288; L = 4096; } }

__device__ __forceinline__ void qknorm_phase(unsigned char* ws, const float* qk_norm, int l, int gw, int NGW, int lane) {
    const float* qkg = qk_norm + (size_t)l * 6 * 128;
    for (int it = gw; it < M * 50; it += NGW) {
        const int row = it / 50, s = it % 50; size_t off; int ldc, h, gi;
        if (s < 12) { off = WS_QA; ldc = 1536; h = s; gi = 0; } else if (s < 24) { off = WS_KA; ldc = 1536; h = s - 12; gi = 1; }
        else if (s < 32) { off = WS_QB; ldc = 1024; h = s - 24; gi = 2; } else if (s < 34) { off = WS_KB; ldc = 256; h = s - 32; gi = 3; }
        else if (s < 42) { off = WS_QC; ldc = 1024; h = s - 34; gi = 4; } else { off = WS_KC; ldc = 1024; h = s - 42; gi = 5; }
        unsigned* p = (unsigned*)((bf16*)(ws + off) + (size_t)row * ldc + h * 128) + lane;
        const unsigned w = *p; const float v0 = bf_lo(w), v1 = bf_hi(w);
        const float ss = wave_sum(v0 * v0 + v1 * v1);
        const float r = rsqrtf(ss * (1.0f / 128.0f) + EPS);
        *p = pk2(v0 * r * qkg[gi * 128 + 2 * lane], v1 * r * qkg[gi * 128 + 2 * lane + 1]);
    }
}

__device__ __forceinline__ void attn_naive_phase(unsigned char* ws, const float* relb, const float* sink_all, const float* rpb_all, int l, LAS unsigned char* lds, int gw, int NGW, int wave, int lane) {
    LAS unsigned char* tab = lds + 8192;
    for (int n = wave * 64 + lane; n <= 1024; n += NWAVES * 64) tab[n] = (unsigned char)t5_bucket_dev(-n);
    __syncthreads();
    LAS float* pl = (LAS float*)(lds + wave * 16384); LAS int* tl = (LAS int*)(lds + wave * 16384 + 2048);
    const float* sink = sink_all + l * 8; const float* rpb = rpb_all + (size_t)l * 8 * 15 * 31;
    for (int it = gw; it < 28 * M; it += NGW) {
        const int h28 = it / M, row = it % M; int base, L; seq_of(row, base, L); const int t = row - base;
        if ((FAST_MASK >> (h28 < 12 ? 0 : (h28 < 20 ? 1 : 2))) & 1) continue;
        const bf16 *Q, *Kp, *Vp; int ldq, ldk, qoff, koff, nslots, type, g = 0, hh = 0, d = 1;
        if (h28 < 12) { type = 0; g = h28 >> 2; hh = h28 & 3; d = (g == 0) ? 1 : (g == 1 ? 4 : 16); Q = (const bf16*)(ws + WS_QA); Kp = (const bf16*)(ws + WS_KA); Vp = (const bf16*)(ws + WS_VA); ldq = 1536; ldk = 1536; qoff = h28 * 128; koff = h28 * 128; nslots = 129; }
        else if (h28 < 20) { type = 1; hh = h28 - 12; Q = (const bf16*)(ws + WS_QB); Kp = (const bf16*)(ws + WS_KB); Vp = (const bf16*)(ws + WS_VB); ldq = 1024; ldk = 256; qoff = hh * 128; koff = (hh >> 2) * 128; nslots = 257; }
        else { type = 2; hh = h28 - 20; Q = (const bf16*)(ws + WS_QC); Kp = (const bf16*)(ws + WS_KC); Vp = (const bf16*)(ws + WS_VC); ldq = 1024; ldk = 1024; qoff = hh * 128; koff = hh * 128; nslots = 128; }
        const int rows = L >> 6, r = t >> 6, c = t & 63; int rs = r - 4; rs = rs < 0 ? 0 : (rs > rows - 8 ? rows - 8 : rs); int qs = c - 8; qs = qs < 0 ? 0 : (qs > 48 ? 48 : qs);
        const bf16* qp = Q + (size_t)row * ldq + qoff;
        float mx = -1e30f;
#pragma unroll 1
        for (int j = lane; j < nslots; j += 64) {
            bool valid = true; int tk = t; float bias = 0.f;
            if (type == 0) { const int rel = (j - 64) * d; tk = t + rel; valid = tk >= 0 && tk < L; const int n = rel < 0 ? -rel : rel; bias = relb[((int)tab[n] + (rel > 0 ? 16 : 0)) * 20 + h28]; }
            else if (type == 1) { const int rel = j - 128; tk = t + rel; valid = tk >= 0 && tk < L; const int n = rel < 0 ? -rel : rel; bias = relb[((int)tab[n] + (rel > 0 ? 16 : 0)) * 20 + 12 + hh]; }
            else { const int kr = rs + (j >> 4), kc = qs + (j & 15); tk = kr * 64 + kc; bias = rpb[(hh * 15 + (kr - r + 7)) * 31 + (kc - c + 15)]; }
            if (!valid) tk = t;
            float dot = 0.f; const bf16* kp = Kp + (size_t)(base + tk) * ldk + koff;
#pragma unroll 4
            for (int ch = 0; ch < 16; ++ch) { const u32x4 kv = *(const u32x4*)(kp + 8 * ch); const u32x4 qv = *(const u32x4*)(qp + 8 * ch);
#pragma unroll
                for (int e = 0; e < 4; ++e) dot += bf_lo(qv[e]) * bf_lo(kv[e]) + bf_hi(qv[e]) * bf_hi(kv[e]); }
            const float sc = valid ? dot * 0.08838834764831845f + bias : -1e30f;
            mx = fmaxf(mx, sc);
            pl[j] = sc; tl[j] = tk;
        }
        mx = wave_max(mx);
        if (type == 1) mx = fmaxf(mx, sink[hh]);
        float den = 0.f;
#pragma unroll 1
        for (int j = lane; j < nslots; j += 64) { const float sc = pl[j]; const float p = (sc > -1e29f) ? __expf(sc - mx) : 0.f; den += p; pl[j] = p; }
        den = wave_sum(den);
        if (type == 1) den += __expf(sink[hh] - mx);
        LDS_WAIT(); asm volatile("" ::: "memory");
        float o0 = 0.f, o1 = 0.f;
#pragma unroll 4
        for (int j = 0; j < nslots; ++j) { const float p = pl[j]; const int tk = tl[j];
            const unsigned w = *(const unsigned*)(Vp + (size_t)(base + tk) * ldk + koff + 2 * lane); o0 += p * bf_lo(w); o1 += p * bf_hi(w); }
        const float inv = 1.0f / den; o0 *= inv; o1 *= inv;
        if (type == 0) { *(unsigned*)((bf16*)(ws + WS_OAG) + ((size_t)g * M + row) * 512 + hh * 128 + 2 * lane) = pk2(o0, o1);
            if (lane == 0) ((float*)(ws + WS_LSE))[((size_t)g * M + row) * 4 + hh] = mx + __logf(den); }
        else { *(unsigned*)((bf16*)(ws + WS_O) + (size_t)row * KBR + (type == 1 ? 512 : 1536) + hh * 128 + 2 * lane) = pk2(o0, o1); }
        LDS_WAIT(); asm volatile("" ::: "memory");
    }
}
__device__ __forceinline__ void combine_phase(unsigned char* ws, int gw, int NGW, int lane) {
    const float* lse = (const float*)(ws + WS_LSE); const bf16* oag = (const bf16*)(ws + WS_OAG); bf16* O = (bf16*)(ws + WS_O);
    const int hh = lane >> 4;
    const bool panel = LOCAL_SEAMS && gridDim.x == 256u; const int c_ = (int)blockIdx.x;
    const int rbase = panel ? (8 * (c_ % 8) + (c_ / 8) % 8) * 256 + (c_ / 64) * 64 + (gw & (NWAVES - 1)) : gw, rstep = panel ? NWAVES : NGW, rend = panel ? rbase + 64 : M;
    for (int row = rbase; row < rend; row += rstep) {
        const float l0 = lse[((size_t)0 * M + row) * 4 + hh], l1 = lse[((size_t)1 * M + row) * 4 + hh], l2 = lse[((size_t)2 * M + row) * 4 + hh];
        const u32x4 a0 = *(const u32x4*)(oag + ((size_t)0 * M + row) * 512 + 8 * lane), a1 = *(const u32x4*)(oag + ((size_t)1 * M + row) * 512 + 8 * lane), a2 = *(const u32x4*)(oag + ((size_t)2 * M + row) * 512 + 8 * lane);
        const float mx = fmaxf(l0, fmaxf(l1, l2)); float w0 = __expf(l0 - mx), w1 = __expf(l1 - mx), w2 = __expf(l2 - mx); const float inv = 1.0f / (w0 + w1 + w2); w0 *= inv; w1 *= inv; w2 *= inv;
        u32x4 o;
#pragma unroll
        for (int e = 0; e < 4; ++e) o[e] = pk2(w0 * bf_lo(a0[e]) + w1 * bf_lo(a1[e]) + w2 * bf_lo(a2[e]), w0 * bf_hi(a0[e]) + w1 * bf_hi(a1[e]) + w2 * bf_hi(a2[e]));
        *(u32x4*)(O + (size_t)row * KBR + 8 * lane) = o;
    }
}

__device__ __forceinline__ int vcu_of() { const int G = gridDim.x, bx = blockIdx.x; return (G % 8 == 0) ? (bx % 8) * (G / 8) + bx / 8 : bx; }
typedef short v4i16_t __attribute__((ext_vector_type(4)));
typedef pg8::bf16x8 bf16x8;
constexpr int AT_TAB_OFF = RING_BYTES + 512;
constexpr int AT_BIAS_OFF = RING_BYTES + 2048;
static_assert(AT_BIAS_OFF + 1152 * 4 <= LDS_BYTES, "attention LDS map");
__device__ __forceinline__ unsigned off_b(unsigned row, unsigned ch) { return 256u * row + 16u * (ch ^ (((row & 3u) << 2) | ((row >> 2) & 3u))); }
__device__ __forceinline__ int clampi(int v, int lo, int hi) { return v < lo ? lo : (v > hi ? hi : v); }

struct TokLin { int base, pos0, d, r, lim; __device__ __forceinline__ bool operator()(int s, int& row) const { const int p = pos0 + s; row = base + p * d + r; return p >= 0 && p < lim; } };
struct TokGrid { int base, rlo, cs; __device__ __forceinline__ bool operator()(int s, int& row) const { row = base + (rlo + (s >> 5)) * 64 + cs + (s & 31); return true; } };

#define WG_SYNC() do { asm volatile("s_waitcnt lgkmcnt(0)" ::: "memory"); __builtin_amdgcn_s_barrier(); asm volatile("" ::: "memory"); } while (0)
constexpr int AT_GAIN_OFF = AT_BIAS_OFF + 1152 * 4;
static_assert(AT_GAIN_OFF + 768 * 4 <= LDS_BYTES, "attention LDS map");
template <int NPASS, class TokF>
__device__ __forceinline__ unsigned stage_load(const bf16* P, int ld, int npass, int tid, const TokF tokf, u32x4 (&v)[NPASS]) {
    const int ch = tid & 15, sl = tid >> 4; unsigned okm = 0u;
#pragma unroll
    for (int i = 0; i < NPASS; ++i) { v[i] = (u32x4){0u, 0u, 0u, 0u}; if (i < npass) { int row; const bool ok = tokf(sl + 32 * i, row); row = ok ? row : tokf.base; okm |= ok ? (1u << i) : 0u;
            v[i] = *(const u32x4*)(P + (size_t)row * ld + 8 * ch); } }
    return okm;
}
template <int NPASS, bool NORM>
__device__ __forceinline__ void stage_store(LAS unsigned char* lds, int npass, const LAS float* gain, int tid, const u32x4 (&v)[NPASS], unsigned okm) {
    const int ch = tid & 15, sl = tid >> 4;
    float gn[8];
    if (NORM) { const f32x4 a = *(const LAS f32x4*)(gain + 8 * ch), b = *(const LAS f32x4*)(gain + 8 * ch + 4); gn[0] = a[0]; gn[1] = a[1]; gn[2] = a[2]; gn[3] = a[3]; gn[4] = b[0]; gn[5] = b[1]; gn[6] = b[2]; gn[7] = b[3]; }
#pragma unroll
    for (int i = 0; i < NPASS; ++i) if (i < npass) {
        const bool ok = (okm >> i) & 1u;
        u32x4 w; w.x = ok ? v[i].x : 0u; w.y = ok ? v[i].y : 0u; w.z = ok ? v[i].z : 0u; w.w = ok ? v[i].w : 0u;
        if (NORM) {
            float f[8]; float ss = 0.f;
#pragma unroll
            for (int e = 0; e < 4; ++e) { f[2 * e] = bf_lo(w[e]); f[2 * e + 1] = bf_hi(w[e]); ss += f[2 * e] * f[2 * e] + f[2 * e + 1] * f[2 * e + 1]; }
            ss += __shfl_xor(ss, 1); ss += __shfl_xor(ss, 2); ss += __shfl_xor(ss, 4); ss += __shfl_xor(ss, 8);
            const float rs = rsqrtf(ss * (1.0f / 128.0f) + EPS);
#pragma unroll
            for (int e = 0; e < 4; ++e) w[e] = pg8::cvt_pk_bf16(f[2 * e] * rs * gn[2 * e], f[2 * e + 1] * rs * gn[2 * e + 1]);
        }
        *(LAS u32x4*)(lds + off_b((unsigned)(sl + 32 * i), (unsigned)ch)) = w;
    }
}
__device__ __forceinline__ void q_issue(const bf16* qrow, int g4, u32x4 (&raw)[4]) {
#pragma unroll
    for (int ks = 0; ks < 4; ++ks) raw[ks] = *(const u32x4*)(qrow + 32 * ks + 8 * g4);
}
template <bool NORM>
__device__ __forceinline__ void q_finish(u32x4 (&raw)[4], const LAS float* gq, int g4, bf16x8 (&qf)[4]) {
    if (NORM) {
        float ss = 0.f;
#pragma unroll
        for (int ks = 0; ks < 4; ++ks)
#pragma unroll
            for (int e = 0; e < 4; ++e) { const float a = bf_lo(raw[ks][e]), b = bf_hi(raw[ks][e]); ss += a * a + b * b; }
        ss = xrow16_sum(ss);
        const float rs = rsqrtf(ss * (1.0f / 128.0f) + EPS);
#pragma unroll
        for (int ks = 0; ks < 4; ++ks) { const f32x4 ga = *(const LAS f32x4*)(gq + 32 * ks + 8 * g4), gb = *(const LAS f32x4*)(gq + 32 * ks + 8 * g4 + 4);
            raw[ks][0] = pg8::cvt_pk_bf16(bf_lo(raw[ks][0]) * rs * ga[0], bf_hi(raw[ks][0]) * rs * ga[1]); raw[ks][1] = pg8::cvt_pk_bf16(bf_lo(raw[ks][1]) * rs * ga[2], bf_hi(raw[ks][1]) * rs * ga[3]);
            raw[ks][2] = pg8::cvt_pk_bf16(bf_lo(raw[ks][2]) * rs * gb[0], bf_hi(raw[ks][2]) * rs * gb[1]); raw[ks][3] = pg8::cvt_pk_bf16(bf_lo(raw[ks][3]) * rs * gb[2], bf_hi(raw[ks][3]) * rs * gb[3]); }
    }
#pragma unroll
    for (int ks = 0; ks < 4; ++ks) qf[ks] = __builtin_bit_cast(bf16x8, raw[ks]);
}
constexpr float QK_SCALE = 0.08838834764831845f;
constexpr float LOG2E = 1.4426950408889634f, LN2 = 0.6931471805599453f;
constexpr float QK_SCALE2 = QK_SCALE * LOG2E;
template <int NT, int NB>
__device__ __forceinline__ void st_tiles(LAS unsigned char* lds, int slot0, const bf16x8 (&qf)[4], int lane, f32x4 (&S)[NT]) {
    const unsigned i = lane & 15, g4 = lane >> 4;
    unsigned ko[4];
#pragma unroll
    for (int ks = 0; ks < 4; ++ks) ko[ks] = off_b(i, 4u * ks + g4);
    LAS unsigned char* base = lds + 256 * slot0;
    bf16x8 a[NB][4];
#pragma unroll
    for (int kk = 0; kk < NB - 1 && kk < NT; ++kk)
#pragma unroll
        for (int ks = 0; ks < 4; ++ks) a[kk % NB][ks] = *(const LAS bf16x8*)(base + 4096 * kk + ko[ks]);
#pragma unroll
    for (int kk = 0; kk < NT; ++kk) {
        if (kk + NB - 1 < NT) {
#pragma unroll
            for (int ks = 0; ks < 4; ++ks) a[(kk + NB - 1) % NB][ks] = *(const LAS bf16x8*)(base + 4096 * (kk + NB - 1) + ko[ks]);
        }
        __builtin_amdgcn_sched_barrier(0);
        f32x4 acc = (f32x4){0.f, 0.f, 0.f, 0.f};
#pragma unroll
        for (int ks = 0; ks < 4; ++ks) acc = __builtin_amdgcn_mfma_f32_16x16x32_bf16(a[kk % NB][ks], qf[ks], acc, 0, 0, 0);
        S[kk] = acc;
        __builtin_amdgcn_sched_barrier(0);
    }
}
template <int NT>
__device__ __forceinline__ void softmax_pack(f32x4 (&S)[NT], float extra, bf16x8 (&P)[(NT + 1) / 2], float& inv_l, float& lse) {
    float m = extra;
#pragma unroll
    for (int kk = 0; kk < NT; ++kk) m = fmaxf(m, fmaxf(fmaxf(S[kk][0], S[kk][1]), fmaxf(S[kk][2], S[kk][3])));
    m = xrow16_max(m);
    float l = 0.f;
#pragma unroll
    for (int kk = 0; kk < NT; ++kk)
#pragma unroll
        for (int r = 0; r < 4; ++r) { const float p = __builtin_amdgcn_exp2f(S[kk][r] - m); S[kk][r] = p; l += p; }
    l = xrow16_sum(l);
    l += __builtin_amdgcn_exp2f(extra - m);
    inv_l = 1.0f / l; lse = (m + __log2f(l)) * LN2;
#pragma unroll
    for (int s = 0; s < (NT + 1) / 2; ++s) {
        u32x4 w; w.x = pg8::cvt_pk_bf16(S[2 * s][0], S[2 * s][1]); w.y = pg8::cvt_pk_bf16(S[2 * s][2], S[2 * s][3]);
        if (2 * s + 1 < NT) { w.z = pg8::cvt_pk_bf16(S[2 * s + 1][0], S[2 * s + 1][1]); w.w = pg8::cvt_pk_bf16(S[2 * s + 1][2], S[2 * s + 1][3]); } else { w.z = 0u; w.w = 0u; }
        P[s] = __builtin_bit_cast(bf16x8, w);
    }
}
template <int NT, int NB>
__device__ __forceinline__ void pv_tile(LAS unsigned char* lds, int slot0, const bf16x8 (&P)[(NT + 1) / 2], int lane, f32x4 (&O)[8]) {
    constexpr int NK = (NT + 1) / 2;
    const unsigned g4 = lane >> 4, qq = (lane & 15) >> 2, p = lane & 3, rl = 4 * g4 + qq;
    unsigned vo[8];
#pragma unroll
    for (int c = 0; c < 8; ++c) vo[c] = off_b(rl, 2u * c + (p >> 1)) + 8u * (p & 1);
    LAS unsigned char* base = lds + 256 * slot0;
#pragma unroll
    for (int c = 0; c < 8; ++c) O[c] = (f32x4){0.f, 0.f, 0.f, 0.f};
    v4i16_t lo[NB][8], hi[NB][8];
    if (NB == 2) {
#pragma unroll
        for (int c = 0; c < 8; ++c) { lo[0][c] = __builtin_amdgcn_ds_read_tr16_b64_v4i16((LAS v4i16_t*)(base + vo[c])); hi[0][c] = __builtin_amdgcn_ds_read_tr16_b64_v4i16((LAS v4i16_t*)(base + 4096 * ((1 < NT) ? 1 : 0) + vo[c])); }
    }
#pragma unroll
    for (int s = 0; s < NK; ++s) {
        const int sl = (NB == 2) ? s + 1 : s, bi = (NB == 2) ? ((s + 1) & 1) : 0;
        if (sl < NK) {
            const int t0 = 2 * sl, t1 = (2 * sl + 1 < NT) ? 2 * sl + 1 : NT - 1;
#pragma unroll
            for (int c = 0; c < 8; ++c) { lo[bi][c] = __builtin_amdgcn_ds_read_tr16_b64_v4i16((LAS v4i16_t*)(base + 4096 * t0 + vo[c])); hi[bi][c] = __builtin_amdgcn_ds_read_tr16_b64_v4i16((LAS v4i16_t*)(base + 4096 * t1 + vo[c])); }
        }
        __builtin_amdgcn_sched_barrier(0);
#pragma unroll
        for (int c = 0; c < 8; ++c) {
            const bf16x8 a = __builtin_shufflevector(lo[(NB == 2) ? (s & 1) : 0][c], hi[(NB == 2) ? (s & 1) : 0][c], 0, 1, 2, 3, 4, 5, 6, 7);
            O[c] = __builtin_amdgcn_mfma_f32_16x16x32_bf16(a, P[s], O[c], 0, 0, 0);
        }
        __builtin_amdgcn_sched_barrier(0);
    }
}
__device__ __forceinline__ void store_o(bf16* orow, const f32x4 (&O)[8], float inv_l, int g4) {
#pragma unroll
    for (int c = 0; c < 8; ++c) { u32x2 w; w.x = pg8::cvt_pk_bf16(O[c][0] * inv_l, O[c][1] * inv_l); w.y = pg8::cvt_pk_bf16(O[c][2] * inv_l, O[c][3] * inv_l); *(u32x2*)(orow + 16 * c + 4 * g4) = w; }
}


constexpr int NU_A = 1536, NU_B = 512, NU_C = 1024;

struct DescA { int head12, g, hh, d, base, Ls, r, qb, pos0; };
__device__ __forceinline__ DescA decode_A(int u) {
    DescA D_; const int part = u >= 768, uu = part ? u - 768 : u; D_.head12 = uu >> 6; int rem = uu & 63;
    D_.g = D_.head12 >> 2; D_.hh = D_.head12 & 3; D_.d = (D_.g == 0) ? 1 : (D_.g == 1 ? 4 : 16);
    int L = 8192, nbq = 64 / D_.d; D_.base = 0;
    if (part) { const int seq = rem >> 5; rem &= 31; D_.base = 8192 + 4096 * seq; L = 4096; nbq = 32 / D_.d; }
    D_.r = rem / nbq; D_.qb = rem % nbq; D_.Ls = L / D_.d; D_.pos0 = 128 * D_.qb - 64; return D_;
}
__device__ __forceinline__ void run_A(unsigned char* ws, const float* relb, LAS unsigned char* lds, int u0, int u1, int wave_s) {
    if (u0 >= u1) return;
    LAS float* bv = (LAS float*)(lds + AT_BIAS_OFF); LAS unsigned char* tab = lds + AT_TAB_OFF; const LAS float* gains = (const LAS float*)(lds + AT_GAIN_OFF);
    LAS unsigned char* ldsv = lds + 65536;
    DescA d = decode_A(u0);
    u32x4 kreg[8], vreg[8], qraw[4]; unsigned kok, vok; int bias_head = -1;
    { const int tid = tid_of(wave_s), lane = tid & 63, wave = __builtin_amdgcn_readfirstlane(tid >> 6); const TokLin tk{d.base, d.pos0, d.d, d.r, d.Ls};
      const int qrow = d.base + (128 * d.qb + 16 * wave + (lane & 15)) * d.d + d.r;
      q_issue((const bf16*)(ws + WS_QA) + (size_t)qrow * 1536 + d.head12 * 128, lane >> 4, qraw);
      kok = stage_load<8>((const bf16*)(ws + WS_KA) + d.head12 * 128, 1536, 8, tid, tk, kreg);
      vok = stage_load<8>((const bf16*)(ws + WS_VA) + d.head12 * 128, 1536, 8, tid, tk, vreg); }
    for (int u = u0; u < u1; ++u) {
        const int tid = tid_of(wave_s), lane = tid & 63, wave = __builtin_amdgcn_readfirstlane(tid >> 6), q = lane & 15, g4 = lane >> 4;
        const float NEGINF = sconst(0xf149f2cau);
        if (d.head12 != bias_head) {
            if (tid < 160) { const int dl = tid - 80; float b = NEGINF; if (dl >= -64 && dl <= 64) { const int rel = dl * d.d, n = rel < 0 ? -rel : rel; b = relb[((int)tab[n] + (rel > 0 ? 16 : 0)) * 20 + d.head12] * LOG2E; } bv[tid] = b; }
            bias_head = d.head12; }
        stage_store<8, NORM_ON_LOAD != 0>(lds, 8, gains + 128, tid, kreg, kok);
        stage_store<8, false>(ldsv, 8, nullptr, tid, vreg, vok);
        const int qrow = d.base + (128 * d.qb + 16 * wave + q) * d.d + d.r;
        bf16x8 qf[4]; q_finish<NORM_ON_LOAD != 0>(qraw, gains, g4, qf);
        DescA dn = d;
        if (u + 1 < u1) { dn = decode_A(u + 1); const TokLin tkn{dn.base, dn.pos0, dn.d, dn.r, dn.Ls};
            const int qrn = dn.base + (128 * dn.qb + 16 * wave + q) * dn.d + dn.r;
            q_issue((const bf16*)(ws + WS_QA) + (size_t)qrn * 1536 + dn.head12 * 128, g4, qraw);
            kok = stage_load<8>((const bf16*)(ws + WS_KA) + dn.head12 * 128, 1536, 8, tid, tkn, kreg);
            vok = stage_load<8>((const bf16*)(ws + WS_VA) + dn.head12 * 128, 1536, 8, tid, tkn, vreg); }
        WG_SYNC();
        f32x4 S[9]; st_tiles<9, 3>(lds, 16 * wave, qf, lane, S);
        const LAS float* bvq = bv + (4 * g4 - q + 16);
        if (d.pos0 >= 0 && d.pos0 + 256 <= d.Ls) {
#pragma unroll
            for (int kk = 0; kk < 9; ++kk)
#pragma unroll
                for (int rr = 0; rr < 4; ++rr) S[kk][rr] = S[kk][rr] * QK_SCALE2 + bvq[16 * kk + rr];
        } else {
#pragma unroll
            for (int kk = 0; kk < 9; ++kk)
#pragma unroll
                for (int rr = 0; rr < 4; ++rr) {
                    const int p = d.pos0 + 16 * (wave + kk) + 4 * g4 + rr;
                    const bool ok = p >= 0 && p < d.Ls;
                    { const float sb = S[kk][rr] * QK_SCALE2 + bvq[16 * kk + rr]; S[kk][rr] = ok ? sb : NEGINF; }
                }
        }
        bf16x8 P[5]; float inv_l, lse; softmax_pack<9>(S, NEGINF, P, inv_l, lse);
        f32x4 O[8]; pv_tile<9, 2>(ldsv, 16 * wave, P, lane, O);
        store_o((bf16*)(ws + WS_OAG) + ((size_t)d.g * M + qrow) * 512 + d.hh * 128, O, inv_l, g4);
        if (g4 == 0) ((float*)(ws + WS_LSE))[((size_t)d.g * M + qrow) * 4 + d.hh] = lse;
        WG_SYNC();
        d = dn;
    }
}
struct DescB { int kvh, base, L, qb, pos0; };
__device__ __forceinline__ DescB decode_B(int u) {
    DescB D_; const int part = u >= 256, uu = part ? u - 256 : u; D_.kvh = uu >> 7; const int rem = uu & 127;
    D_.base = 0; D_.L = 8192; D_.qb = rem;
    if (part) { const int seq = rem >> 6; D_.qb = rem & 63; D_.base = 8192 + 4096 * seq; D_.L = 4096; }
    D_.pos0 = 64 * D_.qb - 128; return D_;
}
__device__ __forceinline__ void run_B(unsigned char* ws, const float* relb, const float* sinkl, LAS unsigned char* lds, int u0, int u1, int wave_s) {
    if (u0 >= u1) return;
    LAS float* bv = (LAS float*)(lds + AT_BIAS_OFF); LAS unsigned char* tab = lds + AT_TAB_OFF; const LAS float* gains = (const LAS float*)(lds + AT_GAIN_OFF);
    DescB d = decode_B(u0);
    u32x4 kreg[10], qraw0[4]; unsigned kok; int bias_kvh = -1;
    { const int tid = tid_of(wave_s), lane = tid & 63, wave = __builtin_amdgcn_readfirstlane(tid >> 6); const TokLin tk{d.base, d.pos0, 1, 0, d.L};
      const int qrow0 = d.base + 64 * d.qb + 32 * (wave >> 2) + (lane & 15);
      q_issue((const bf16*)(ws + WS_QB) + (size_t)qrow0 * 1024 + (4 * d.kvh + (wave & 3)) * 128, lane >> 4, qraw0);
      kok = stage_load<10>((const bf16*)(ws + WS_KB) + d.kvh * 128, 256, 10, tid, tk, kreg); }
    for (int u = u0; u < u1; ++u) {
        const int tid = tid_of(wave_s), lane = tid & 63, wave = __builtin_amdgcn_readfirstlane(tid >> 6), q = lane & 15, g4 = lane >> 4;
        const int hl = wave & 3, hq = 4 * d.kvh + hl;
        const TokLin tokf{d.base, d.pos0, 1, 0, d.L}; const float NEGINF = sconst(0xf149f2cau);
        if (d.kvh != bias_kvh) {
            for (int e = tid; e < 1152; e += NWAVES * 64) { const int h = e / 288, dl = e % 288 - 144; float b = NEGINF; if (dl >= -128 && dl <= 128) { const int n = dl < 0 ? -dl : dl; b = relb[((int)tab[n] + (dl > 0 ? 16 : 0)) * 20 + 12 + 4 * d.kvh + h] * LOG2E; } bv[e] = b; }
            bias_kvh = d.kvh; }
        stage_store<10, NORM_ON_LOAD != 0>(lds, 10, gains + 3 * 128, tid, kreg, kok);
        const int tq0 = 2 * (wave >> 2), qrow0 = d.base + 64 * d.qb + 16 * tq0 + q;
        const bf16* qbase = (const bf16*)(ws + WS_QB) + hq * 128;
        u32x4 qraw1[4]; q_issue(qbase + (size_t)(qrow0 + 16) * 1024, g4, qraw1);
        const float snk = sinkl[hq] * LOG2E;
        WG_SYNC();
        bf16x8 P[2][9]; float inv_l[2];
#pragma unroll
        for (int tt = 0; tt < 2; ++tt) {
            const int tq = tq0 + tt;
            bf16x8 qf[4];
            if (tt == 0) q_finish<NORM_ON_LOAD != 0>(qraw0, gains + 2 * 128, g4, qf); else q_finish<NORM_ON_LOAD != 0>(qraw1, gains + 2 * 128, g4, qf);
            f32x4 S[17]; st_tiles<17, 3>(lds, 16 * tq, qf, lane, S);
            const LAS float* bvq = bv + hl * 288 + (4 * g4 - q + 16);
            if (d.pos0 >= 0 && d.pos0 + 320 <= d.L) {
#pragma unroll
                for (int kk = 0; kk < 17; ++kk)
#pragma unroll
                    for (int rr = 0; rr < 4; ++rr) S[kk][rr] = S[kk][rr] * QK_SCALE2 + bvq[16 * kk + rr];
            } else {
#pragma unroll
                for (int kk = 0; kk < 17; ++kk)
#pragma unroll
                    for (int rr = 0; rr < 4; ++rr) {
                        const int p = d.pos0 + 16 * (tq + kk) + 4 * g4 + rr;
                        const bool ok = p >= 0 && p < d.L;
                        { const float sb = S[kk][rr] * QK_SCALE2 + bvq[16 * kk + rr]; S[kk][rr] = ok ? sb : NEGINF; }
                    }
            }
            float lse; softmax_pack<17>(S, snk, P[tt], inv_l[tt], lse);
            if (tt == 0) asm volatile("" ::: "memory");
        }
        WG_SYNC();
        { u32x4 vreg[10]; const unsigned vok = stage_load<10>((const bf16*)(ws + WS_VB) + d.kvh * 128, 256, 10, tid, tokf, vreg); stage_store<10, false>(lds, 10, nullptr, tid, vreg, vok); }
        DescB dn = d;
        if (u + 1 < u1) { dn = decode_B(u + 1); const TokLin tkn{dn.base, dn.pos0, 1, 0, dn.L};
            q_issue((const bf16*)(ws + WS_QB) + (size_t)(dn.base + 64 * dn.qb + 16 * tq0 + q) * 1024 + (4 * dn.kvh + hl) * 128, g4, qraw0);
            kok = stage_load<10>((const bf16*)(ws + WS_KB) + dn.kvh * 128, 256, 10, tid, tkn, kreg); }
        WG_SYNC();
#pragma unroll
        for (int tt = 0; tt < 2; ++tt) {
            const int tq = tq0 + tt, qrow = qrow0 + 16 * tt;
            f32x4 O[8]; pv_tile<17, 1>(lds, 16 * tq, P[tt], lane, O);
            store_o((bf16*)(ws + WS_O) + (size_t)qrow * KBR + 512 + hq * 128, O, inv_l[tt], g4);
        }
        WG_SYNC();
        d = dn;
    }
}
struct DescC { int h, base, rows, cb, r0, rlo, nrows, cs; };
__device__ __forceinline__ DescC decode_C(int u) {
    DescC D_; const int part = u >= 512, uu = part ? u - 512 : u; D_.h = uu >> 6; int rem = uu & 63;
    D_.base = 0; D_.rows = 128; D_.cb = rem >> 4; int rb = rem & 15;
    if (part) { const int seq = rem >> 5; rem &= 31; D_.base = 8192 + 4096 * seq; D_.rows = 64; D_.cb = rem >> 3; rb = rem & 7; }
    D_.r0 = 8 * rb; D_.rlo = clampi(D_.r0 - 4, 0, D_.rows - 8); const int rhi = clampi(D_.r0 + 3, 0, D_.rows - 8) + 7; D_.nrows = rhi - D_.rlo + 1; D_.cs = clampi(16 * D_.cb - 8, 0, 32); return D_;
}
__device__ __forceinline__ void run_C(unsigned char* ws, const float* rpbl, LAS unsigned char* lds, int u0, int u1, int wave_s) {
    if (u0 >= u1) return;
    LAS float* bv = (LAS float*)(lds + AT_BIAS_OFF); const LAS float* gains = (const LAS float*)(lds + AT_GAIN_OFF);
    DescC d = decode_C(u0);
    u32x4 kreg[15], qraw[4]; unsigned kok; int bias_h = -1;
    { const int tid = tid_of(wave_s), lane = tid & 63, wave = __builtin_amdgcn_readfirstlane(tid >> 6); const TokGrid tk{d.base, d.rlo, d.cs};
      const int qrow = d.base + (d.r0 + wave) * 64 + 16 * d.cb + (lane & 15);
      q_issue((const bf16*)(ws + WS_QC) + (size_t)qrow * 1024 + d.h * 128, lane >> 4, qraw);
      kok = stage_load<15>((const bf16*)(ws + WS_KC) + d.h * 128, 1024, d.nrows, tid, tk, kreg); }
    for (int u = u0; u < u1; ++u) {
        const int tid = tid_of(wave_s), lane = tid & 63, wave = __builtin_amdgcn_readfirstlane(tid >> 6), q = lane & 15, g4 = lane >> 4;
        const TokGrid tokf{d.base, d.rlo, d.cs}; const float NEGINF = sconst(0xf149f2cau);
        if (d.h != bias_h) { if (tid < 465) bv[tid] = rpbl[d.h * 465 + tid] * LOG2E; bias_h = d.h; }
        stage_store<15, NORM_ON_LOAD != 0>(lds, d.nrows, gains + 5 * 128, tid, kreg, kok);
        const int r = d.r0 + wave, rsw = clampi(r - 4, 0, d.rows - 8), c = 16 * d.cb + q, qs = clampi(c - 8, 0, 48), qrow = d.base + r * 64 + c;
        WG_SYNC();
        bf16x8 qf[4]; q_finish<NORM_ON_LOAD != 0>(qraw, gains + 4 * 128, g4, qf);
        f32x4 S[16]; st_tiles<16, 3>(lds, 32 * (rsw - d.rlo), qf, lane, S);
#pragma unroll
        for (int kk = 0; kk < 16; ++kk)
#pragma unroll
            for (int rr = 0; rr < 4; ++rr) {
                const int kc = d.cs + 16 * (kk & 1) + 4 * g4 + rr, dr = rsw + (kk >> 1) - r, dc = kc - c;
                const bool ok = kc >= qs && kc < qs + 16;
                { const float sb = S[kk][rr] * QK_SCALE2 + bv[(dr + 7) * 31 + clampi(dc + 15, 0, 30)]; S[kk][rr] = ok ? sb : NEGINF; }
            }
        bf16x8 P[8]; float inv_l, lse; softmax_pack<16>(S, NEGINF, P, inv_l, lse);
        WG_SYNC();
        { u32x4 vreg[15]; const unsigned vok = stage_load<15>((const bf16*)(ws + WS_VC) + d.h * 128, 1024, d.nrows, tid, tokf, vreg); stage_store<15, false>(lds, d.nrows, nullptr, tid, vreg, vok); }
        DescC dn = d;
        if (u + 1 < u1) { dn = decode_C(u + 1); const TokGrid tkn{dn.base, dn.rlo, dn.cs};
            q_issue((const bf16*)(ws + WS_QC) + (size_t)(dn.base + (dn.r0 + wave) * 64 + 16 * dn.cb + q) * 1024 + dn.h * 128, g4, qraw);
            kok = stage_load<15>((const bf16*)(ws + WS_KC) + dn.h * 128, 1024, dn.nrows, tid, tkn, kreg); }
        WG_SYNC();
        f32x4 O[8]; pv_tile<16, 2>(lds, 32 * (rsw - d.rlo), P, lane, O);
        store_o((bf16*)(ws + WS_O) + (size_t)qrow * KBR + 1536 + d.h * 128, O, inv_l, g4);
        WG_SYNC();
        d = dn;
    }
}
__device__ __forceinline__ void attn_fast_phase(unsigned char* ws, const float* relb, const float* qk_norm, const float* sink_all, const float* rpb_all, int l, LAS unsigned char* lds, int wave_s) {
    { const int tid = tid_of(wave_s); LAS unsigned char* tab = lds + AT_TAB_OFF; LAS float* gains = (LAS float*)(lds + AT_GAIN_OFF);
      for (int n = tid; n <= 1024; n += NWAVES * 64) tab[n] = (unsigned char)t5_bucket_dev(-n);
      for (int n = tid; n < 768; n += NWAVES * 64) gains[n] = qk_norm[(size_t)l * 768 + n]; }
    __syncthreads();
    const float* sinkl = sink_all + l * 8; const float* rpbl = rpb_all + (size_t)l * 8 * 465;
    const int G = gridDim.x, vcu = vcu_of();
    if (FAST_MASK & 4) { const int per = (NU_C + G - 1) / G, u0 = vcu * per, u1 = (u0 + per < NU_C) ? u0 + per : NU_C; run_C(ws, rpbl, lds, u0, u1, wave_s); if ((PROBE_DUP >> 13) & 1) run_C(ws, rpbl, lds, u0, u1, wave_s); }
    if (FAST_MASK & 2) { const int per = (NU_B + G - 1) / G, u0 = vcu * per, u1 = (u0 + per < NU_B) ? u0 + per : NU_B; run_B(ws, relb, sinkl, lds, u0, u1, wave_s); if ((PROBE_DUP >> 12) & 1) run_B(ws, relb, sinkl, lds, u0, u1, wave_s); }
    if (FAST_MASK & 1) { const int per = (NU_A + G - 1) / G, u0 = vcu * per, u1 = (u0 + per < NU_A) ? u0 + per : NU_A; run_A(ws, relb, lds, u0, u1, wave_s); if ((PROBE_DUP >> 11) & 1) run_A(ws, relb, lds, u0, u1, wave_s); }
}

constexpr int NP = 10;
enum { PH_UP1 = 0, PH_DN1, PH_IN, PH_QKN, PH_ATT, PH_CMB, PH_BR, PH_OUT, PH_UP2, PH_DN2 };
constexpr int NPH = 1 + DEPTH * NP;

__device__ __forceinline__ KArgs kargs() { u64 p = (u64)__builtin_amdgcn_kernarg_segment_ptr(); asm volatile("" : "+s"(p)); return (KArgs)p; }

#define OTID() tid_of(wave_s)
#define IN(k) (lo <= (k) && (k) < hi)
#define SEAM(k) do { if (ONE_LAUNCH && IN(k) && IN((k) + 1)) { XcdBarrier b_; b_.bar = (unsigned*)(kargs()->ws + WS_CTL) + CW_BAR; b_.x = xb_xcc_id(); b_.st = (volatile LAS unsigned*)(lds + MISC_OFF) + 8; xcd_barrier(b_, OTID()); if ((PROBE_DUP >> 7) & 1) xcd_barrier(b_, OTID()); } } while (0)
#define LSEAM(k) do { if (ONE_LAUNCH && IN(k) && IN((k) + 1)) { const unsigned bad_ = (unsigned)__builtin_amdgcn_readfirstlane((int)((volatile LAS unsigned*)(lds + MISC_OFF))[12]); \
    if (LOCAL_SEAMS && bad_ == 0u) grp_barrier((unsigned*)(kargs()->ws + WS_CTL) + CW_BAR, OTID()); \
    else { XcdBarrier b_; b_.bar = (unsigned*)(kargs()->ws + WS_CTL) + CW_BAR; b_.x = xb_xcc_id(); b_.st = (volatile LAS unsigned*)(lds + MISC_OFF) + 8; xcd_barrier(b_, OTID()); } } } while (0)
#define TIDS() const int tid = OTID(), lane = tid & 63, wave = __builtin_amdgcn_readfirstlane(tid >> 6); const int gw = vcu_of() * NWAVES + wave, NGW = (int)gridDim.x * NWAVES; (void)lane; (void)gw; (void)NGW
template <int L_>
__device__ __forceinline__ void layer_body(const int lo, const int hi, LAS unsigned char* lds, const int wave_s) {
    constexpr int l = L_;

        const int g0 = 1 + l * NP;
        for (int rep = 0; rep <= ((PROBE_DUP >> 1) & 1); ++rep)
        if (IN(g0 + PH_UP1)) {
            KArgs ka = kargs(); unsigned char* ws = ka->ws; unsigned char* wl = ws + WS_W + (size_t)l * W_LAYER;
            pg8::Gemm g{(const bf16*)(ws + WS_XB), (const bf16*)(wl + W_1A), M, 2 * FF, D}; pg8::StaticOrder S; S.init(M, 2 * FF, (int)gridDim.x, (int)blockIdx.x);
            rstd_cache_reset(lds, OTID()); EpiUp E{(bf16*)(ws + WS_ACT), (const u64*)(ws + WS_RSQ) + (size_t)(3 * l + 0) * M, lds};
            if ((PROBE_DUP >> 8) & 1) { S.r1 = 5; pg8::gemm_phase<EpiUp, pg8::StaticOrder, GEMM_ALIGN, GEMM_SP2>(lds, g, S, E, wave_s);
                { XcdBarrier b_; b_.bar = (unsigned*)(kargs()->ws + WS_CTL) + CW_BAR; b_.x = xb_xcc_id(); b_.st = (volatile LAS unsigned*)(lds + MISC_OFF) + 8; xcd_barrier(b_, OTID()); } S.r0 = 5; S.r1 = 1 << 30; }
            pg8::gemm_phase<EpiUp, pg8::StaticOrder, GEMM_ALIGN, GEMM_SP2>(lds, g, S, E, wave_s);
        }
        if ((PROBE_DUP >> 6) & 1) if (IN(g0 + PH_UP1)) {
            KArgs ka = kargs(); unsigned char* ws = ka->ws; unsigned char* wl = ws + WS_W + (size_t)l * W_LAYER;
            pg8::Gemm g{(const bf16*)(ws + WS_XB), (const bf16*)(wl + W_1A), M, 2 * FF, D}; pg8::StaticOrder S; S.init(M, 2 * FF, (int)gridDim.x, (int)blockIdx.x);
            EpiNull E{};
            pg8::gemm_phase<EpiNull, pg8::StaticOrder, GEMM_ALIGN, GEMM_SP2>(lds, g, S, E, wave_s);
        }
        LSEAM(g0 + PH_UP1);
        if (IN(g0 + PH_DN1)) {
            KArgs ka = kargs(); unsigned char* ws = ka->ws; unsigned char* wl = ws + WS_W + (size_t)l * W_LAYER;
            pg8::Gemm g{(const bf16*)(ws + WS_ACT), (const bf16*)(wl + W_1B), M, D, FF}; pg8::StaticOrder S; S.init(M, D, (int)gridDim.x, (int)blockIdx.x);
            EpiRes<1, false, FP8_GATES != 0> E{(bf16*)(ws + WS_XB), ws + WS_XL, nullptr, (u64*)(ws + WS_RSQ) + (size_t)(3 * l + 1) * M, ws + WS_XB8};
            pg8::gemm_phase<EpiRes<1, false, FP8_GATES != 0>, pg8::StaticOrder, GEMM_ALIGN, GEMM_SP2>(lds, g, S, E, wave_s);
        }
        if ((PROBE_DUP >> 9) & 1) if (IN(g0 + PH_DN1)) {
            KArgs ka = kargs(); unsigned char* ws = ka->ws; unsigned char* wl = ws + WS_W + (size_t)l * W_LAYER;
            pg8::Gemm g{(const bf16*)(ws + WS_ACT), (const bf16*)(wl + W_1B), M, D, FF}; pg8::StaticOrder S; S.init(M, D, (int)gridDim.x, (int)blockIdx.x);
            if ((PROBE_DUP >> 10) & 1) { g.ablk = true; g.bblk = true; }
            EpiNull E{};
            pg8::gemm_phase<EpiNull, pg8::StaticOrder, GEMM_ALIGN, GEMM_SP2>(lds, g, S, E, wave_s);
        }
        LSEAM(g0 + PH_DN1);
        for (int rep = 0; rep <= ((PROBE_DUP >> 2) & 1); ++rep)
        if (FP8_GATES && FP8_QK) {
            if (IN(g0 + PH_IN)) {
                KArgs ka = kargs(); unsigned char* ws = ka->ws; unsigned char* wl = ws + WS_W + (size_t)l * W_LAYER;
                pg8::Gemm g{(const bf16*)(ws + WS_XB8), (const bf16*)(wl + W_IN8), M, 12544, D / 2}; pg8::StaticOrder S; S.init(M, 12544, (int)gridDim.x, (int)blockIdx.x);
                EpiIn8 E{ws, (const u64*)(ws + WS_RSQ) + (size_t)(3 * l + 1) * M, ka->in[8] + (size_t)l * 768, lds};
                pg8::gemm_phase<EpiIn8, pg8::StaticOrder, GEMM_ALIGN, GEMM_SP2, true>(lds, g, S, E, wave_s);
            }
            if (IN(g0 + PH_IN)) {
                KArgs ka = kargs(); unsigned char* ws = ka->ws; unsigned char* wl = ws + WS_W + (size_t)l * W_LAYER;
                pg8::Gemm g{(const bf16*)(ws + WS_XB), (const bf16*)(wl + W_IN), M, 2816, D}; pg8::StaticOrder S; S.init(M, 2816, (int)gridDim.x, (int)gridDim.x - 1 - (int)blockIdx.x);
                EpiV E{ws, (const u64*)(ws + WS_RSQ) + (size_t)(3 * l + 1) * M};
                pg8::gemm_phase<EpiV, pg8::StaticOrder, GEMM_ALIGN, GEMM_SP2>(lds, g, S, E, wave_s);
            }
        } else {
        if (FP8_GATES && FP8_QA) {
            if (IN(g0 + PH_IN)) {
                KArgs ka = kargs(); unsigned char* ws = ka->ws; unsigned char* wl = ws + WS_W + (size_t)l * W_LAYER;
                constexpr int N8 = FP8_QA == 2 ? 11264 : 9216;
                pg8::Gemm g{(const bf16*)(ws + WS_XB8), (const bf16*)(wl + W_IN8), M, N8, D / 2}; pg8::StaticOrder S; S.init(M, N8, (int)gridDim.x, (int)blockIdx.x);
                rstd_cache_reset(lds, OTID()); EpiInT<2> E{ws, (const u64*)(ws + WS_RSQ) + (size_t)(3 * l + 1) * M, ka->in[8] + (size_t)l * 768, lds};
                pg8::gemm_phase<EpiInT<2>, pg8::StaticOrder, GEMM_ALIGN, GEMM_SP2, true>(lds, g, S, E, wave_s);
            }
            if (IN(g0 + PH_IN)) {
                KArgs ka = kargs(); unsigned char* ws = ka->ws; unsigned char* wl = ws + WS_W + (size_t)l * W_LAYER;
                constexpr int N16 = FP8_QA == 2 ? 4096 : 6144;
                pg8::Gemm g{(const bf16*)(ws + WS_XB), (const bf16*)(wl + W_IN) + (size_t)3072 * D, M, N16, D}; pg8::StaticOrder S; S.init(M, N16, (int)gridDim.x, (int)blockIdx.x);
                rstd_cache_reset(lds, OTID()); EpiInT<1> E{ws, (const u64*)(ws + WS_RSQ) + (size_t)(3 * l + 1) * M, ka->in[8] + (size_t)l * 768, lds};
                pg8::gemm_phase<EpiInT<1>, pg8::StaticOrder, GEMM_ALIGN, GEMM_SP2>(lds, g, S, E, wave_s);
            }
        } else {
        if (FP8_GATES && IN(g0 + PH_IN)) {
            KArgs ka = kargs(); unsigned char* ws = ka->ws; unsigned char* wl = ws + WS_W + (size_t)l * W_LAYER;
            pg8::Gemm g{(const bf16*)(ws + WS_XB8), (const bf16*)(wl + W_IN8), M, 6144, D / 2}; pg8::StaticOrder S; S.init(M, 6144, (int)gridDim.x, (int)blockIdx.x);
            rstd_cache_reset(lds, OTID()); EpiGate E{ws + WS_G, (const u64*)(ws + WS_RSQ) + (size_t)(3 * l + 1) * M, lds};
            pg8::gemm_phase<EpiGate, pg8::StaticOrder, GEMM_ALIGN, GEMM_SP2, true>(lds, g, S, E, wave_s);
        }
        if (IN(g0 + PH_IN)) {
            KArgs ka = kargs(); unsigned char* ws = ka->ws; unsigned char* wl = ws + WS_W + (size_t)l * W_LAYER;
            constexpr int NQKV = FP8_GATES ? 9216 : NIN;
            pg8::Gemm g{(const bf16*)(ws + WS_XB), (const bf16*)(wl + W_IN), M, NQKV, D}; pg8::StaticOrder S; S.init(M, NQKV, (int)gridDim.x, (int)blockIdx.x);
            rstd_cache_reset(lds, OTID()); EpiIn E{ws, (const u64*)(ws + WS_RSQ) + (size_t)(3 * l + 1) * M, ka->in[8] + (size_t)l * 768, lds};
            pg8::gemm_phase<EpiIn, pg8::StaticOrder, GEMM_ALIGN, GEMM_SP2>(lds, g, S, E, wave_s);
        }
        }
        }
        SEAM(g0 + PH_IN);
        if (!NORM_ON_LOAD && !QKN_IN_EPI && IN(g0 + PH_QKN)) { KArgs ka = kargs(); TIDS(); qknorm_phase(ka->ws, ka->in[8], l, gw, NGW, lane); }
        if (!NORM_ON_LOAD && !QKN_IN_EPI) SEAM(g0 + PH_QKN);
        for (int rep = 0; rep <= ((PROBE_DUP >> 3) & 1); ++rep)
        if (IN(g0 + PH_ATT)) {
            if (FAST_MASK != 0) { KArgs ka = kargs(); attn_fast_phase(ka->ws, ka->in[2], ka->in[8], ka->in[9], ka->in[10], l, lds, wave_s); __syncthreads(); }
            if (FAST_MASK != 7) { KArgs ka = kargs(); TIDS(); attn_naive_phase(ka->ws, ka->in[2], ka->in[9], ka->in[10], l, lds, gw, NGW, wave, lane); __syncthreads(); }
        }
        SEAM(g0 + PH_ATT);
        for (int rep = 0; rep <= ((PROBE_DUP >> 4) & 1); ++rep)
        if (IN(g0 + PH_CMB)) { KArgs ka = kargs(); TIDS(); combine_phase(ka->ws, gw, NGW, lane); }
        LSEAM(g0 + PH_CMB);
        for (int rep = 0; rep <= ((PROBE_DUP >> 5) & 1); ++rep)
        if (IN(g0 + PH_BR)) {
            KArgs ka = kargs(); unsigned char* ws = ka->ws; unsigned char* wl = ws + WS_W + (size_t)l * W_LAYER;
            pg8::Gemm g{(const bf16*)(ws + WS_O), (const bf16*)(wl + W_BR), M, D, KBR}; pg8::StaticOrder S; S.init(M, D, (int)gridDim.x, (int)blockIdx.x);
            EpiBr E{(const unsigned char*)(ws + WS_G), (bf16*)(ws + WS_Z)};
            pg8::gemm_phase<EpiBr, pg8::StaticOrder, GEMM_ALIGN, GEMM_SP2>(lds, g, S, E, wave_s);
        }
        LSEAM(g0 + PH_BR);
        if (IN(g0 + PH_OUT)) {
            KArgs ka = kargs(); unsigned char* ws = ka->ws; unsigned char* wl = ws + WS_W + (size_t)l * W_LAYER;
            pg8::Gemm g{(const bf16*)(ws + WS_Z), (const bf16*)(wl + W_O), M, D, D}; pg8::StaticOrder S; S.init(M, D, (int)gridDim.x, (int)blockIdx.x);
            EpiRes<0> E{(bf16*)(ws + WS_XB), ws + WS_XL, nullptr, (u64*)(ws + WS_RSQ) + (size_t)(3 * l + 2) * M};
            pg8::gemm_phase<EpiRes<0>, pg8::StaticOrder, GEMM_ALIGN, GEMM_SP2>(lds, g, S, E, wave_s);
        }
        LSEAM(g0 + PH_OUT);
        for (int rep = 0; rep <= ((PROBE_DUP >> 1) & 1); ++rep)
        if (IN(g0 + PH_UP2)) {
            KArgs ka = kargs(); unsigned char* ws = ka->ws; unsigned char* wl = ws + WS_W + (size_t)l * W_LAYER;
            pg8::Gemm g{(const bf16*)(ws + WS_XB), (const bf16*)(wl + W_2A), M, 2 * FF, D}; pg8::StaticOrder S; S.init(M, 2 * FF, (int)gridDim.x, (int)blockIdx.x);
            rstd_cache_reset(lds, OTID()); EpiUp E{(bf16*)(ws + WS_ACT), (const u64*)(ws + WS_RSQ) + (size_t)(3 * l + 2) * M, lds};
            if ((PROBE_DUP >> 8) & 1) { S.r1 = 5; pg8::gemm_phase<EpiUp, pg8::StaticOrder, GEMM_ALIGN, GEMM_SP2>(lds, g, S, E, wave_s);
                { XcdBarrier b_; b_.bar = (unsigned*)(kargs()->ws + WS_CTL) + CW_BAR; b_.x = xb_xcc_id(); b_.st = (volatile LAS unsigned*)(lds + MISC_OFF) + 8; xcd_barrier(b_, OTID()); } S.r0 = 5; S.r1 = 1 << 30; }
            pg8::gemm_phase<EpiUp, pg8::StaticOrder, GEMM_ALIGN, GEMM_SP2>(lds, g, S, E, wave_s);
        }
        LSEAM(g0 + PH_UP2);
        if (IN(g0 + PH_DN2)) {
            KArgs ka = kargs(); unsigned char* ws = ka->ws; unsigned char* wl = ws + WS_W + (size_t)l * W_LAYER;
            pg8::Gemm g{(const bf16*)(ws + WS_ACT), (const bf16*)(wl + W_2B), M, D, FF}; pg8::StaticOrder S; S.init(M, D, (int)gridDim.x, (int)blockIdx.x);
            if (l == DEPTH - 1) { EpiRes<1, true> E{(bf16*)(ws + WS_XB), ws + WS_XL, ka->out, nullptr};
                pg8::gemm_phase<EpiRes<1, true>, pg8::StaticOrder, GEMM_ALIGN, GEMM_SP2>(lds, g, S, E, wave_s); }
            else { EpiRes<1> E{(bf16*)(ws + WS_XB), ws + WS_XL, nullptr, (u64*)(ws + WS_RSQ) + (size_t)(3 * l + 3) * M};
                pg8::gemm_phase<EpiRes<1>, pg8::StaticOrder, GEMM_ALIGN, GEMM_SP2>(lds, g, S, E, wave_s); }
        }
        LSEAM(g0 + PH_DN2);

}
__global__ void __launch_bounds__(NWAVES * 64, 2) fwd(Args args) {
    extern __shared__ __attribute__((aligned(16))) unsigned char lds_raw[];
    LAS unsigned char* lds = (LAS unsigned char*)lds_raw;
#ifdef CODE_SHIFT_NOPS
    asm volatile(".rept " CODE_SHIFT_NOPS "\n\ts_nop 0\n\t.endr" ::: "memory");
#endif
    const int wave_s = __builtin_amdgcn_readfirstlane((int)threadIdx.x >> 6);
    { const int tid = OTID(); for (int u = tid; u < (LDS_BYTES - RING_BYTES) / 4; u += NWAVES * 64) ((LAS unsigned*)(lds + RING_BYTES))[u] = 0u; }
    __syncthreads();
    if (ONE_LAUNCH && LOCAL_SEAMS) { unsigned* xt = (unsigned*)(kargs()->ws + WS_CTL) + CW_BAR + XB_XTAB; const unsigned xv = xb_xcc_id() + 1u; if (OTID() == 0) xt[blockIdx.x] = xv; }
    if (ONE_LAUNCH) (void)xcd_barrier_post((unsigned*)(kargs()->ws + WS_CTL) + CW_BAR, (volatile LAS unsigned*)(lds + MISC_OFF) + 8, OTID());
    const int lo = args.ph_lo, hi = args.ph_hi;

    for (int rep = 0; rep <= (PROBE_DUP & 1); ++rep)
    if (IN(0)) { KArgs ka = kargs(); TIDS(); prologue(ka, lds, gw, NGW, wave, lane); __syncthreads(); }
    SEAM(0);
    if (ONE_LAUNCH && LOCAL_SEAMS) {
        const int tid = OTID(); const unsigned* xt = (const unsigned*)(kargs()->ws + WS_CTL) + CW_BAR + XB_XTAB;
        bool bad = (gridDim.x != 256u);
        if (!bad && tid < 256) { const unsigned a = xt[tid], b = xt[tid & 63]; bad = (a == 0u) || (a != b); }
        if (bad) ((volatile LAS unsigned*)(lds + MISC_OFF))[12] = 1u;
        __syncthreads();
    }
    layer_body<0>(lo, hi, lds, wave_s); layer_body<1>(lo, hi, lds, wave_s); layer_body<2>(lo, hi, lds, wave_s); layer_body<3>(lo, hi, lds, wave_s);
#undef IN
#undef SEAM
#undef LSEAM
#undef TIDS
#undef OTID
}

extern "C" void kernel_launch(void* const* d_in, const int* in_sizes, int n_in, void* d_out, int out_size, void* d_ws, size_t ws_size, hipStream_t stream) {
    static int grid = 0;
    if (grid == 0) {
        if (n_in != 18 || out_size != M * D || ws_size < WS_END) { fprintf(stderr, "kernel_launch: unexpected problem (n_in %d, out %d, ws %zu, need %zu); nothing launched\n", n_in, out_size, ws_size, (size_t)WS_END); grid = -1; return; }
        int dev = 0, cus = 0, per_cu = 0;
        if (hipGetDevice(&dev) != hipSuccess || hipDeviceGetAttribute(&cus, hipDeviceAttributeMultiprocessorCount, dev) != hipSuccess) { grid = -1; return; }
        if (hipFuncSetAttribute((const void*)fwd, hipFuncAttributeMaxDynamicSharedMemorySize, LDS_BYTES) != hipSuccess) { fprintf(stderr, "kernel_launch: hipFuncSetAttribute failed\n"); grid = -1; return; }
        if (hipOccupancyMaxActiveBlocksPerMultiprocessor(&per_cu, (const void*)fwd, NWAVES * 64, LDS_BYTES) != hipSuccess || per_cu < 1) { fprintf(stderr, "kernel_launch: occupancy query says %d\n", per_cu); }
        (void)hipGetLastError();
        grid = cus;
    }
    if (grid < 0) return;
    (void)hipMemsetAsync((char*)d_ws + WS_CTL, 0, CTL_ZERO_BYTES, stream);
    Args a{};
    for (int i = 0; i < 18; ++i) a.in[i] = (const float*)d_in[i];
    a.out = (float*)d_out; a.ws = (unsigned char*)d_ws;
    if (ONE_LAUNCH) { a.ph_lo = 0; a.ph_hi = NPH; hipLaunchKernelGGL(fwd, dim3(grid), dim3(NWAVES * 64), LDS_BYTES, stream, a); }
    else for (int p = 0; p < NPH; ++p) { a.ph_lo = p; a.ph_hi = p + 1; hipLaunchKernelGGL(fwd, dim3(grid), dim3(NWAVES * 64), LDS_BYTES, stream, a); }
}
```

```cpp
#include <hip/hip_runtime.h>
#include <cstdio>
#include <cstdint>

#ifndef PROBE_DUP
#define LOCAL_SEAMS 1
#define PROBE_DUP 0
#endif
#ifndef ONE_LAUNCH
#define ONE_LAUNCH 1
#endif

#ifndef FAST_MASK
#define FAST_MASK 7
#endif
#ifndef GEMM_ALIGN
#define GEMM_ALIGN true
#endif
#ifndef GEMM_SP2
#define GEMM_SP2 true
#endif
#ifndef GEMM_BAL
#define GEMM_BAL false
#endif
#ifndef FP8_GATES
#define FP8_GATES 1
#endif
#ifndef UNROLL_LAYERS
#define UNROLL_LAYERS 1
#endif
#ifndef FP8_QA
#define FP8_QA 2
#endif
#ifndef FP8_QK
#define FP8_QK 0
#endif
#ifndef STATIC_PRIO
#define STATIC_PRIO 0
#endif
#ifndef QKN_IN_EPI
#define QKN_IN_EPI 1
#endif
#ifndef NORM_ON_LOAD
#define NORM_ON_LOAD 0
#endif
typedef unsigned long long u64;
__device__ __forceinline__ int tid_of(int wave_s) { int t; asm volatile("v_mbcnt_lo_u32_b32 %0, -1, 0\n\tv_mbcnt_hi_u32_b32 %0, -1, %0\n\tv_lshl_add_u32 %0, %1, 6, %0" : "=&v"(t) : "s"(wave_s)); return t; }
namespace pg8 {
#define PG8_LAS __attribute__((address_space(3)))
typedef unsigned short bf16_t;
typedef short bf16x8 __attribute__((ext_vector_type(8)));
typedef float f32x4 __attribute__((ext_vector_type(4)));
typedef unsigned u32x4 __attribute__((ext_vector_type(4)));
typedef unsigned u32x2 __attribute__((ext_vector_type(2)));
constexpr int BM = 256, BK = 64, HALF = 128, HTB = HALF * BK * 2, STAGE_BYTES = 8 * HTB, NXCD = 8, WGM = 8;

__host__ __device__ __forceinline__ int lds_byte(int r, int c) { const int st = (r >> 4) * 2 + (c >> 5), rr = r & 15, cc = c & 31, ob = rr * 64 + cc * 2; return st * 1024 + (ob ^ (((ob >> 9) & 1) << 5)); }
__host__ __device__ __forceinline__ void stage_rc(int b, int& R, int& C) { const int st = b / 1024, sb = b % 1024, swz = sb ^ (((sb >> 9) & 1) << 5); R = (st >> 1) * 16 + swz / 64; C = (st & 1) * 32 + (swz % 64) / 2; }
__host__ __device__ __forceinline__ int perm32(int rho) { const int n = rho >> 4, i = rho & 15; return 8 * (i >> 2) + 4 * n + (i & 3); }

struct Unit { int pm, pn; };
struct Gemm { const bf16_t* A; const bf16_t* Bt; int M, N, K; bool ablk = false, bblk = false; };

struct StaticOrder {
    int nM, nN, nwg, G, c, r0 = 0, r1 = 1 << 30;
    __host__ __device__ void init(int M, int N, int G_, int c_) { nM = M / BM; nN = N / BM; nwg = nM * nN; G = G_; c = c_; }
    __host__ __device__ bool next(int i, Unit& u) const {
        if (i + r0 >= r1) return false;
        const long L = (long)(i + r0) * G + c; if (L >= nwg) return false;
        int wgid = (int)L; { const int q = nwg / NXCD, r = nwg % NXCD, xcd = wgid % NXCD, off = wgid / NXCD; wgid = (xcd < r ? xcd * (q + 1) : r * (q + 1) + (xcd - r) * q) + off; }
        const int nig = WGM * nN, gid = wgid / nig, fm = gid * WGM, gsz = (nM - fm) < WGM ? (nM - fm) : WGM;
        u.pm = fm + ((wgid % nig) % gsz); u.pn = (wgid % nig) / gsz; return true;
    }
    __device__ __forceinline__ void a_ready(const Unit&) const {}
    __device__ __forceinline__ void done(const Unit&) const {}
};

typedef int i32x8 __attribute__((ext_vector_type(8)));
typedef int i32x4 __attribute__((ext_vector_type(4)));
__device__ __forceinline__ i32x8 cat8(bf16x8 a, bf16x8 b) { return __builtin_shufflevector(__builtin_bit_cast(i32x4, a), __builtin_bit_cast(i32x4, b), 0, 1, 2, 3, 4, 5, 6, 7); }
__device__ __forceinline__ unsigned cvt_pk_bf16(float lo, float hi) { unsigned r; asm volatile("v_cvt_pk_bf16_f32 %0, %1, %2" : "=v"(r) : "v"(lo), "v"(hi)); return r; }
__device__ __forceinline__ float bf_lo(unsigned w) { return __uint_as_float(w << 16); }
__device__ __forceinline__ float bf_hi(unsigned w) { return __uint_as_float(w & 0xffff0000u); }

template <class Epi, class Sched, bool ALIGN_EPI = false, bool SP2 = false, bool FP8 = false>
__device__ __forceinline__ void gemm_phase(PG8_LAS unsigned char* lds, const Gemm g, const Sched& S, const Epi& E, const int wave_s  ) {
    const int tid = tid_of(wave_s);
    const int wid = __builtin_amdgcn_readfirstlane(tid >> 6), lane = tid & 63, wr = wid >> 2, wc = wid & 3, fr = lane & 15, fq = lane >> 4;
    const int K = g.K, nt = K / BK;
    unsigned voffA[2], voffB[2];
#pragma unroll
    for (int i = 0; i < 2; ++i) { int R, C; stage_rc(tid * 16 + i * 8192, R, C); const int Rb = Epi::PERM ? ((R & ~31) + perm32(R & 31)) : R;
        voffA[i] = (unsigned)(R * (g.ablk ? BK : K) + C) * 2u; voffB[i] = (unsigned)(Rb * (g.bblk ? BK : K) + C) * 2u; }
    const size_t kstepA = g.ablk ? (size_t)(BM * BK * 2) : (size_t)(BK * 2), kstepB = g.bblk ? (size_t)(BM * BK * 2) : (size_t)(BK * 2);
    const size_t hstepA = g.ablk ? (size_t)(HALF * BK * 2) : (size_t)HALF * K * 2, hstepB = g.bblk ? (size_t)(HALF * BK * 2) : (size_t)HALF * K * 2;
    const size_t tstepA = (size_t)BM * K * 2, tstepB = (size_t)BM * K * 2;
    const unsigned ldsw = (unsigned)wid * 1024u;
    const int aoff = lds_byte(wr * 64 + fr, fq * 8), boff = lds_byte(wc * 32 + fr, fq * 8);
#define PG8_SA(b, h) (((b) * 2 + (h)) * HTB)
#define PG8_SB(b, h) ((4 + (b) * 2 + (h)) * HTB)
#define PG8_STAGE(bufoff, gbase, voff) do { const char* _gb = (const char*)(gbase); asm volatile("" : "+s"(_gb));     \
        _Pragma("unroll") for (int _i = 0; _i < 2; ++_i) \
        __builtin_amdgcn_global_load_lds((const unsigned*)(_gb + (voff)[_i]), (PG8_LAS unsigned*)(lds + (bufoff) + ldsw + _i * 8192), 16, 0, 0); } while (0)
#define PG8_LDA(dst, b, h) do { _Pragma("unroll") for (int m = 0; m < 4; ++m) _Pragma("unroll") for (int k = 0; k < 2; ++k) dst[m][k] = *(const PG8_LAS bf16x8*)(lds + PG8_SA(b, h) + aoff + m * 2048 + k * 1024); } while (0)
#define PG8_LDB(dst, b, h) do { _Pragma("unroll") for (int n = 0; n < 2; ++n) _Pragma("unroll") for (int k = 0; k < 2; ++k) dst[n][k] = *(const PG8_LAS bf16x8*)(lds + PG8_SB(b, h) + boff + n * 2048 + k * 1024); } while (0)
#define PG8_MMA(ai, bj, At, Bt) do { if (!STATIC_PRIO) __builtin_amdgcn_s_setprio(1); _Pragma("unroll") for (int m = 0; m < 4; ++m) _Pragma("unroll") for (int n = 0; n < 2; ++n) { \
        if constexpr (FP8) { acc[ai][bj][m][n] = __builtin_amdgcn_mfma_scale_f32_16x16x128_f8f6f4(cat8(Bt[n][0], Bt[n][1]), cat8(At[m][0], At[m][1]), acc[ai][bj][m][n], 0, 0, 0, 0, 0, 0); }   \
        else { _Pragma("unroll") for (int k = 0; k < 2; ++k) acc[ai][bj][m][n] = __builtin_amdgcn_mfma_f32_16x16x32_bf16(Bt[n][k], At[m][k], acc[ai][bj][m][n], 0, 0, 0); } } \
        if (!STATIC_PRIO) __builtin_amdgcn_s_setprio(0); } while (0)
#define PG8_WAIT_V(n) asm volatile("s_waitcnt vmcnt(" #n ")" ::: "memory")
#define PG8_WAIT_L(n) asm volatile("s_waitcnt lgkmcnt(" #n ")" ::: "memory")
#define PG8_BAR __builtin_amdgcn_s_barrier()
#define PG8_SCHED __builtin_amdgcn_sched_barrier(0)
    Unit cur, nxt; int ui = 0;
    if (!S.next(0, cur)) return;
    if (STATIC_PRIO && wr == 1) __builtin_amdgcn_s_setprio(1);
    f32x4 acc[2][2][4][2];
#pragma unroll
    for (int a = 0; a < 2; ++a)
#pragma unroll
        for (int b = 0; b < 2; ++b)
#pragma unroll
            for (int m = 0; m < 4; ++m)
#pragma unroll
                for (int n = 0; n < 2; ++n) acc[a][b][m][n] = (f32x4){0.f, 0.f, 0.f, 0.f};
    bf16x8 At[4][2], B0[2][2], B1[2][2];
    const char* cA = (const char*)g.A + (size_t)cur.pm * tstepA; const char* cB = (const char*)g.Bt + (size_t)cur.pn * tstepB;
    S.a_ready(cur);
    if constexpr (SP2 && GEMM_BAL) {
        PG8_STAGE(PG8_SB(0, 0), cB, voffB); PG8_STAGE(PG8_SB(0, 1), cB + hstepB, voffB); PG8_STAGE(PG8_SA(0, 0), cA, voffA); PG8_STAGE(PG8_SA(0, 1), cA + hstepA, voffA);
        if (wr == 1) PG8_BAR;
        PG8_WAIT_V(0); PG8_BAR;
        PG8_STAGE(PG8_SB(1, 0), cB + kstepB, voffB); PG8_STAGE(PG8_SB(1, 1), cB + hstepB + kstepB, voffB);
        PG8_BAR;
    } else if constexpr (SP2) {
        PG8_STAGE(PG8_SB(0, 0), cB, voffB); PG8_STAGE(PG8_SB(0, 1), cB + hstepB, voffB); PG8_STAGE(PG8_SA(0, 0), cA, voffA); PG8_STAGE(PG8_SA(0, 1), cA + hstepA, voffA);
        if (wr == 1) PG8_BAR;
        PG8_WAIT_V(2); PG8_BAR;
        PG8_STAGE(PG8_SB(1, 0), cB + kstepB, voffB); PG8_STAGE(PG8_SA(1, 0), cA + kstepA, voffA); PG8_STAGE(PG8_SB(1, 1), cB + hstepB + kstepB, voffB);
        PG8_WAIT_V(6); PG8_BAR;
    } else {
        PG8_STAGE(PG8_SB(0, 0), cB, voffB); PG8_STAGE(PG8_SA(0, 0), cA, voffA); PG8_STAGE(PG8_SB(0, 1), cB + hstepB, voffB); PG8_STAGE(PG8_SA(0, 1), cA + hstepA, voffA);
        if (wr == 1) PG8_BAR;
        PG8_WAIT_V(4); PG8_BAR;
        PG8_STAGE(PG8_SB(1, 0), cB + kstepB, voffB); PG8_STAGE(PG8_SA(1, 0), cA + kstepA, voffA); PG8_STAGE(PG8_SB(1, 1), cB + hstepB + kstepB, voffB);
        PG8_WAIT_V(6); PG8_BAR;
    }
    for (;;) {
        const bool has_next = S.next(ui + 1, nxt);
        const char* nA = has_next ? (const char*)g.A + (size_t)nxt.pm * tstepA : cA; const char* nB = has_next ? (const char*)g.Bt + (size_t)nxt.pn * tstepB : cB;
        for (int t = 0; t < nt; t += 2) {
            const bool last = (t == nt - 2);
            const char* a1 = cA + (size_t)(t + 1) * kstepA;
            const char* a2 = last ? nA : cA + (size_t)(t + 2) * kstepA; const char* b2 = last ? nB : cB + (size_t)(t + 2) * kstepB;
            const char* a3 = a2 + kstepA; const char* b3 = b2 + kstepB;
            if (last && has_next) S.a_ready(nxt);
            if constexpr (Epi::MID) { if (t == Epi::MID_T0 || t == Epi::MID_T1) { const int t2 = tid_of(wave_s) & 63; E.mid(acc, cur, t, wr, wc, t2 & 15, t2 >> 4); } }
            if constexpr (SP2 && GEMM_BAL) {
            PG8_LDB(B0, 0, 0); PG8_LDB(B1, 0, 1); PG8_SCHED; PG8_LDA(At, 0, 0); PG8_STAGE(PG8_SA(1, 0), a1, voffA); PG8_STAGE(PG8_SA(1, 1), a1 + hstepA, voffA);
            PG8_WAIT_V(4); PG8_WAIT_L(0); PG8_BAR; PG8_MMA(0, 0, At, B0); PG8_MMA(0, 1, At, B1); PG8_BAR; PG8_SCHED;
            PG8_LDA(At, 0, 1); PG8_STAGE(PG8_SB(0, 0), b2, voffB); PG8_STAGE(PG8_SB(0, 1), b2 + hstepB, voffB);
            PG8_WAIT_V(4); PG8_WAIT_L(0); PG8_BAR; PG8_MMA(1, 0, At, B0); PG8_MMA(1, 1, At, B1); PG8_BAR; PG8_SCHED;
            PG8_LDB(B0, 1, 0); PG8_LDB(B1, 1, 1); PG8_SCHED; PG8_LDA(At, 1, 0); PG8_STAGE(PG8_SA(0, 0), a2, voffA); PG8_STAGE(PG8_SA(0, 1), a2 + hstepA, voffA);
            PG8_WAIT_V(4); PG8_WAIT_L(0); PG8_BAR; PG8_MMA(0, 0, At, B0); PG8_MMA(0, 1, At, B1); PG8_BAR; PG8_SCHED;
            PG8_LDA(At, 1, 1); PG8_STAGE(PG8_SB(1, 0), b3, voffB); PG8_STAGE(PG8_SB(1, 1), b3 + hstepB, voffB);
            PG8_WAIT_V(4); PG8_WAIT_L(0); PG8_BAR; PG8_MMA(1, 0, At, B0); PG8_MMA(1, 1, At, B1); PG8_BAR; PG8_SCHED;
            } else if constexpr (SP2) {
            PG8_LDB(B0, 0, 0); PG8_LDB(B1, 0, 1); PG8_SCHED; PG8_LDA(At, 0, 0); PG8_STAGE(PG8_SA(1, 1), a1 + hstepA, voffA);
            PG8_WAIT_V(8); PG8_WAIT_L(0); PG8_BAR; PG8_MMA(0, 0, At, B0); PG8_MMA(0, 1, At, B1); PG8_BAR; PG8_SCHED;
            PG8_LDA(At, 0, 1); PG8_STAGE(PG8_SB(0, 0), b2, voffB); PG8_STAGE(PG8_SB(0, 1), b2 + hstepB, voffB); PG8_STAGE(PG8_SA(0, 0), a2, voffA);
            PG8_WAIT_V(8); PG8_WAIT_L(0); PG8_BAR; PG8_MMA(1, 0, At, B0); PG8_MMA(1, 1, At, B1); PG8_BAR; PG8_SCHED;
            PG8_LDB(B0, 1, 0); PG8_LDB(B1, 1, 1); PG8_SCHED; PG8_LDA(At, 1, 0); PG8_STAGE(PG8_SA(0, 1), a2 + hstepA, voffA);
            PG8_WAIT_V(8); PG8_WAIT_L(0); PG8_BAR; PG8_MMA(0, 0, At, B0); PG8_MMA(0, 1, At, B1); PG8_BAR; PG8_SCHED;
            PG8_LDA(At, 1, 1); PG8_STAGE(PG8_SB(1, 0), b3, voffB); PG8_STAGE(PG8_SB(1, 1), b3 + hstepB, voffB); PG8_STAGE(PG8_SA(1, 0), a3, voffA);
            PG8_WAIT_V(8); PG8_WAIT_L(0); PG8_BAR; PG8_MMA(1, 0, At, B0); PG8_MMA(1, 1, At, B1); PG8_BAR; PG8_SCHED;
            } else {
            PG8_LDB(B0, 0, 0); PG8_SCHED; PG8_LDA(At, 0, 0); PG8_STAGE(PG8_SA(1, 1), a1 + hstepA, voffA);
            PG8_WAIT_L(8); PG8_BAR; PG8_WAIT_L(0); PG8_MMA(0, 0, At, B0); PG8_BAR; PG8_SCHED;
            PG8_LDB(B1, 0, 1); PG8_STAGE(PG8_SB(0, 0), b2, voffB);
            PG8_BAR; PG8_WAIT_L(0); PG8_MMA(0, 1, At, B1); PG8_BAR;
            PG8_LDA(At, 0, 1); PG8_STAGE(PG8_SA(0, 0), a2, voffA);
            PG8_BAR; PG8_WAIT_L(0); PG8_MMA(1, 0, At, B0); PG8_BAR; PG8_SCHED;
            PG8_STAGE(PG8_SB(0, 1), b2 + hstepB, voffB);
            PG8_WAIT_V(6); PG8_BAR; PG8_MMA(1, 1, At, B1); PG8_BAR;
            PG8_LDB(B0, 1, 0); PG8_SCHED; PG8_LDA(At, 1, 0); PG8_STAGE(PG8_SA(0, 1), a2 + hstepA, voffA);
            PG8_WAIT_L(8); PG8_BAR; PG8_WAIT_L(0); PG8_MMA(0, 0, At, B0); PG8_BAR; PG8_SCHED;
            PG8_LDB(B1, 1, 1); PG8_STAGE(PG8_SB(1, 0), b3, voffB);
            PG8_BAR; PG8_WAIT_L(0); PG8_MMA(0, 1, At, B1); PG8_BAR;
            PG8_LDA(At, 1, 1); PG8_STAGE(PG8_SA(1, 0), a3, voffA);
            PG8_BAR; PG8_WAIT_L(0); PG8_MMA(1, 0, At, B0); PG8_BAR; PG8_SCHED;
            PG8_STAGE(PG8_SB(1, 1), b3 + hstepB, voffB);
            PG8_WAIT_V(6); PG8_BAR; PG8_MMA(1, 1, At, B1); PG8_BAR;
            }
        }
        if constexpr (ALIGN_EPI) { if (wr == 0) PG8_BAR; }
        { const int t2 = tid_of(wave_s) & 63; E(acc, cur, wr, wc, t2 & 15, t2 >> 4); } S.done(cur);
        if (!has_next) break;
#pragma unroll
        for (int a = 0; a < 2; ++a)
#pragma unroll
            for (int b = 0; b < 2; ++b)
#pragma unroll
                for (int m = 0; m < 4; ++m)
#pragma unroll
                    for (int n = 0; n < 2; ++n) acc[a][b][m][n] = (f32x4){0.f, 0.f, 0.f, 0.f};
        cur = nxt; cA = nA; cB = nB; ++ui;
        if constexpr (ALIGN_EPI) { if (wr == 1) PG8_BAR; }
    }
    PG8_WAIT_V(0);
    if constexpr (!ALIGN_EPI) { if (wr == 0) PG8_BAR; }
    PG8_BAR;
    if (STATIC_PRIO) __builtin_amdgcn_s_setprio(0);
#undef PG8_SA
#undef PG8_SB
#undef PG8_STAGE
#undef PG8_LDA
#undef PG8_LDB
#undef PG8_MMA
#undef PG8_WAIT_V
#undef PG8_WAIT_L
#undef PG8_BAR
#undef PG8_SCHED
}
}

constexpr int M = 16384, D = 2048, FF = 5632, NIN = 15360, KBR = 2560, DEPTH = 4;
constexpr int NWAVES = 8;
constexpr float EPS = 1e-6f;
constexpr float SSQ_SCALE = 16777216.0f;
typedef unsigned short bf16;
typedef pg8::f32x4 f32x4;
typedef pg8::u32x4 u32x4;
typedef pg8::u32x2 u32x2;
typedef float f32x2v __attribute__((ext_vector_type(2)));
#define LAS __attribute__((address_space(3)))

constexpr size_t MiB = 1u << 20;
constexpr size_t WS_CTL = 0, CTL_ZERO_BYTES = 4 * MiB;
constexpr size_t WS_RSQ = 1 * MiB;
constexpr size_t WS_W = 8 * MiB, W_LAYER = 210 * MiB;
constexpr size_t W_IN8 = FP8_QK ? 66 * MiB + 12 * MiB : 66 * MiB + 36 * MiB;
constexpr float W8_SCALE = 256.0f;
constexpr size_t W_1A = 0, W_1B = 44 * MiB, W_IN = 66 * MiB, W_BR = 126 * MiB, W_O = 136 * MiB, W_2A = 144 * MiB, W_2B = 188 * MiB;
constexpr size_t WS_XB = 848 * MiB;
constexpr size_t WS_QA = 912 * MiB, WS_KA = WS_QA + 48 * MiB, WS_VA = WS_KA + 48 * MiB, WS_QB = WS_VA + 48 * MiB, WS_KB = WS_QB + 32 * MiB, WS_VB = WS_KB + 8 * MiB,
                 WS_QC = WS_VB + 8 * MiB, WS_KC = WS_QC + 32 * MiB, WS_VC = WS_KC + 32 * MiB, WS_G = WS_VC + 32 * MiB;
constexpr size_t WS_O = WS_G + (FP8_GATES ? 96 : 192) * MiB;
constexpr size_t WS_OAG = WS_O + 80 * MiB;
constexpr size_t WS_LSE = WS_OAG + 48 * MiB;
constexpr size_t WS_Z = WS_LSE + 1 * MiB;
constexpr size_t WS_XL = WS_Z + 64 * MiB;
constexpr size_t WS_XB8 = WS_XL + 64 * MiB;
constexpr size_t WS_ACT = WS_XB8 + 32 * MiB;
constexpr size_t WS_END = WS_ACT + 176 * MiB;
static_assert((size_t)M * FF * 2 == 176 * MiB, "act size");
static_assert(WS_W + 4 * W_LAYER == WS_XB, "weight map");
constexpr int CW_BAR = 4096;

constexpr int RING_BYTES = 131072, MISC_OFF = RING_BYTES + 320, LDS_BYTES = 147456;

#define XB_TMO      128
#define XB_XCNT(j)  (256  + 64 * (j))
#define XB_XSUB(j)  (1280 + 64 * (j))
#define XB_XGEN(j)  (2304 + 64 * (j))
#define XB_TOP      3328
#define XB_TOPGEN   3392
#define XCD_BAR_WORDS 3456
#define XB_SPIN_CAP (1u << 22)
__device__ __forceinline__ unsigned xb_ld(unsigned* p)              { return __hip_atomic_load(p, __ATOMIC_RELAXED, __HIP_MEMORY_SCOPE_AGENT); }
__device__ __forceinline__ unsigned xb_add(unsigned* p, unsigned v) { return __hip_atomic_fetch_add(p, v, __ATOMIC_RELAXED, __HIP_MEMORY_SCOPE_AGENT); }
__device__ __forceinline__ unsigned xb_xcc_id() { return (unsigned)__builtin_amdgcn_s_getreg((3 << 11) | 20) & 0xFu; }
#define XB_SPIN(cond, bar) do { unsigned _sp = 0; while (cond) { __builtin_amdgcn_s_sleep(1); \
    if ((++_sp & 255u) == 0u) { if (xb_ld(&(bar)[XB_TMO])) break; if (_sp > XB_SPIN_CAP) { atomicAdd(&(bar)[XB_TMO], 1u); break; } } } } while (0)
struct XcdBarrier { unsigned* bar; unsigned x; volatile LAS unsigned* st; };
__device__ __forceinline__ XcdBarrier xcd_barrier_post(unsigned* bar, volatile LAS unsigned* st, int tid) {
    XcdBarrier b; b.bar = bar; b.x = xb_xcc_id(); b.st = st;
    if (tid == 0) (void)xb_add(&bar[XB_XCNT(b.x)], 1u);
    return b;
}
__device__ __forceinline__ void xcd_barrier_complete(unsigned* bar, unsigned x, unsigned& nloc, unsigned& nx) {
    const unsigned G = gridDim.x * gridDim.y * gridDim.z;
    unsigned sum, cnt, mine, sp = 0u;
    for (;;) {
        sum = 0u; cnt = 0u; mine = 0u;
#pragma unroll
        for (unsigned j = 0; j < 16; ++j) { const unsigned c = xb_ld(&bar[XB_XCNT(j)]); sum += c; cnt += (c > 0u) ? 1u : 0u; mine = (j == x) ? c : mine; }
        if (sum == G) break;
        __builtin_amdgcn_s_sleep(1);
        if ((++sp & 255u) == 0u) { if (xb_ld(&bar[XB_TMO])) break; if (sp > XB_SPIN_CAP) { atomicAdd(&bar[XB_TMO], 1u); break; } }
    }
    nloc = mine > 0u ? mine : 1u; nx = cnt > 0u ? cnt : 1u;
}
__device__ __forceinline__ void xcd_barrier(const XcdBarrier& b, int tid) {
    asm volatile("s_waitcnt vmcnt(0)" ::: "memory");
    __syncthreads();
    if (tid == 0) {
        unsigned* bar = b.bar;
        __builtin_amdgcn_s_waitcnt(0);
        unsigned nloc = b.st[0], nx = b.st[1];
        if (nloc == 0u) { xcd_barrier_complete(bar, b.x, nloc, nx); b.st[0] = nloc; b.st[1] = nx; }
        const unsigned old = xb_add(&bar[XB_XSUB(b.x)], 1u);
        const unsigned gen = old / nloc;
        if (old + 1u == (gen + 1u) * nloc) {
            __builtin_amdgcn_fence(__ATOMIC_RELEASE, "agent");
            asm volatile("s_waitcnt vmcnt(0)" ::: "memory");
            const unsigned og = xb_add(&bar[XB_TOP], 1u);
            const unsigned tg = og / nx;
            if (og + 1u == (tg + 1u) * nx) xb_add(&bar[XB_TOPGEN], 1u);
            else XB_SPIN(xb_ld(&bar[XB_TOPGEN]) == tg, bar);
            __builtin_amdgcn_fence(__ATOMIC_ACQUIRE, "agent");
            xb_add(&bar[XB_XGEN(b.x)], 1u);
            asm volatile("s_waitcnt vmcnt(0)" ::: "memory");
        } else {
            XB_SPIN(xb_ld(&bar[XB_XGEN(b.x)]) == gen, bar);
            __builtin_amdgcn_fence(__ATOMIC_ACQUIRE, "agent");
            asm volatile("s_waitcnt vmcnt(0)" ::: "memory");
        }
    }
    __syncthreads();
}

#define XB_GRP      4096
#define XB_XTAB     12288
__device__ __forceinline__ void grp_barrier(unsigned* bar, int tid) {
    asm volatile("s_waitcnt vmcnt(0)" ::: "memory");
    __syncthreads();
    if (tid == 0) {
        unsigned* ctr = bar + XB_GRP + 64u * (blockIdx.x & 63u);
        const unsigned old = xb_add(ctr, 1u);
        const unsigned target = (old & ~3u) + 4u;
        XB_SPIN(xb_ld(ctr) < target, bar);
        __builtin_amdgcn_fence(__ATOMIC_ACQUIRE, "agent");
        asm volatile("s_waitcnt vmcnt(0)" ::: "memory");
    }
    __syncthreads();
}

#define LDS_WAIT() asm volatile("s_waitcnt lgkmcnt(0)" ::: "memory")
__device__ __forceinline__ unsigned f2bf(float f) { unsigned u = __builtin_bit_cast(unsigned, f); return (u + 0x7fffu + ((u >> 16) & 1u)) >> 16; }
__device__ __forceinline__ unsigned pk2(float lo, float hi) { return f2bf(lo) | (f2bf(hi) << 16); }
__device__ __forceinline__ float bf_lo(unsigned w) { return __uint_as_float(w << 16); }
__device__ __forceinline__ float bf_hi(unsigned w) { return __uint_as_float(w & 0xffff0000u); }
__device__ __forceinline__ float xrow16_sum(float x) {
    auto s = __builtin_amdgcn_permlane16_swap(__float_as_uint(x), __float_as_uint(x), false, false);
    x = __uint_as_float(s[0]) + __uint_as_float(s[1]);
    auto t = __builtin_amdgcn_permlane32_swap(__float_as_uint(x), __float_as_uint(x), false, false);
    return __uint_as_float(t[0]) + __uint_as_float(t[1]);
}
__device__ __forceinline__ float xrow16_max(float x) {
    auto s = __builtin_amdgcn_permlane16_swap(__float_as_uint(x), __float_as_uint(x), false, false);
    x = fmaxf(__uint_as_float(s[0]), __uint_as_float(s[1]));
    auto t = __builtin_amdgcn_permlane32_swap(__float_as_uint(x), __float_as_uint(x), false, false);
    return fmaxf(__uint_as_float(t[0]), __uint_as_float(t[1]));
}
__device__ __forceinline__ float wave_sum(float v) {
#pragma unroll
    for (int o = 1; o < 64; o <<= 1) v += __shfl_xor(v, o);
    return v;
}
__device__ __forceinline__ float wave_max(float v) {
#pragma unroll
    for (int o = 1; o < 64; o <<= 1) v = fmaxf(v, __shfl_xor(v, o));
    return v;
}
__device__ __forceinline__ float rstd_row(const u64* rsq, int row) {
    const u64 v = rsq[row];
    return rsqrtf((float)v * (1.0f / (SSQ_SCALE * (float)D)) + EPS);
}
__device__ __forceinline__ float sconst(unsigned bits) { unsigned r; asm volatile("s_mov_b32 %0, %1" : "=s"(r) : "s"(bits)); return __builtin_bit_cast(float, r); }
__device__ __forceinline__ float sigmoidf_(float x) { return __builtin_amdgcn_rcpf(1.0f + __expf(-x)); }

constexpr int RTAB_OFF = RING_BYTES + 9216, RTAG_OFF = RTAB_OFF + 4096;
static_assert(RTAG_OFF + 64 <= LDS_BYTES, "rstd cache LDS map");
__device__ __forceinline__ void rstd_cache_reset(LAS unsigned char* lds, int tid) { if ((tid & 63) == 0) ((LAS int*)(lds + RTAG_OFF))[tid >> 6] = -1; }
__device__ __forceinline__ void rstd8(const u64* rsq, LAS unsigned char* lds, int pm, int wr, int wc, int fr, int fq, float scale, float (&rs)[2][4]) {
    const int wid = wr * 4 + wc;
    LAS float* tab = (LAS float*)(lds + RTAB_OFF) + wid * 128; LAS int* tag = (LAS int*)(lds + RTAG_OFF) + wid;
    const int have = __builtin_amdgcn_readfirstlane(*tag);
    if (have == pm) {
#pragma unroll
        for (int ai = 0; ai < 2; ++ai)
#pragma unroll
            for (int m = 0; m < 4; ++m) rs[ai][m] = tab[(ai * 4 + m) * 16 + fr];
    } else {
#pragma unroll
        for (int ai = 0; ai < 2; ++ai)
#pragma unroll
            for (int m = 0; m < 4; ++m) { rs[ai][m] = rstd_row(rsq, pm * 256 + wr * 64 + fr + ai * 128 + m * 16) * scale; if (fq == 0) tab[(ai * 4 + m) * 16 + fr] = rs[ai][m]; }
        if (fq == 0 && fr == 0) *tag = pm;
    }
}

struct EpiUp {
    static constexpr bool PERM = true, MID = false; static constexpr int MID_T0 = -1, MID_T1 = -1;
    bf16* act; const u64* rsq; LAS unsigned char* lds;
    __device__ __forceinline__ void mid(f32x4 (&)[2][2][4][2], const pg8::Unit&, int, int, int, int, int) const {}
    __device__ __forceinline__ void operator()(const f32x4 (&acc)[2][2][4][2], const pg8::Unit& u, int wr, int wc, int fr, int fq) const {
        const int row0 = u.pm * 256 + wr * 64 + fr, col0 = u.pn * 128 + wc * 32 + 8 * fq;
        float rs8[2][4]; rstd8(rsq, lds, u.pm, wr, wc, fr, fq, 1.0f, rs8);
#pragma unroll
        for (int ai = 0; ai < 2; ++ai)
#pragma unroll
            for (int m = 0; m < 4; ++m) {
                const int row = row0 + ai * 128 + m * 16; const float rs = rs8[ai][m], rsl = rs * -1.44269504f, rs2 = rs * rs;
                unsigned wq[4];
#pragma unroll
                for (int n = 0; n < 2; ++n)
#pragma unroll
                    for (int j = 0; j < 4; j += 2) {
                        const f32x2v g2 = (f32x2v){acc[ai][0][m][n][j], acc[ai][0][m][n][j + 1]}, u2 = (f32x2v){acc[ai][1][m][n][j], acc[ai][1][m][n][j + 1]};
                        const f32x2v t2 = g2 * rsl; f32x2v e2 = (f32x2v){__builtin_amdgcn_exp2f(t2[0]), __builtin_amdgcn_exp2f(t2[1])}; e2 = e2 + 1.0f;
                        const f32x2v r2 = (f32x2v){__builtin_amdgcn_rcpf(e2[0]), __builtin_amdgcn_rcpf(e2[1])}; const f32x2v o2 = ((g2 * u2) * rs2) * r2;
                        wq[2 * n + (j >> 1)] = pg8::cvt_pk_bf16(o2[0], o2[1]);
                    }
                u32x4 w; w.x = wq[0]; w.y = wq[1]; w.z = wq[2]; w.w = wq[3];
                *(u32x4*)(act + (size_t)row * FF + col0) = w;
            }
    }
};
struct EpiNull {
    static constexpr bool PERM = true, MID = false; static constexpr int MID_T0 = -1, MID_T1 = -1;
    __device__ __forceinline__ void mid(f32x4 (&)[2][2][4][2], const pg8::Unit&, int, int, int, int, int) const {}
    __device__ __forceinline__ void operator()(const f32x4 (&acc)[2][2][4][2], const pg8::Unit&, int, int, int, int) const {
#pragma unroll
        for (int ai = 0; ai < 2; ++ai)
#pragma unroll
            for (int bj = 0; bj < 2; ++bj)
#pragma unroll
                for (int m = 0; m < 4; ++m) asm volatile("" :: "v"(acc[ai][bj][m][0]), "v"(acc[ai][bj][m][1]));
    }
};
template <int HALFSC, bool LAST = false, bool F8 = false> struct EpiRes {
    static constexpr bool PERM = true, MID = false; static constexpr int MID_T0 = -1, MID_T1 = -1;
    bf16* xh; unsigned char* xl; float* out; u64* rsq_next; unsigned char* x8 = nullptr;
    __device__ __forceinline__ void mid(f32x4 (&)[2][2][4][2], const pg8::Unit&, int, int, int, int, int) const {}
    __device__ __forceinline__ void operator()(const f32x4 (&acc)[2][2][4][2], const pg8::Unit& u, int wr, int wc, int fr, int fq) const {
        const float sc = HALFSC ? 0.5f : 1.0f;
        const int row0 = u.pm * 256 + wr * 64 + fr, col0 = u.pn * 256 + wc * 32 + 8 * fq;
        const char* xhb = (const char*)xh; const char* xlb = (const char*)xl; asm volatile("" : "+s"(xhb), "+s"(xlb));
        const unsigned e0 = (unsigned)row0 * (unsigned)D + (unsigned)col0;
        u32x4 xab[2][2][2]; u32x2 xcb[2][2][2];
#define EPIRES_ISSUE(ab_) do { _Pragma("unroll") for (int mm = 0; mm < 2; ++mm) _Pragma("unroll") for (int bj = 0; bj < 2; ++bj) { \
            const unsigned eo = e0 + (unsigned)((((ab_) >> 1) * 128 + (2 * ((ab_) & 1) + mm) * 16) * D + bj * 128); xab[(ab_) & 1][mm][bj] = *(const u32x4*)(xhb + (size_t)(2u * eo)); xcb[(ab_) & 1][mm][bj] = *(const u32x2*)(xlb + (size_t)eo); } } while (0)
        EPIRES_ISSUE(0);
#pragma unroll
        for (int ab = 0; ab < 4; ++ab) {
            const int ai = ab >> 1, m0 = 2 * (ab & 1);
            if (ab + 1 < 4) EPIRES_ISSUE(ab + 1);
            const u32x4 (&xa)[2][2] = xab[ab & 1]; const u32x2 (&xc)[2][2] = xcb[ab & 1];
#pragma unroll
            for (int mm = 0; mm < 2; ++mm) {
                const int m = m0 + mm, row = row0 + ai * 128 + m * 16; f32x2v ssq2 = (f32x2v){0.f, 0.f};
#pragma unroll
                for (int bj = 0; bj < 2; ++bj) {
                    const unsigned eo = e0 + (unsigned)((ai * 128 + m * 16) * D + bj * 128); const size_t o = (size_t)eo;
                    f32x2v v2[4];
                    { const f32x2v l2[4] = {__builtin_amdgcn_cvt_pk_f32_fp8((int)xc[mm][bj].x, false), __builtin_amdgcn_cvt_pk_f32_fp8((int)xc[mm][bj].x, true),
                                            __builtin_amdgcn_cvt_pk_f32_fp8((int)xc[mm][bj].y, false), __builtin_amdgcn_cvt_pk_f32_fp8((int)xc[mm][bj].y, true)};
#pragma unroll
                      for (int e = 0; e < 4; ++e) { const f32x2v a2 = (f32x2v){acc[ai][bj][m][e >> 1][2 * (e & 1)], acc[ai][bj][m][e >> 1][2 * (e & 1) + 1]}, h2 = (f32x2v){bf_lo(xa[mm][bj][e]), bf_hi(xa[mm][bj][e])};
                          v2[e] = a2 * sc + h2; v2[e] = l2[e] * (1.0f / 512.0f) + v2[e]; } }
                    if constexpr (LAST) { __builtin_nontemporal_store((f32x4){v2[0][0], v2[0][1], v2[1][0], v2[1][1]}, (f32x4*)(out + o)); __builtin_nontemporal_store((f32x4){v2[2][0], v2[2][1], v2[3][0], v2[3][1]}, (f32x4*)(out + o + 4)); }
                    else {
                        u32x4 wh; f32x2v lw2[4];
#pragma unroll
                        for (int e = 0; e < 4; ++e) { wh[e] = pg8::cvt_pk_bf16(v2[e][0], v2[e][1]); ssq2 = v2[e] * v2[e] + ssq2;
                            const f32x2v hn2 = (f32x2v){bf_lo(wh[e]), bf_hi(wh[e])}; lw2[e] = (v2[e] - hn2) * 512.0f; }
                        int wl0 = 0, wl1 = 0;
                        wl0 = __builtin_amdgcn_cvt_pk_fp8_f32(lw2[0][0], lw2[0][1], wl0, false); wl0 = __builtin_amdgcn_cvt_pk_fp8_f32(lw2[1][0], lw2[1][1], wl0, true);
                        wl1 = __builtin_amdgcn_cvt_pk_fp8_f32(lw2[2][0], lw2[2][1], wl1, false); wl1 = __builtin_amdgcn_cvt_pk_fp8_f32(lw2[3][0], lw2[3][1], wl1, true);
                        *(u32x4*)((char*)xhb + (size_t)(2u * eo)) = wh; { u32x2 wl; wl.x = (unsigned)wl0; wl.y = (unsigned)wl1; *(u32x2*)((char*)xlb + (size_t)eo) = wl; }
                        if constexpr (F8) { int w0 = 0, w1 = 0; w0 = __builtin_amdgcn_cvt_pk_fp8_f32(v2[0][0], v2[0][1], w0, false); w0 = __builtin_amdgcn_cvt_pk_fp8_f32(v2[1][0], v2[1][1], w0, true);
                            w1 = __builtin_amdgcn_cvt_pk_fp8_f32(v2[2][0], v2[2][1], w1, false); w1 = __builtin_amdgcn_cvt_pk_fp8_f32(v2[3][0], v2[3][1], w1, true); u32x2 w8; w8.x = (unsigned)w0; w8.y = (unsigned)w1; *(u32x2*)(x8 + o) = w8; }
                    }
                }
                if constexpr (!LAST) { float ssq = xrow16_sum(ssq2[0] + ssq2[1]);
                    if (fq == 0) __hip_atomic_fetch_add(rsq_next + row, (u64)(ssq * SSQ_SCALE), __ATOMIC_RELAXED, __HIP_MEMORY_SCOPE_AGENT); }
            }
        }
    }
};
#undef EPIRES_ISSUE
template <int MODE = 0> struct EpiInT {
    static constexpr bool PERM = true, MID = false; static constexpr int MID_T0 = -1, MID_T1 = -1;
    unsigned char* ws; const u64* rsq; const float* qkg; LAS unsigned char* lds;
    __device__ __forceinline__ void mid(f32x4 (&)[2][2][4][2], const pg8::Unit&, int, int, int, int, int) const {}
    __device__ __forceinline__ void operator()(const f32x4 (&acc)[2][2][4][2], const pg8::Unit& u, int wr, int wc, int fr, int fq) const {
        const int c = (MODE == 1) ? ((FP8_QA == 2 && u.pn >= 12) ? u.pn + 20 : u.pn + 12)
                    : (MODE == 2) ? (FP8_QA == 2 ? (u.pn < 24 ? u.pn + 36 : (u.pn < 36 ? u.pn - 24 : u.pn - 12)) : (u.pn >= 12 ? u.pn + 24 : u.pn)) : u.pn;
        size_t off; int ldc, lc, gi = -1; bool gate = false;
        if (c < 6) { off = WS_QA; ldc = 1536; lc = c; gi = 0; } else if (c < 12) { off = WS_KA; ldc = 1536; lc = c - 6; gi = 1; } else if (c < 18) { off = WS_VA; ldc = 1536; lc = c - 12; }
        else if (c < 22) { off = WS_QB; ldc = 1024; lc = c - 18; gi = 2; } else if (c == 22) { off = WS_KB; ldc = 256; lc = 0; gi = 3; } else if (c == 23) { off = WS_VB; ldc = 256; lc = 0; }
        else if (c < 28) { off = WS_QC; ldc = 1024; lc = c - 24; gi = 4; } else if (c < 32) { off = WS_KC; ldc = 1024; lc = c - 28; gi = 5; } else if (c < 36) { off = WS_VC; ldc = 1024; lc = c - 32; }
        else { off = WS_G; ldc = 6144; lc = c - 36; gate = true; }
        bf16* dst = (bf16*)(ws + off);
        const int row0 = u.pm * 256 + wr * 64 + fr, col0 = lc * 256 + wc * 32 + 8 * fq;
        float rs[2][4]; rstd8(rsq, lds, u.pm, wr, wc, fr, fq, MODE == 2 ? 1.0f / W8_SCALE : 1.0f, rs);
        if (QKN_IN_EPI && gi >= 0) {
            LAS float* T = (LAS float*)(lds + RING_BYTES + 512);
#pragma unroll
            for (int ai = 0; ai < 2; ++ai)
#pragma unroll
                for (int mp = 0; mp < 2; ++mp) {
                    float pv[4];
#pragma unroll
                    for (int k = 0; k < 4; ++k) {
                        const f32x4 a = acc[ai][k & 1][2 * mp + (k >> 1)][0], b = acc[ai][k & 1][2 * mp + (k >> 1)][1];
                        f32x2v q2 = (f32x2v){a[0], a[1]} * (f32x2v){a[0], a[1]}; q2 = (f32x2v){a[2], a[3]} * (f32x2v){a[2], a[3]} + q2;
                        q2 = (f32x2v){b[0], b[1]} * (f32x2v){b[0], b[1]} + q2; q2 = (f32x2v){b[2], b[3]} * (f32x2v){b[2], b[3]} + q2;
                        pv[k] = q2[0] + q2[1];
                    }
                    auto s0 = __builtin_amdgcn_permlane16_swap(__float_as_uint(pv[0]), __float_as_uint(pv[1]), false, false);
                    const float t0 = __uint_as_float(s0[0]) + __uint_as_float(s0[1]);
                    auto s1 = __builtin_amdgcn_permlane16_swap(__float_as_uint(pv[2]), __float_as_uint(pv[3]), false, false);
                    const float t1 = __uint_as_float(s1[0]) + __uint_as_float(s1[1]);
                    auto s2 = __builtin_amdgcn_permlane32_swap(__float_as_uint(t0), __float_as_uint(t1), false, false);
                    const float tot = __uint_as_float(s2[0]) + __uint_as_float(s2[1]);
                    T[((ai * 128 + wr * 64 + (2 * mp + (fq >> 1)) * 16 + fr) * 2 + (fq & 1)) * 4 + wc] = tot;
                }
            asm volatile("s_waitcnt lgkmcnt(0)" ::: "memory"); __builtin_amdgcn_s_barrier(); asm volatile("" ::: "memory");
            const f32x4 g0 = *(const f32x4*)(qkg + gi * 128 + wc * 32 + 8 * fq), g1 = *(const f32x4*)(qkg + gi * 128 + wc * 32 + 8 * fq + 4);
#pragma unroll
            for (int ai = 0; ai < 2; ++ai)
#pragma unroll
                for (int m = 0; m < 4; ++m) {
                    const int row = row0 + ai * 128 + m * 16;
#pragma unroll
                    for (int bj = 0; bj < 2; ++bj) {
                        const f32x4 t = *(const LAS f32x4*)(T + ((ai * 128 + wr * 64 + m * 16 + fr) * 2 + bj) * 4);
                        const float sc = rs[ai][m] * rsqrtf(((t[0] + t[1]) + (t[2] + t[3])) * (rs[ai][m] * rs[ai][m] * (1.0f / 128.0f)) + EPS);
                        const f32x4 a = acc[ai][bj][m][0] * sc * g0, b = acc[ai][bj][m][1] * sc * g1;
                        u32x4 w; w.x = pg8::cvt_pk_bf16(a[0], a[1]); w.y = pg8::cvt_pk_bf16(a[2], a[3]); w.z = pg8::cvt_pk_bf16(b[0], b[1]); w.w = pg8::cvt_pk_bf16(b[2], b[3]);
                        *(u32x4*)(dst + (size_t)row * ldc + col0 + bj * 128) = w;
                    }
                }
            return;
        }
        if (gate) {
            unsigned char* g8 = ws + WS_G; const float C255 = sconst(0x437f0000u);
#pragma unroll
            for (int ai = 0; ai < 2; ++ai)
#pragma unroll
                for (int m = 0; m < 4; ++m) {
                    const int row = row0 + ai * 128 + m * 16; const float rl = rs[ai][m] * -1.44269504f;
#pragma unroll
                    for (int bj = 0; bj < 2; ++bj) {
                        unsigned wq[2];
#pragma unroll
                        for (int n = 0; n < 2; ++n) {
                            unsigned wv = 0u;
#pragma unroll
                            for (int j = 0; j < 4; j += 2) {
                                const f32x2v a2 = (f32x2v){acc[ai][bj][m][n][j], acc[ai][bj][m][n][j + 1]}; const f32x2v t2 = a2 * rl;
                                f32x2v e2 = (f32x2v){__builtin_amdgcn_exp2f(t2[0]), __builtin_amdgcn_exp2f(t2[1])}; e2 = e2 + 1.0f;
                                const f32x2v s2 = (f32x2v){__builtin_amdgcn_rcpf(e2[0]), __builtin_amdgcn_rcpf(e2[1])}; const f32x2v q2 = s2 * C255 + 0.5f;
                                wv |= (unsigned)fmaxf(q2[0], 1.0f) << (8 * j); wv |= (unsigned)fmaxf(q2[1], 1.0f) << (8 * j + 8);
                            }
                            wq[n] = wv;
                        }
                        u32x2 w; w.x = wq[0]; w.y = wq[1];
                        *(u32x2*)(g8 + (size_t)row * 6144 + col0 + bj * 128) = w;
                    }
                }
            return;
        }
#pragma unroll
        for (int ai = 0; ai < 2; ++ai)
#pragma unroll
            for (int m = 0; m < 4; ++m) {
                const int row = row0 + ai * 128 + m * 16; const float r_ = rs[ai][m];
#pragma unroll
                for (int bj = 0; bj < 2; ++bj) {
                    const f32x4 a = acc[ai][bj][m][0] * r_, b = acc[ai][bj][m][1] * r_;
                    u32x4 w; w.x = pg8::cvt_pk_bf16(a[0], a[1]); w.y = pg8::cvt_pk_bf16(a[2], a[3]); w.z = pg8::cvt_pk_bf16(b[0], b[1]); w.w = pg8::cvt_pk_bf16(b[2], b[3]);
                    *(u32x4*)(dst + (size_t)row * ldc + col0 + bj * 128) = w;
                }
            }
    }
};
typedef EpiInT<0> EpiIn;
struct EpiIn8 {
    static constexpr bool PERM = true, MID = false; static constexpr int MID_T0 = -1, MID_T1 = -1;
    unsigned char* ws; const u64* rsq; const float* qkg; LAS unsigned char* lds;
    __device__ __forceinline__ void mid(f32x4 (&)[2][2][4][2], const pg8::Unit&, int, int, int, int, int) const {}
    __device__ __forceinline__ void operator()(const f32x4 (&acc)[2][2][4][2], const pg8::Unit& u, int wr, int wc, int fr, int fq) const {
        const int c = u.pn; size_t off = WS_QA; int ldc = 1536, lc = c, gi = 0;
        if (c < 6) { off = WS_QA; ldc = 1536; lc = c; gi = 0; } else if (c < 12) { off = WS_KA; ldc = 1536; lc = c - 6; gi = 1; }
        else if (c < 16) { off = WS_QB; ldc = 1024; lc = c - 12; gi = 2; } else if (c == 16) { off = WS_KB; ldc = 256; lc = 0; gi = 3; }
        else if (c < 21) { off = WS_QC; ldc = 1024; lc = c - 17; gi = 4; } else if (c < 25) { off = WS_KC; ldc = 1024; lc = c - 21; gi = 5; }
        asm volatile("" : "+v"(fr), "+v"(fq));
        const int row0 = u.pm * 256 + wr * 64 + fr;
        float rs[2][4];
#pragma unroll
        for (int ai = 0; ai < 2; ++ai)
#pragma unroll
            for (int m = 0; m < 4; ++m) rs[ai][m] = rstd_row(rsq, row0 + ai * 128 + m * 16) * (1.0f / W8_SCALE);
        if (c >= 25) {
            unsigned char* g8 = ws + WS_G; const float C255 = sconst(0x437f0000u); const int col0 = (c - 25) * 256 + wc * 32 + 8 * fq;
#pragma unroll
            for (int ai = 0; ai < 2; ++ai)
#pragma unroll
                for (int m = 0; m < 4; ++m) {
                    const int row = row0 + ai * 128 + m * 16; const float r_ = rs[ai][m];
#pragma unroll
                    for (int bj = 0; bj < 2; ++bj) {
                        u32x2 w; w.x = 0u; w.y = 0u;
#pragma unroll
                        for (int j = 0; j < 4; ++j) {
                            const float qa = fminf(fmaxf(sigmoidf_(acc[ai][bj][m][0][j] * r_) * C255 + 0.5f, 1.0f), C255), qb = fminf(fmaxf(sigmoidf_(acc[ai][bj][m][1][j] * r_) * C255 + 0.5f, 1.0f), C255);
                            w.x |= (unsigned)qa << (8 * j); w.y |= (unsigned)qb << (8 * j);
                        }
                        *(u32x2*)(g8 + (size_t)row * 6144 + col0 + bj * 128) = w;
                    }
                }
            return;
        }
        bf16* dst = (bf16*)(ws + off); const int col0 = lc * 256 + wc * 32 + 8 * fq;
        LAS float* T = (LAS float*)(lds + RING_BYTES + 512);
#pragma unroll
        for (int ai = 0; ai < 2; ++ai)
#pragma unroll
            for (int m = 0; m < 4; ++m)
#pragma unroll
                for (int bj = 0; bj < 2; ++bj) {
                    const f32x4 a = acc[ai][bj][m][0], b = acc[ai][bj][m][1];
                    float p = ((a[0] * a[0] + a[1] * a[1]) + (a[2] * a[2] + a[3] * a[3])) + ((b[0] * b[0] + b[1] * b[1]) + (b[2] * b[2] + b[3] * b[3]));
                    p *= rs[ai][m] * rs[ai][m];
                    p = xrow16_sum(p);
                    if (fq == 0) T[((ai * 128 + wr * 64 + m * 16 + fr) * 2 + bj) * 4 + wc] = p;
                }
        asm volatile("s_waitcnt lgkmcnt(0)" ::: "memory"); __builtin_amdgcn_s_barrier(); asm volatile("" ::: "memory");
        const f32x4 g0 = *(const f32x4*)(qkg + gi * 128 + wc * 32 + 8 * fq), g1 = *(const f32x4*)(qkg + gi * 128 + wc * 32 + 8 * fq + 4);
#pragma unroll
        for (int ai = 0; ai < 2; ++ai)
#pragma unroll
            for (int m = 0; m < 4; ++m) {
                const int row = row0 + ai * 128 + m * 16;
#pragma unroll
                for (int bj = 0; bj < 2; ++bj) {
                    const f32x4 t = *(const LAS f32x4*)(T + ((ai * 128 + wr * 64 + m * 16 + fr) * 2 + bj) * 4);
                    const float sc = rs[ai][m] * rsqrtf(((t[0] + t[1]) + (t[2] + t[3])) * (1.0f / 128.0f) + EPS);
                    const f32x4 a = acc[ai][bj][m][0] * sc * g0, b = acc[ai][bj][m][1] * sc * g1;
                    u32x4 w; w.x = pg8::cvt_pk_bf16(a[0], a[1]); w.y = pg8::cvt_pk_bf16(a[2], a[3]); w.z = pg8::cvt_pk_bf16(b[0], b[1]); w.w = pg8::cvt_pk_bf16(b[2], b[3]);
                    *(u32x4*)(dst + (size_t)row * ldc + col0 + bj * 128) = w;
                }
            }
    }
};
struct EpiV {
    static constexpr bool PERM = true, MID = false; static constexpr int MID_T0 = -1, MID_T1 = -1;
    unsigned char* ws; const u64* rsq;
    __device__ __forceinline__ void mid(f32x4 (&)[2][2][4][2], const pg8::Unit&, int, int, int, int, int) const {}
    __device__ __forceinline__ void operator()(const f32x4 (&acc)[2][2][4][2], const pg8::Unit& u, int wr, int wc, int fr, int fq) const {
        const int c = u.pn; size_t off = WS_VA; int ldc = 1536, lc = c;
        if (c < 6) { off = WS_VA; ldc = 1536; lc = c; } else if (c == 6) { off = WS_VB; ldc = 256; lc = 0; } else { off = WS_VC; ldc = 1024; lc = c - 7; }
        bf16* dst = (bf16*)(ws + off);
        const int row0 = u.pm * 256 + wr * 64 + fr, col0 = lc * 256 + wc * 32 + 8 * fq;
#pragma unroll
        for (int ai = 0; ai < 2; ++ai)
#pragma unroll
            for (int m = 0; m < 4; ++m) {
                const int row = row0 + ai * 128 + m * 16; const float r_ = rstd_row(rsq, row);
#pragma unroll
                for (int bj = 0; bj < 2; ++bj) {
                    const f32x4 a = acc[ai][bj][m][0] * r_, b = acc[ai][bj][m][1] * r_;
                    u32x4 w; w.x = pg8::cvt_pk_bf16(a[0], a[1]); w.y = pg8::cvt_pk_bf16(a[2], a[3]); w.z = pg8::cvt_pk_bf16(b[0], b[1]); w.w = pg8::cvt_pk_bf16(b[2], b[3]);
                    *(u32x4*)(dst + (size_t)row * ldc + col0 + bj * 128) = w;
                }
            }
    }
};
struct EpiGate {
    static constexpr bool PERM = true, MID = false; static constexpr int MID_T0 = -1, MID_T1 = -1;
    unsigned char* g8; const u64* rsq; LAS unsigned char* lds;
    __device__ __forceinline__ void mid(f32x4 (&)[2][2][4][2], const pg8::Unit&, int, int, int, int, int) const {}
    __device__ __forceinline__ void operator()(const f32x4 (&acc)[2][2][4][2], const pg8::Unit& u, int wr, int wc, int fr, int fq) const {
        const int row0 = u.pm * 256 + wr * 64 + fr, col0 = u.pn * 256 + wc * 32 + 8 * fq; const float C255 = sconst(0x437f0000u);
        float rs8[2][4]; rstd8(rsq, lds, u.pm, wr, wc, fr, fq, 1.0f / W8_SCALE, rs8);
#pragma unroll
        for (int ai = 0; ai < 2; ++ai)
#pragma unroll
            for (int m = 0; m < 4; ++m) {
                const int row = row0 + ai * 128 + m * 16; const float rl = rs8[ai][m] * -1.44269504f;
#pragma unroll
                for (int bj = 0; bj < 2; ++bj) {
                    unsigned wq[2];
#pragma unroll
                    for (int n = 0; n < 2; ++n) {
                        unsigned wv = 0u;
#pragma unroll
                        for (int j = 0; j < 4; j += 2) {
                            const f32x2v a2 = (f32x2v){acc[ai][bj][m][n][j], acc[ai][bj][m][n][j + 1]}; const f32x2v t2 = a2 * rl;
                            f32x2v e2 = (f32x2v){__builtin_amdgcn_exp2f(t2[0]), __builtin_amdgcn_exp2f(t2[1])}; e2 = e2 + 1.0f;
                            const f32x2v s2 = (f32x2v){__builtin_amdgcn_rcpf(e2[0]), __builtin_amdgcn_rcpf(e2[1])}; const f32x2v q2 = s2 * C255 + 0.5f;
                            wv |= (unsigned)fmaxf(q2[0], 1.0f) << (8 * j); wv |= (unsigned)fmaxf(q2[1], 1.0f) << (8 * j + 8);
                        }
                        wq[n] = wv;
                    }
                    u32x2 w; w.x = wq[0]; w.y = wq[1];
                    *(u32x2*)(g8 + (size_t)row * 6144 + col0 + bj * 128) = w;
                }
            }
    }
};
struct EpiBr {
    static constexpr bool PERM = true, MID = true; static constexpr int MID_T0 = 8, MID_T1 = 24;
    const unsigned char* G; bf16* z;
    __device__ __forceinline__ void mid(f32x4 (&acc)[2][2][4][2], const pg8::Unit& u, int t, int wr, int wc, int fr, int fq) const {
        const unsigned char* ga = G + (t == MID_T0 ? 0 : 2048);
        int frx = fr, fqx = fq; asm volatile("" : "+v"(frx), "+v"(fqx));
        const int row0 = u.pm * 256 + wr * 64 + frx, col0 = u.pn * 256 + wc * 32 + 8 * fqx;
        const unsigned char* gab = ga; asm volatile("" : "+s"(gab));
        const unsigned o0 = (unsigned)row0 * 6144u + (unsigned)col0;
        u32x2 na[2][4][2], nb[2][4][2];
#pragma unroll
        for (int ai = 0; ai < 2; ++ai)
#pragma unroll
            for (int m = 0; m < 4; ++m)
#pragma unroll
                for (int bj = 0; bj < 2; ++bj) { const unsigned o = o0 + (unsigned)((ai * 128 + m * 16) * 6144 + bj * 128); na[ai][m][bj] = *(const u32x2*)(gab + (size_t)o); nb[ai][m][bj] = *(const u32x2*)(gab + (size_t)(o + 2048u)); }
#pragma unroll
        for (int ai = 0; ai < 2; ++ai)
#pragma unroll
            for (int m = 0; m < 4; ++m)
#pragma unroll
                for (int bj = 0; bj < 2; ++bj)
#pragma unroll
                    for (int n = 0; n < 2; ++n)
#pragma unroll
                        for (int j = 0; j < 4; j += 2) {
                            const f32x2v a2 = (f32x2v){(float)((na[ai][m][bj][n] >> (8 * j)) & 0xffu), (float)((na[ai][m][bj][n] >> (8 * j + 8)) & 0xffu)};
                            const f32x2v r2 = (f32x2v){__builtin_amdgcn_rcpf((float)((nb[ai][m][bj][n] >> (8 * j)) & 0xffu)), __builtin_amdgcn_rcpf((float)((nb[ai][m][bj][n] >> (8 * j + 8)) & 0xffu))};
                            const f32x2v v2 = (f32x2v){acc[ai][bj][m][n][j], acc[ai][bj][m][n][j + 1]} * (a2 * r2);
                            acc[ai][bj][m][n][j] = v2[0]; acc[ai][bj][m][n][j + 1] = v2[1];
                        }
    }
    __device__ __forceinline__ void operator()(const f32x4 (&acc)[2][2][4][2], const pg8::Unit& u, int wr, int wc, int fr, int fq) const {
        const int row0 = u.pm * 256 + wr * 64 + fr, col0 = u.pn * 256 + wc * 32 + 8 * fq;
#pragma unroll
        for (int ai = 0; ai < 2; ++ai)
#pragma unroll
            for (int m = 0; m < 4; ++m) {
                const int row = row0 + ai * 128 + m * 16;
#pragma unroll
                for (int bj = 0; bj < 2; ++bj) {
                    const u32x2 ng = *(const u32x2*)(G + (size_t)row * 6144 + 4096 + col0 + bj * 128);
                    float o[8];
#pragma unroll
                    for (int n = 0; n < 2; ++n)
#pragma unroll
                        for (int j = 0; j < 4; ++j) o[4 * n + j] = acc[ai][bj][m][n][j] * ((float)((ng[n] >> (8 * j)) & 0xffu) * (1.0f / 255.0f));
                    u32x4 w; w.x = pg8::cvt_pk_bf16(o[0], o[1]); w.y = pg8::cvt_pk_bf16(o[2], o[3]); w.z = pg8::cvt_pk_bf16(o[4], o[5]); w.w = pg8::cvt_pk_bf16(o[6], o[7]);
                    *(u32x4*)(z + (size_t)row * D + col0 + bj * 128) = w;
                }
            }
    }
};

__device__ __forceinline__ void cvt_item(const float* __restrict__ W, int N, const float* __restrict__ scale, bf16* dst, int dpitch, int dcol, int mode, int kb, int nb, LAS unsigned* T, int lane) {
    const int k0 = kb * 64, n0 = nb * 64, kpl = lane >> 4, n4 = (lane & 15) * 4;
    f32x4 r0[8], r1[8];
#pragma unroll
    for (int i = 0; i < 8; ++i) { const int k = k0 + 2 * (4 * i + kpl); r0[i] = __builtin_nontemporal_load((const f32x4*)(W + (size_t)k * N + n0 + n4)); r1[i] = __builtin_nontemporal_load((const f32x4*)(W + (size_t)(k + 1) * N + n0 + n4)); }
#pragma unroll
    for (int i = 0; i < 8; ++i) { const int kp = 4 * i + kpl, k = k0 + 2 * kp; const float s0 = scale ? scale[k] : 1.f, s1 = scale ? scale[k + 1] : 1.f;
#pragma unroll
        for (int j = 0; j < 4; ++j) T[(n4 + j) * 33 + kp] = pk2(r0[i][j] * s0, r1[i][j] * s1); }
    LDS_WAIT(); asm volatile("" ::: "memory");
    const int q = lane & 7;
#pragma unroll
    for (int i = 0; i < 8; ++i) { const int n = 8 * i + (lane >> 3); const LAS unsigned* s = T + n * 33 + 4 * q;
        u32x4 o; o.x = s[0]; o.y = s[1]; o.z = s[2]; o.w = s[3];
        const int c = n0 + n; int drow = c;
        if (mode == 1) { drow = (c < FF) ? (256 * (c >> 7) + (c & 127)) : (256 * ((c - FF) >> 7) + 128 + ((c - FF) & 127)); }
        __builtin_nontemporal_store(o, (u32x4*)(dst + (size_t)drow * dpitch + dcol + k0 + 8 * q)); }
    LDS_WAIT(); asm volatile("" ::: "memory");
}

__device__ __forceinline__ void cvt_item_fp8(const float* __restrict__ W, int N, const float* __restrict__ scale, unsigned char* dst, int K, int ncol0, int kb, int nb, LAS unsigned* T, int lane) {
    const int k0 = kb * 64, n0 = nb * 64, kql = lane >> 4, n4 = (lane & 15) * 4;
#pragma unroll
    for (int ih = 0; ih < 2; ++ih) {
        f32x4 r[2][4];
#pragma unroll
        for (int i = 0; i < 2; ++i)
#pragma unroll
            for (int e = 0; e < 4; ++e) r[i][e] = __builtin_nontemporal_load((const f32x4*)(W + (size_t)(k0 + 4 * (4 * (2 * ih + i) + kql) + e) * N + ncol0 + n0 + n4));
#pragma unroll
        for (int i = 0; i < 2; ++i) { const int kq = 4 * (2 * ih + i) + kql, k = k0 + 4 * kq; const f32x4 sc = *(const f32x4*)(scale + k) * W8_SCALE;
#pragma unroll
            for (int j = 0; j < 4; ++j) { int w = 0; w = __builtin_amdgcn_cvt_pk_fp8_f32(r[i][0][j] * sc[0], r[i][1][j] * sc[1], w, false); w = __builtin_amdgcn_cvt_pk_fp8_f32(r[i][2][j] * sc[2], r[i][3][j] * sc[3], w, true);
                T[(n4 + j) * 17 + kq] = (unsigned)w; } }
    }
    LDS_WAIT(); asm volatile("" ::: "memory");
    const int q = lane & 3;
#pragma unroll
    for (int i = 0; i < 4; ++i) { const int n = 16 * i + (lane >> 2); const LAS unsigned* sp = T + n * 17 + 4 * q;
        u32x4 o; o.x = sp[0]; o.y = sp[1]; o.z = sp[2]; o.w = sp[3];
        __builtin_nontemporal_store(o, (u32x4*)(dst + (size_t)(n0 + n) * K + k0 + 16 * q)); }
    LDS_WAIT(); asm volatile("" ::: "memory");
}

struct Args { const float* in[18]; float* out; unsigned char* ws; int ph_lo, ph_hi; };
typedef const __attribute__((address_space(4))) Args* KArgs;

__device__ __forceinline__ void prologue(KArgs a, LAS unsigned char* lds, int gw, int NGW, int wave, int lane) {
    LAS unsigned* T = (LAS unsigned*)(lds + wave * 16384);
    constexpr int I0 = 32 * 176, I1 = 88 * 32, I2Q = 32 * 144, I2 = FP8_GATES ? 32 * 144 + 32 * 96 : 32 * 240, I3 = 8 * 32, I4 = 16 * 32, I5 = 16 * 32, I6 = 32 * 32, PER = 2 * I0 + 2 * I1 + I2 + I3 + I4 + I5 + I6;
    for (int it = gw; it < DEPTH * PER; it += NGW) {
        const int l = it / PER; int r = it % PER; unsigned char* wl = a->ws + WS_W + (size_t)l * W_LAYER;
        if (r < I0) { cvt_item(a->in[4] + (size_t)l * D * 2 * FF, 2 * FF, a->in[3] + l * D, (bf16*)(wl + W_1A), D, 0, 1, r / 176, r % 176, T, lane); continue; } r -= I0;
        if (r < I1) { cvt_item(a->in[5] + (size_t)l * FF * D, D, nullptr, (bf16*)(wl + W_1B), FF, 0, 0, r / 32, r % 32, T, lane); continue; } r -= I1;
        if (FP8_GATES && FP8_QK) {
            if (r < 32 * 196) { const int kb = r / 196, nb = r % 196, d0 = 64 * nb; const int off = d0 < 3072 ? 0 : (d0 < 4352 ? 1536 : (d0 < 6400 ? 1792 : 2816));
                cvt_item_fp8(a->in[7] + (size_t)l * D * NIN, NIN, a->in[6] + l * D, wl + W_IN8, D, off, kb, nb, T, lane); continue; }
            if (r < I2) { const int rr = r - 32 * 196, kb = rr / 44, nb = rr % 44, d0 = 64 * nb; const int off = d0 < 1536 ? 3072 : (d0 < 1792 ? 4352 : 6400);
                cvt_item(a->in[7] + (size_t)l * D * NIN + off, NIN, a->in[6] + l * D, (bf16*)(wl + W_IN), D, 0, 0, kb, nb, T, lane); continue; }
            r -= I2;
        } else if (FP8_GATES) {
            if (FP8_QA) {
                if (FP8_QA == 2) {
                    if (r < 32 * 64) { const int nbl = r % 64; cvt_item(a->in[7] + (size_t)l * D * NIN + (nbl < 48 ? 0 : 2048), NIN, a->in[6] + l * D, (bf16*)(wl + W_IN), D, 0, 0, r / 64, 48 + nbl, T, lane); continue; }
                    if (r < I2) { const int rr = r - 32 * 64, nb = rr % 176; cvt_item_fp8(a->in[7] + (size_t)l * D * NIN, NIN, a->in[6] + l * D, wl + W_IN8, D, nb < 96 ? 9216 : (nb < 144 ? -6144 : -3072), rr / 176, nb, T, lane); continue; }
                }
                if (r < 32 * 96) { cvt_item(a->in[7] + (size_t)l * D * NIN, NIN, a->in[6] + l * D, (bf16*)(wl + W_IN), D, 0, 0, r / 96, 48 + r % 96, T, lane); continue; }
                if (r < I2) { const int rr = r - 32 * 96, nb = rr % 144; cvt_item_fp8(a->in[7] + (size_t)l * D * NIN, NIN, a->in[6] + l * D, wl + W_IN8, D, nb < 48 ? 0 : 6144, rr / 144, nb, T, lane); continue; }
            } else {
            if (r < I2Q) { cvt_item(a->in[7] + (size_t)l * D * NIN, NIN, a->in[6] + l * D, (bf16*)(wl + W_IN), D, 0, 0, r / 144, r % 144, T, lane); continue; }
            if (r < I2) { const int rr = r - I2Q; cvt_item_fp8(a->in[7] + (size_t)l * D * NIN, NIN, a->in[6] + l * D, wl + W_IN8, D, 9216, rr / 96, rr % 96, T, lane); continue; }
            }
            r -= I2;
        } else { if (r < I2) { cvt_item(a->in[7] + (size_t)l * D * NIN, NIN, a->in[6] + l * D, (bf16*)(wl + W_IN), D, 0, 0, r / 240, r % 240, T, lane); continue; } r -= I2; }
        if (r < I3) { cvt_item(a->in[11] + (size_t)l * 512 * D, D, nullptr, (bf16*)(wl + W_BR), KBR, 0, 0, r / 32, r % 32, T, lane); continue; } r -= I3;
        if (r < I4) { cvt_item(a->in[12] + (size_t)l * 1024 * D, D, nullptr, (bf16*)(wl + W_BR), KBR, 512, 0, r / 32, r % 32, T, lane); continue; } r -= I4;
        if (r < I5) { cvt_item(a->in[13] + (size_t)l * 1024 * D, D, nullptr, (bf16*)(wl + W_BR), KBR, 1536, 0, r / 32, r % 32, T, lane); continue; } r -= I5;
        if (r < I6) { cvt_item(a->in[14] + (size_t)l * D * D, D, nullptr, (bf16*)(wl + W_O), D, 0, 0, r / 32, r % 32, T, lane); continue; } r -= I6;
        if (r < I0) { cvt_item(a->in[16] + (size_t)l * D * 2 * FF, 2 * FF, a->in[15] + l * D, (bf16*)(wl + W_2A), D, 0, 1, r / 176, r % 176, T, lane); continue; } r -= I0;
        cvt_item(a->in[17] + (size_t)l * FF * D, D, nullptr, (bf16*)(wl + W_2B), FF, 0, 0, r / 32, r % 32, T, lane);
    }
    u64* rsq0 = (u64*)(a->ws + WS_RSQ); bf16* xb = (bf16*)(a->ws + WS_XB); unsigned char* xl = a->ws + WS_XL;
    for (int row = gw; row < M; row += NGW) {
        const float* src = row < 8192 ? a->in[0] + (size_t)row * D : a->in[1] + (size_t)(row - 8192) * D;
        f32x4 v[8]; float s = 0.f;
#pragma unroll
        for (int j = 0; j < 8; ++j) { v[j] = __builtin_nontemporal_load((const f32x4*)(src + 256 * j + 4 * lane)); s += (v[j][0] * v[j][0] + v[j][1] * v[j][1]) + (v[j][2] * v[j][2] + v[j][3] * v[j][3]); }
#pragma unroll
        for (int j = 0; j < 8; ++j) {
            u32x2 w; w.x = pk2(v[j][0], v[j][1]); w.y = pk2(v[j][2], v[j][3]); *(u32x2*)(xb + (size_t)row * D + 256 * j + 4 * lane) = w;
            int wl = 0; wl = __builtin_amdgcn_cvt_pk_fp8_f32((v[j][0] - bf_lo(w.x)) * 512.0f, (v[j][1] - bf_hi(w.x)) * 512.0f, wl, false); wl = __builtin_amdgcn_cvt_pk_fp8_f32((v[j][2] - bf_lo(w.y)) * 512.0f, (v[j][3] - bf_hi(w.y)) * 512.0f, wl, true);
            *(unsigned*)(xl + (size_t)row * D + 256 * j + 4 * lane) = (unsigned)wl; }
        s = wave_sum(s);
        if (lane == 0) rsq0[row] = (u64)(s * SSQ_SCALE);
    }
}

__device__ __forceinline__ int t5_bucket_dev(int rel) {
    const int n = rel < 0 ? -rel : rel; int b;
    if (n < 8) b = n; else b = 8 + (n >= 15) + (n >= 27) + (n >= 50) + (n >= 91) + (n >= 166) + (n >= 305) + (n >= 559);
    return b + (rel > 0 ? 16 : 0);
}
__device__ __forceinline__ void seq_of(int row, int& base, int& L) { if (row < 8192) { base = 0; L = 8192; } else if (row < 12288) { base = 8192; L = 4096; } else { base = 12288; L = 4096; } }

__device__ __forceinline__ void qknorm_phase(unsigned char* ws, const float* qk_norm, int l, int gw, int NGW, int lane) {
    const float* qkg = qk_norm + (size_t)l * 6 * 128;
    for (int it = gw; it < M * 50; it += NGW) {
        const int row = it / 50, s = it % 50; size_t off; int ldc, h, gi;
        if (s < 12) { off = WS_QA; ldc = 1536; h = s; gi = 0; } else if (s < 24) { off = WS_KA; ldc = 1536; h = s - 12; gi = 1; }
        else if (s < 32) { off = WS_QB; ldc = 1024; h = s - 24; gi = 2; } else if (s < 34) { off = WS_KB; ldc = 256; h = s - 32; gi = 3; }
        else if (s < 42) { off = WS_QC; ldc = 1024; h = s - 34; gi = 4; } else { off = WS_KC; ldc = 1024; h = s - 42; gi = 5; }
        unsigned* p = (unsigned*)((bf16*)(ws + off) + (size_t)row * ldc + h * 128) + lane;
        const unsigned w = *p; const float v0 = bf_lo(w), v1 = bf_hi(w);
        const float ss = wave_sum(v0 * v0 + v1 * v1);
        const float r = rsqrtf(ss * (1.0f / 128.0f) + EPS);
        *p = pk2(v0 * r * qkg[gi * 128 + 2 * lane], v1 * r * qkg[gi * 128 + 2 * lane + 1]);
    }
}

__device__ __forceinline__ void attn_naive_phase(unsigned char* ws, const float* relb, const float* sink_all, const float* rpb_all, int l, LAS unsigned char* lds, int gw, int NGW, int wave, int lane) {
    LAS unsigned char* tab = lds + 8192;
    for (int n = wave * 64 + lane; n <= 1024; n += NWAVES * 64) tab[n] = (unsigned char)t5_bucket_dev(-n);
    __syncthreads();
    LAS float* pl = (LAS float*)(lds + wave * 16384); LAS int* tl = (LAS int*)(lds + wave * 16384 + 2048);
    const float* sink = sink_all + l * 8; const float* rpb = rpb_all + (size_t)l * 8 * 15 * 31;
    for (int it = gw; it < 28 * M; it += NGW) {
        const int h28 = it / M, row = it % M; int base, L; seq_of(row, base, L); const int t = row - base;
        if ((FAST_MASK >> (h28 < 12 ? 0 : (h28 < 20 ? 1 : 2))) & 1) continue;
        const bf16 *Q, *Kp, *Vp; int ldq, ldk, qoff, koff, nslots, type, g = 0, hh = 0, d = 1;
        if (h28 < 12) { type = 0; g = h28 >> 2; hh = h28 & 3; d = (g == 0) ? 1 : (g == 1 ? 4 : 16); Q = (const bf16*)(ws + WS_QA); Kp = (const bf16*)(ws + WS_KA); Vp = (const bf16*)(ws + WS_VA); ldq = 1536; ldk = 1536; qoff = h28 * 128; koff = h28 * 128; nslots = 129; }
        else if (h28 < 20) { type = 1; hh = h28 - 12; Q = (const bf16*)(ws + WS_QB); Kp = (const bf16*)(ws + WS_KB); Vp = (const bf16*)(ws + WS_VB); ldq = 1024; ldk = 256; qoff = hh * 128; koff = (hh >> 2) * 128; nslots = 257; }
        else { type = 2; hh = h28 - 20; Q = (const bf16*)(ws + WS_QC); Kp = (const bf16*)(ws + WS_KC); Vp = (const bf16*)(ws + WS_VC); ldq = 1024; ldk = 1024; qoff = hh * 128; koff = hh * 128; nslots = 128; }
        const int rows = L >> 6, r = t >> 6, c = t & 63; int rs = r - 4; rs = rs < 0 ? 0 : (rs > rows - 8 ? rows - 8 : rs); int qs = c - 8; qs = qs < 0 ? 0 : (qs > 48 ? 48 : qs);
        const bf16* qp = Q + (size_t)row * ldq + qoff;
        float mx = -1e30f;
#pragma unroll 1
        for (int j = lane; j < nslots; j += 64) {
            bool valid = true; int tk = t; float bias = 0.f;
            if (type == 0) { const int rel = (j - 64) * d; tk = t + rel; valid = tk >= 0 && tk < L; const int n = rel < 0 ? -rel : rel; bias = relb[((int)tab[n] + (rel > 0 ? 16 : 0)) * 20 + h28]; }
            else if (type == 1) { const int rel = j - 128; tk = t + rel; valid = tk >= 0 && tk < L; const int n = rel < 0 ? -rel : rel; bias = relb[((int)tab[n] + (rel > 0 ? 16 : 0)) * 20 + 12 + hh]; }
            else { const int kr = rs + (j >> 4), kc = qs + (j & 15); tk = kr * 64 + kc; bias = rpb[(hh * 15 + (kr - r + 7)) * 31 + (kc - c + 15)]; }
            if (!valid) tk = t;
            float dot = 0.f; const bf16* kp = Kp + (size_t)(base + tk) * ldk + koff;
#pragma unroll 4
            for (int ch = 0; ch < 16; ++ch) { const u32x4 kv = *(const u32x4*)(kp + 8 * ch); const u32x4 qv = *(const u32x4*)(qp + 8 * ch);
#pragma unroll
                for (int e = 0; e < 4; ++e) dot += bf_lo(qv[e]) * bf_lo(kv[e]) + bf_hi(qv[e]) * bf_hi(kv[e]); }
            const float sc = valid ? dot * 0.08838834764831845f + bias : -1e30f;
            mx = fmaxf(mx, sc);
            pl[j] = sc; tl[j] = tk;
        }
        mx = wave_max(mx);
        if (type == 1) mx = fmaxf(mx, sink[hh]);
        float den = 0.f;
#pragma unroll 1
        for (int j = lane; j < nslots; j += 64) { const float sc = pl[j]; const float p = (sc > -1e29f) ? __expf(sc - mx) : 0.f; den += p; pl[j] = p; }
        den = wave_sum(den);
        if (type == 1) den += __expf(sink[hh] - mx);
        LDS_WAIT(); asm volatile("" ::: "memory");
        float o0 = 0.f, o1 = 0.f;
#pragma unroll 4
        for (int j = 0; j < nslots; ++j) { const float p = pl[j]; const int tk = tl[j];
            const unsigned w = *(const unsigned*)(Vp + (size_t)(base + tk) * ldk + koff + 2 * lane); o0 += p * bf_lo(w); o1 += p * bf_hi(w); }
        const float inv = 1.0f / den; o0 *= inv; o1 *= inv;
        if (type == 0) { *(unsigned*)((bf16*)(ws + WS_OAG) + ((size_t)g * M + row) * 512 + hh * 128 + 2 * lane) = pk2(o0, o1);
            if (lane == 0) ((float*)(ws + WS_LSE))[((size_t)g * M + row) * 4 + hh] = mx + __logf(den); }
        else { *(unsigned*)((bf16*)(ws + WS_O) + (size_t)row * KBR + (type == 1 ? 512 : 1536) + hh * 128 + 2 * lane) = pk2(o0, o1); }
        LDS_WAIT(); asm volatile("" ::: "memory");
    }
}
__device__ __forceinline__ void combine_phase(unsigned char* ws, int gw, int NGW, int lane) {
    const float* lse = (const float*)(ws + WS_LSE); const bf16* oag = (const bf16*)(ws + WS_OAG); bf16* O = (bf16*)(ws + WS_O);
    const int hh = lane >> 4;
    const bool panel = LOCAL_SEAMS && gridDim.x == 256u; const int c_ = (int)blockIdx.x;
    const int rbase = panel ? (8 * (c_ % 8) + (c_ / 8) % 8) * 256 + (c_ / 64) * 64 + (gw & (NWAVES - 1)) : gw, rstep = panel ? NWAVES : NGW, rend = panel ? rbase + 64 : M;
    for (int row = rbase; row < rend; row += rstep) {
        const float l0 = lse[((size_t)0 * M + row) * 4 + hh], l1 = lse[((size_t)1 * M + row) * 4 + hh], l2 = lse[((size_t)2 * M + row) * 4 + hh];
        const u32x4 a0 = *(const u32x4*)(oag + ((size_t)0 * M + row) * 512 + 8 * lane), a1 = *(const u32x4*)(oag + ((size_t)1 * M + row) * 512 + 8 * lane), a2 = *(const u32x4*)(oag + ((size_t)2 * M + row) * 512 + 8 * lane);
        const float mx = fmaxf(l0, fmaxf(l1, l2)); float w0 = __expf(l0 - mx), w1 = __expf(l1 - mx), w2 = __expf(l2 - mx); const float inv = 1.0f / (w0 + w1 + w2); w0 *= inv; w1 *= inv; w2 *= inv;
        u32x4 o;
#pragma unroll
        for (int e = 0; e < 4; ++e) o[e] = pk2(w0 * bf_lo(a0[e]) + w1 * bf_lo(a1[e]) + w2 * bf_lo(a2[e]), w0 * bf_hi(a0[e]) + w1 * bf_hi(a1[e]) + w2 * bf_hi(a2[e]));
        *(u32x4*)(O + (size_t)row * KBR + 8 * lane) = o;
    }
}

__device__ __forceinline__ int vcu_of() { const int G = gridDim.x, bx = blockIdx.x; return (G % 8 == 0) ? (bx % 8) * (G / 8) + bx / 8 : bx; }
typedef short v4i16_t __attribute__((ext_vector_type(4)));
typedef pg8::bf16x8 bf16x8;
constexpr int AT_TAB_OFF = RING_BYTES + 512;
constexpr int AT_BIAS_OFF = RING_BYTES + 2048;
static_assert(AT_BIAS_OFF + 1152 * 4 <= LDS_BYTES, "attention LDS map");
__device__ __forceinline__ unsigned off_b(unsigned row, unsigned ch) { return 256u * row + 16u * (ch ^ (((row & 3u) << 2) | ((row >> 2) & 3u))); }
__device__ __forceinline__ int clampi(int v, int lo, int hi) { return v < lo ? lo : (v > hi ? hi : v); }

struct TokLin { int base, pos0, d, r, lim; __device__ __forceinline__ bool operator()(int s, int& row) const { const int p = pos0 + s; row = base + p * d + r; return p >= 0 && p < lim; } };
struct TokGrid { int base, rlo, cs; __device__ __forceinline__ bool operator()(int s, int& row) const { row = base + (rlo + (s >> 5)) * 64 + cs + (s & 31); return true; } };

#define WG_SYNC() do { asm volatile("s_waitcnt lgkmcnt(0)" ::: "memory"); __builtin_amdgcn_s_barrier(); asm volatile("" ::: "memory"); } while (0)
constexpr int AT_GAIN_OFF = AT_BIAS_OFF + 1152 * 4;
static_assert(AT_GAIN_OFF + 768 * 4 <= LDS_BYTES, "attention LDS map");
template <int NPASS, class TokF>
__device__ __forceinline__ unsigned stage_load(const bf16* P, int ld, int npass, int tid, const TokF tokf, u32x4 (&v)[NPASS]) {
    const int ch = tid & 15, sl = tid >> 4; unsigned okm = 0u;
#pragma unroll
    for (int i = 0; i < NPASS; ++i) { v[i] = (u32x4){0u, 0u, 0u, 0u}; if (i < npass) { int row; const bool ok = tokf(sl + 32 * i, row); row = ok ? row : tokf.base; okm |= ok ? (1u << i) : 0u;
            v[i] = *(const u32x4*)(P + (size_t)row * ld + 8 * ch); } }
    return okm;
}
template <int NPASS, bool NORM>
__device__ __forceinline__ void stage_store(LAS unsigned char* lds, int npass, const LAS float* gain, int tid, const u32x4 (&v)[NPASS], unsigned okm) {
    const int ch = tid & 15, sl = tid >> 4;
    float gn[8];
    if (NORM) { const f32x4 a = *(const LAS f32x4*)(gain + 8 * ch), b = *(const LAS f32x4*)(gain + 8 * ch + 4); gn[0] = a[0]; gn[1] = a[1]; gn[2] = a[2]; gn[3] = a[3]; gn[4] = b[0]; gn[5] = b[1]; gn[6] = b[2]; gn[7] = b[3]; }
#pragma unroll
    for (int i = 0; i < NPASS; ++i) if (i < npass) {
        const bool ok = (okm >> i) & 1u;
        u32x4 w; w.x = ok ? v[i].x : 0u; w.y = ok ? v[i].y : 0u; w.z = ok ? v[i].z : 0u; w.w = ok ? v[i].w : 0u;
        if (NORM) {
            float f[8]; float ss = 0.f;
#pragma unroll
            for (int e = 0; e < 4; ++e) { f[2 * e] = bf_lo(w[e]); f[2 * e + 1] = bf_hi(w[e]); ss += f[2 * e] * f[2 * e] + f[2 * e + 1] * f[2 * e + 1]; }
            ss += __shfl_xor(ss, 1); ss += __shfl_xor(ss, 2); ss += __shfl_xor(ss, 4); ss += __shfl_xor(ss, 8);
            const float rs = rsqrtf(ss * (1.0f / 128.0f) + EPS);
#pragma unroll
            for (int e = 0; e < 4; ++e) w[e] = pg8::cvt_pk_bf16(f[2 * e] * rs * gn[2 * e], f[2 * e + 1] * rs * gn[2 * e + 1]);
        }
        *(LAS u32x4*)(lds + off_b((unsigned)(sl + 32 * i), (unsigned)ch)) = w;
    }
}
__device__ __forceinline__ void q_issue(const bf16* qrow, int g4, u32x4 (&raw)[4]) {
#pragma unroll
    for (int ks = 0; ks < 4; ++ks) raw[ks] = *(const u32x4*)(qrow + 32 * ks + 8 * g4);
}
template <bool NORM>
__device__ __forceinline__ void q_finish(u32x4 (&raw)[4], const LAS float* gq, int g4, bf16x8 (&qf)[4]) {
    if (NORM) {
        float ss = 0.f;
#pragma unroll
        for (int ks = 0; ks < 4; ++ks)
#pragma unroll
            for (int e = 0; e < 4; ++e) { const float a = bf_lo(raw[ks][e]), b = bf_hi(raw[ks][e]); ss += a * a + b * b; }
        ss = xrow16_sum(ss);
        const float rs = rsqrtf(ss * (1.0f / 128.0f) + EPS);
#pragma unroll
        for (int ks = 0; ks < 4; ++ks) { const f32x4 ga = *(const LAS f32x4*)(gq + 32 * ks + 8 * g4), gb = *(const LAS f32x4*)(gq + 32 * ks + 8 * g4 + 4);
            raw[ks][0] = pg8::cvt_pk_bf16(bf_lo(raw[ks][0]) * rs * ga[0], bf_hi(raw[ks][0]) * rs * ga[1]); raw[ks][1] = pg8::cvt_pk_bf16(bf_lo(raw[ks][1]) * rs * ga[2], bf_hi(raw[ks][1]) * rs * ga[3]);
            raw[ks][2] = pg8::cvt_pk_bf16(bf_lo(raw[ks][2]) * rs * gb[0], bf_hi(raw[ks][2]) * rs * gb[1]); raw[ks][3] = pg8::cvt_pk_bf16(bf_lo(raw[ks][3]) * rs * gb[2], bf_hi(raw[ks][3]) * rs * gb[3]); }
    }
#pragma unroll
    for (int ks = 0; ks < 4; ++ks) qf[ks] = __builtin_bit_cast(bf16x8, raw[ks]);
}
constexpr float QK_SCALE = 0.08838834764831845f;
constexpr float LOG2E = 1.4426950408889634f, LN2 = 0.6931471805599453f;
constexpr float QK_SCALE2 = QK_SCALE * LOG2E;
template <int NT, int NB>
__device__ __forceinline__ void st_tiles(LAS unsigned char* lds, int slot0, const bf16x8 (&qf)[4], int lane, f32x4 (&S)[NT]) {
    const unsigned i = lane & 15, g4 = lane >> 4;
    unsigned ko[4];
#pragma unroll
    for (int ks = 0; ks < 4; ++ks) ko[ks] = off_b(i, 4u * ks + g4);
    LAS unsigned char* base = lds + 256 * slot0;
    bf16x8 a[NB][4];
#pragma unroll
    for (int kk = 0; kk < NB - 1 && kk < NT; ++kk)
#pragma unroll
        for (int ks = 0; ks < 4; ++ks) a[kk % NB][ks] = *(const LAS bf16x8*)(base + 4096 * kk + ko[ks]);
#pragma unroll
    for (int kk = 0; kk < NT; ++kk) {
        if (kk + NB - 1 < NT) {
#pragma unroll
            for (int ks = 0; ks < 4; ++ks) a[(kk + NB - 1) % NB][ks] = *(const LAS bf16x8*)(base + 4096 * (kk + NB - 1) + ko[ks]);
        }
        __builtin_amdgcn_sched_barrier(0);
        f32x4 acc = (f32x4){0.f, 0.f, 0.f, 0.f};
#pragma unroll
        for (int ks = 0; ks < 4; ++ks) acc = __builtin_amdgcn_mfma_f32_16x16x32_bf16(a[kk % NB][ks], qf[ks], acc, 0, 0, 0);
        S[kk] = acc;
        __builtin_amdgcn_sched_barrier(0);
    }
}
template <int NT>
__device__ __forceinline__ void softmax_pack(f32x4 (&S)[NT], float extra, bf16x8 (&P)[(NT + 1) / 2], float& inv_l, float& lse) {
    float m = extra;
#pragma unroll
    for (int kk = 0; kk < NT; ++kk) m = fmaxf(m, fmaxf(fmaxf(S[kk][0], S[kk][1]), fmaxf(S[kk][2], S[kk][3])));
    m = xrow16_max(m);
    float l = 0.f;
#pragma unroll
    for (int kk = 0; kk < NT; ++kk)
#pragma unroll
        for (int r = 0; r < 4; ++r) { const float p = __builtin_amdgcn_exp2f(S[kk][r] - m); S[kk][r] = p; l += p; }
    l = xrow16_sum(l);
    l += __builtin_amdgcn_exp2f(extra - m);
    inv_l = 1.0f / l; lse = (m + __log2f(l)) * LN2;
#pragma unroll
    for (int s = 0; s < (NT + 1) / 2; ++s) {
        u32x4 w; w.x = pg8::cvt_pk_bf16(S[2 * s][0], S[2 * s][1]); w.y = pg8::cvt_pk_bf16(S[2 * s][2], S[2 * s][3]);
        if (2 * s + 1 < NT) { w.z = pg8::cvt_pk_bf16(S[2 * s + 1][0], S[2 * s + 1][1]); w.w = pg8::cvt_pk_bf16(S[2 * s + 1][2], S[2 * s + 1][3]); } else { w.z = 0u; w.w = 0u; }
        P[s] = __builtin_bit_cast(bf16x8, w);
    }
}
template <int NT, int NB>
__device__ __forceinline__ void pv_tile(LAS unsigned char* lds, int slot0, const bf16x8 (&P)[(NT + 1) / 2], int lane, f32x4 (&O)[8]) {
    constexpr int NK = (NT + 1) / 2;
    const unsigned g4 = lane >> 4, qq = (lane & 15) >> 2, p = lane & 3, rl = 4 * g4 + qq;
    unsigned vo[8];
#pragma unroll
    for (int c = 0; c < 8; ++c) vo[c] = off_b(rl, 2u * c + (p >> 1)) + 8u * (p & 1);
    LAS unsigned char* base = lds + 256 * slot0;
#pragma unroll
    for (int c = 0; c < 8; ++c) O[c] = (f32x4){0.f, 0.f, 0.f, 0.f};
    v4i16_t lo[NB][8], hi[NB][8];
    if (NB == 2) {
#pragma unroll
        for (int c = 0; c < 8; ++c) { lo[0][c] = __builtin_amdgcn_ds_read_tr16_b64_v4i16((LAS v4i16_t*)(base + vo[c])); hi[0][c] = __builtin_amdgcn_ds_read_tr16_b64_v4i16((LAS v4i16_t*)(base + 4096 * ((1 < NT) ? 1 : 0) + vo[c])); }
    }
#pragma unroll
    for (int s = 0; s < NK; ++s) {
        const int sl = (NB == 2) ? s + 1 : s, bi = (NB == 2) ? ((s + 1) & 1) : 0;
        if (sl < NK) {
            const int t0 = 2 * sl, t1 = (2 * sl + 1 < NT) ? 2 * sl + 1 : NT - 1;
#pragma unroll
            for (int c = 0; c < 8; ++c) { lo[bi][c] = __builtin_amdgcn_ds_read_tr16_b64_v4i16((LAS v4i16_t*)(base + 4096 * t0 + vo[c])); hi[bi][c] = __builtin_amdgcn_ds_read_tr16_b64_v4i16((LAS v4i16_t*)(base + 4096 * t1 + vo[c])); }
        }
        __builtin_amdgcn_sched_barrier(0);
#pragma unroll
        for (int c = 0; c < 8; ++c) {
            const bf16x8 a = __builtin_shufflevector(lo[(NB == 2) ? (s & 1) : 0][c], hi[(NB == 2) ? (s & 1) : 0][c], 0, 1, 2, 3, 4, 5, 6, 7);
            O[c] = __builtin_amdgcn_mfma_f32_16x16x32_bf16(a, P[s], O[c], 0, 0, 0);
        }
        __builtin_amdgcn_sched_barrier(0);
    }
}
__device__ __forceinline__ void store_o(bf16* orow, const f32x4 (&O)[8], float inv_l, int g4) {
#pragma unroll
    for (int c = 0; c < 8; ++c) { u32x2 w; w.x = pg8::cvt_pk_bf16(O[c][0] * inv_l, O[c][1] * inv_l); w.y = pg8::cvt_pk_bf16(O[c][2] * inv_l, O[c][3] * inv_l); *(u32x2*)(orow + 16 * c + 4 * g4) = w; }
}


constexpr int NU_A = 1536, NU_B = 512, NU_C = 1024;

struct DescA { int head12, g, hh, d, base, Ls, r, qb, pos0; };
__device__ __forceinline__ DescA decode_A(int u) {
    DescA D_; const int part = u >= 768, uu = part ? u - 768 : u; D_.head12 = uu >> 6; int rem = uu & 63;
    D_.g = D_.head12 >> 2; D_.hh = D_.head12 & 3; D_.d = (D_.g == 0) ? 1 : (D_.g == 1 ? 4 : 16);
    int L = 8192, nbq = 64 / D_.d; D_.base = 0;
    if (part) { const int seq = rem >> 5; rem &= 31; D_.base = 8192 + 4096 * seq; L = 4096; nbq = 32 / D_.d; }
    D_.r = rem / nbq; D_.qb = rem % nbq; D_.Ls = L / D_.d; D_.pos0 = 128 * D_.qb - 64; return D_;
}
__device__ __forceinline__ void run_A(unsigned char* ws, const float* relb, LAS unsigned char* lds, int u0, int u1, int wave_s) {
    if (u0 >= u1) return;
    LAS float* bv = (LAS float*)(lds + AT_BIAS_OFF); LAS unsigned char* tab = lds + AT_TAB_OFF; const LAS float* gains = (const LAS float*)(lds + AT_GAIN_OFF);
    LAS unsigned char* ldsv = lds + 65536;
    DescA d = decode_A(u0);
    u32x4 kreg[8], vreg[8], qraw[4]; unsigned kok, vok; int bias_head = -1;
    { const int tid = tid_of(wave_s), lane = tid & 63, wave = __builtin_amdgcn_readfirstlane(tid >> 6); const TokLin tk{d.base, d.pos0, d.d, d.r, d.Ls};
      const int qrow = d.base + (128 * d.qb + 16 * wave + (lane & 15)) * d.d + d.r;
      q_issue((const bf16*)(ws + WS_QA) + (size_t)qrow * 1536 + d.head12 * 128, lane >> 4, qraw);
      kok = stage_load<8>((const bf16*)(ws + WS_KA) + d.head12 * 128, 1536, 8, tid, tk, kreg);
      vok = stage_load<8>((const bf16*)(ws + WS_VA) + d.head12 * 128, 1536, 8, tid, tk, vreg); }
    for (int u = u0; u < u1; ++u) {
        const int tid = tid_of(wave_s), lane = tid & 63, wave = __builtin_amdgcn_readfirstlane(tid >> 6), q = lane & 15, g4 = lane >> 4;
        const float NEGINF = sconst(0xf149f2cau);
        if (d.head12 != bias_head) {
            if (tid < 160) { const int dl = tid - 80; float b = NEGINF; if (dl >= -64 && dl <= 64) { const int rel = dl * d.d, n = rel < 0 ? -rel : rel; b = relb[((int)tab[n] + (rel > 0 ? 16 : 0)) * 20 + d.head12] * LOG2E; } bv[tid] = b; }
            bias_head = d.head12; }
        stage_store<8, NORM_ON_LOAD != 0>(lds, 8, gains + 128, tid, kreg, kok);
        stage_store<8, false>(ldsv, 8, nullptr, tid, vreg, vok);
        const int qrow = d.base + (128 * d.qb + 16 * wave + q) * d.d + d.r;
        bf16x8 qf[4]; q_finish<NORM_ON_LOAD != 0>(qraw, gains, g4, qf);
        DescA dn = d;
        if (u + 1 < u1) { dn = decode_A(u + 1); const TokLin tkn{dn.base, dn.pos0, dn.d, dn.r, dn.Ls};
            const int qrn = dn.base + (128 * dn.qb + 16 * wave + q) * dn.d + dn.r;
            q_issue((const bf16*)(ws + WS_QA) + (size_t)qrn * 1536 + dn.head12 * 128, g4, qraw);
            kok = stage_load<8>((const bf16*)(ws + WS_KA) + dn.head12 * 128, 1536, 8, tid, tkn, kreg);
            vok = stage_load<8>((const bf16*)(ws + WS_VA) + dn.head12 * 128, 1536, 8, tid, tkn, vreg); }
        WG_SYNC();
        f32x4 S[9]; st_tiles<9, 3>(lds, 16 * wave, qf, lane, S);
        const LAS float* bvq = bv + (4 * g4 - q + 16);
        if (d.pos0 >= 0 && d.pos0 + 256 <= d.Ls) {
#pragma unroll
            for (int kk = 0; kk < 9; ++kk)
#pragma unroll
                for (int rr = 0; rr < 4; ++rr) S[kk][rr] = S[kk][rr] * QK_SCALE2 + bvq[16 * kk + rr];
        } else {
#pragma unroll
            for (int kk = 0; kk < 9; ++kk)
#pragma unroll
                for (int rr = 0; rr < 4; ++rr) {
                    const int p = d.pos0 + 16 * (wave + kk) + 4 * g4 + rr;
                    const bool ok = p >= 0 && p < d.Ls;
                    { const float sb = S[kk][rr] * QK_SCALE2 + bvq[16 * kk + rr]; S[kk][rr] = ok ? sb : NEGINF; }
                }
        }
        bf16x8 P[5]; float inv_l, lse; softmax_pack<9>(S, NEGINF, P, inv_l, lse);
        f32x4 O[8]; pv_tile<9, 2>(ldsv, 16 * wave, P, lane, O);
        store_o((bf16*)(ws + WS_OAG) + ((size_t)d.g * M + qrow) * 512 + d.hh * 128, O, inv_l, g4);
        if (g4 == 0) ((float*)(ws + WS_LSE))[((size_t)d.g * M + qrow) * 4 + d.hh] = lse;
        WG_SYNC();
        d = dn;
    }
}
struct DescB { int kvh, base, L, qb, pos0; };
__device__ __forceinline__ DescB decode_B(int u) {
    DescB D_; const int part = u >= 256, uu = part ? u - 256 : u; D_.kvh = uu >> 7; const int rem = uu & 127;
    D_.base = 0; D_.L = 8192; D_.qb = rem;
    if (part) { const int seq = rem >> 6; D_.qb = rem & 63; D_.base = 8192 + 4096 * seq; D_.L = 4096; }
    D_.pos0 = 64 * D_.qb - 128; return D_;
}
__device__ __forceinline__ void run_B(unsigned char* ws, const float* relb, const float* sinkl, LAS unsigned char* lds, int u0, int u1, int wave_s) {
    if (u0 >= u1) return;
    LAS float* bv = (LAS float*)(lds + AT_BIAS_OFF); LAS unsigned char* tab = lds + AT_TAB_OFF; const LAS float* gains = (const LAS float*)(lds + AT_GAIN_OFF);
    DescB d = decode_B(u0);
    u32x4 kreg[10], qraw0[4]; unsigned kok; int bias_kvh = -1;
    { const int tid = tid_of(wave_s), lane = tid & 63, wave = __builtin_amdgcn_readfirstlane(tid >> 6); const TokLin tk{d.base, d.pos0, 1, 0, d.L};
      const int qrow0 = d.base + 64 * d.qb + 32 * (wave >> 2) + (lane & 15);
      q_issue((const bf16*)(ws + WS_QB) + (size_t)qrow0 * 1024 + (4 * d.kvh + (wave & 3)) * 128, lane >> 4, qraw0);
      kok = stage_load<10>((const bf16*)(ws + WS_KB) + d.kvh * 128, 256, 10, tid, tk, kreg); }
    for (int u = u0; u < u1; ++u) {
        const int tid = tid_of(wave_s), lane = tid & 63, wave = __builtin_amdgcn_readfirstlane(tid >> 6), q = lane & 15, g4 = lane >> 4;
        const int hl = wave & 3, hq = 4 * d.kvh + hl;
        const TokLin tokf{d.base, d.pos0, 1, 0, d.L}; const float NEGINF = sconst(0xf149f2cau);
        if (d.kvh != bias_kvh) {
            for (int e = tid; e < 1152; e += NWAVES * 64) { const int h = e / 288, dl = e % 288 - 144; float b = NEGINF; if (dl >= -128 && dl <= 128) { const int n = dl < 0 ? -dl : dl; b = relb[((int)tab[n] + (dl > 0 ? 16 : 0)) * 20 + 12 + 4 * d.kvh + h] * LOG2E; } bv[e] = b; }
            bias_kvh = d.kvh; }
        stage_store<10, NORM_ON_LOAD != 0>(lds, 10, gains + 3 * 128, tid, kreg, kok);
        const int tq0 = 2 * (wave >> 2), qrow0 = d.base + 64 * d.qb + 16 * tq0 + q;
        const bf16* qbase = (const bf16*)(ws + WS_QB) + hq * 128;
        u32x4 qraw1[4]; q_issue(qbase + (size_t)(qrow0 + 16) * 1024, g4, qraw1);
        const float snk = sinkl[hq] * LOG2E;
        WG_SYNC();
        bf16x8 P[2][9]; float inv_l[2];
#pragma unroll
        for (int tt = 0; tt < 2; ++tt) {
            const int tq = tq0 + tt;
            bf16x8 qf[4];
            if (tt == 0) q_finish<NORM_ON_LOAD != 0>(qraw0, gains + 2 * 128, g4, qf); else q_finish<NORM_ON_LOAD != 0>(qraw1, gains + 2 * 128, g4, qf);
            f32x4 S[17]; st_tiles<17, 3>(lds, 16 * tq, qf, lane, S);
            const LAS float* bvq = bv + hl * 288 + (4 * g4 - q + 16);
            if (d.pos0 >= 0 && d.pos0 + 320 <= d.L) {
#pragma unroll
                for (int kk = 0; kk < 17; ++kk)
#pragma unroll
                    for (int rr = 0; rr < 4; ++rr) S[kk][rr] = S[kk][rr] * QK_SCALE2 + bvq[16 * kk + rr];
            } else {
#pragma unroll
                for (int kk = 0; kk < 17; ++kk)
#pragma unroll
                    for (int rr = 0; rr < 4; ++rr) {
                        const int p = d.pos0 + 16 * (tq + kk) + 4 * g4 + rr;
                        const bool ok = p >= 0 && p < d.L;
                        { const float sb = S[kk][rr] * QK_SCALE2 + bvq[16 * kk + rr]; S[kk][rr] = ok ? sb : NEGINF; }
                    }
            }
            float lse; softmax_pack<17>(S, snk, P[tt], inv_l[tt], lse);
            if (tt == 0) asm volatile("" ::: "memory");
        }
        WG_SYNC();
        { u32x4 vreg[10]; const unsigned vok = stage_load<10>((const bf16*)(ws + WS_VB) + d.kvh * 128, 256, 10, tid, tokf, vreg); stage_store<10, false>(lds, 10, nullptr, tid, vreg, vok); }
        DescB dn = d;
        if (u + 1 < u1) { dn = decode_B(u + 1); const TokLin tkn{dn.base, dn.pos0, 1, 0, dn.L};
            q_issue((const bf16*)(ws + WS_QB) + (size_t)(dn.base + 64 * dn.qb + 16 * tq0 + q) * 1024 + (4 * dn.kvh + hl) * 128, g4, qraw0);
            kok = stage_load<10>((const bf16*)(ws + WS_KB) + dn.kvh * 128, 256, 10, tid, tkn, kreg); }
        WG_SYNC();
#pragma unroll
        for (int tt = 0; tt < 2; ++tt) {
            const int tq = tq0 + tt, qrow = qrow0 + 16 * tt;
            f32x4 O[8]; pv_tile<17, 1>(lds, 16 * tq, P[tt], lane, O);
            store_o((bf16*)(ws + WS_O) + (size_t)qrow * KBR + 512 + hq * 128, O, inv_l[tt], g4);
        }
        WG_SYNC();
        d = dn;
    }
}
struct DescC { int h, base, rows, cb, r0, rlo, nrows, cs; };
__device__ __forceinline__ DescC decode_C(int u) {
    DescC D_; const int part = u >= 512, uu = part ? u - 512 : u; D_.h = uu >> 6; int rem = uu & 63;
    D_.base = 0; D_.rows = 128; D_.cb = rem >> 4; int rb = rem & 15;
    if (part) { const int seq = rem >> 5; rem &= 31; D_.base = 8192 + 4096 * seq; D_.rows = 64; D_.cb = rem >> 3; rb = rem & 7; }
    D_.r0 = 8 * rb; D_.rlo = clampi(D_.r0 - 4, 0, D_.rows - 8); const int rhi = clampi(D_.r0 + 3, 0, D_.rows - 8) + 7; D_.nrows = rhi - D_.rlo + 1; D_.cs = clampi(16 * D_.cb - 8, 0, 32); return D_;
}
__device__ __forceinline__ void run_C(unsigned char* ws, const float* rpbl, LAS unsigned char* lds, int u0, int u1, int wave_s) {
    if (u0 >= u1) return;
    LAS float* bv = (LAS float*)(lds + AT_BIAS_OFF); const LAS float* gains = (const LAS float*)(lds + AT_GAIN_OFF);
    DescC d = decode_C(u0);
    u32x4 kreg[15], qraw[4]; unsigned kok; int bias_h = -1;
    { const int tid = tid_of(wave_s), lane = tid & 63, wave = __builtin_amdgcn_readfirstlane(tid >> 6); const TokGrid tk{d.base, d.rlo, d.cs};
      const int qrow = d.base + (d.r0 + wave) * 64 + 16 * d.cb + (lane & 15);
      q_issue((const bf16*)(ws + WS_QC) + (size_t)qrow * 1024 + d.h * 128, lane >> 4, qraw);
      kok = stage_load<15>((const bf16*)(ws + WS_KC) + d.h * 128, 1024, d.nrows, tid, tk, kreg); }
    for (int u = u0; u < u1; ++u) {
        const int tid = tid_of(wave_s), lane = tid & 63, wave = __builtin_amdgcn_readfirstlane(tid >> 6), q = lane & 15, g4 = lane >> 4;
        const TokGrid tokf{d.base, d.rlo, d.cs}; const float NEGINF = sconst(0xf149f2cau);
        if (d.h != bias_h) { if (tid < 465) bv[tid] = rpbl[d.h * 465 + tid] * LOG2E; bias_h = d.h; }
        stage_store<15, NORM_ON_LOAD != 0>(lds, d.nrows, gains + 5 * 128, tid, kreg, kok);
        const int r = d.r0 + wave, rsw = clampi(r - 4, 0, d.rows - 8), c = 16 * d.cb + q, qs = clampi(c - 8, 0, 48), qrow = d.base + r * 64 + c;
        WG_SYNC();
        bf16x8 qf[4]; q_finish<NORM_ON_LOAD != 0>(qraw, gains + 4 * 128, g4, qf);
        f32x4 S[16]; st_tiles<16, 3>(lds, 32 * (rsw - d.rlo), qf, lane, S);
#pragma unroll
        for (int kk = 0; kk < 16; ++kk)
#pragma unroll
            for (int rr = 0; rr < 4; ++rr) {
                const int kc = d.cs + 16 * (kk & 1) + 4 * g4 + rr, dr = rsw + (kk >> 1) - r, dc = kc - c;
                const bool ok = kc >= qs && kc < qs + 16;
                { const float sb = S[kk][rr] * QK_SCALE2 + bv[(dr + 7) * 31 + clampi(dc + 15, 0, 30)]; S[kk][rr] = ok ? sb : NEGINF; }
            }
        bf16x8 P[8]; float inv_l, lse; softmax_pack<16>(S, NEGINF, P, inv_l, lse);
        WG_SYNC();
        { u32x4 vreg[15]; const unsigned vok = stage_load<15>((const bf16*)(ws + WS_VC) + d.h * 128, 1024, d.nrows, tid, tokf, vreg); stage_store<15, false>(lds, d.nrows, nullptr, tid, vreg, vok); }
        DescC dn = d;
        if (u + 1 < u1) { dn = decode_C(u + 1); const TokGrid tkn{dn.base, dn.rlo, dn.cs};
            q_issue((const bf16*)(ws + WS_QC) + (size_t)(dn.base + (dn.r0 + wave) * 64 + 16 * dn.cb + q) * 1024 + dn.h * 128, g4, qraw);
            kok = stage_load<15>((const bf16*)(ws + WS_KC) + dn.h * 128, 1024, dn.nrows, tid, tkn, kreg); }
        WG_SYNC();
        f32x4 O[8]; pv_tile<16, 2>(lds, 32 * (rsw - d.rlo), P, lane, O);
        store_o((bf16*)(ws + WS_O) + (size_t)qrow * KBR + 1536 + d.h * 128, O, inv_l, g4);
        WG_SYNC();
        d = dn;
    }
}
__device__ __forceinline__ void attn_fast_phase(unsigned char* ws, const float* relb, const float* qk_norm, const float* sink_all, const float* rpb_all, int l, LAS unsigned char* lds, int wave_s) {
    { const int tid = tid_of(wave_s); LAS unsigned char* tab = lds + AT_TAB_OFF; LAS float* gains = (LAS float*)(lds + AT_GAIN_OFF);
      for (int n = tid; n <= 1024; n += NWAVES * 64) tab[n] = (unsigned char)t5_bucket_dev(-n);
      for (int n = tid; n < 768; n += NWAVES * 64) gains[n] = qk_norm[(size_t)l * 768 + n]; }
    __syncthreads();
    const float* sinkl = sink_all + l * 8; const float* rpbl = rpb_all + (size_t)l * 8 * 465;
    const int G = gridDim.x, vcu = vcu_of();
    if (FAST_MASK & 4) { const int per = (NU_C + G - 1) / G, u0 = vcu * per, u1 = (u0 + per < NU_C) ? u0 + per : NU_C; run_C(ws, rpbl, lds, u0, u1, wave_s); if ((PROBE_DUP >> 13) & 1) run_C(ws, rpbl, lds, u0, u1, wave_s); }
    if (FAST_MASK & 2) { const int per = (NU_B + G - 1) / G, u0 = vcu * per, u1 = (u0 + per < NU_B) ? u0 + per : NU_B; run_B(ws, relb, sinkl, lds, u0, u1, wave_s); if ((PROBE_DUP >> 12) & 1) run_B(ws, relb, sinkl, lds, u0, u1, wave_s); }
    if (FAST_MASK & 1) { const int per = (NU_A + G - 1) / G, u0 = vcu * per, u1 = (u0 + per < NU_A) ? u0 + per : NU_A; run_A(ws, relb, lds, u0, u1, wave_s); if ((PROBE_DUP >> 11) & 1) run_A(ws, relb, lds, u0, u1, wave_s); }
}

constexpr int NP = 10;
enum { PH_UP1 = 0, PH_DN1, PH_IN, PH_QKN, PH_ATT, PH_CMB, PH_BR, PH_OUT, PH_UP2, PH_DN2 };
constexpr int NPH = 1 + DEPTH * NP;

__device__ __forceinline__ KArgs kargs() { u64 p = (u64)__builtin_amdgcn_kernarg_segment_ptr(); asm volatile("" : "+s"(p)); return (KArgs)p; }

#define OTID() tid_of(wave_s)
#define IN(k) (lo <= (k) && (k) < hi)
#define SEAM(k) do { if (ONE_LAUNCH && IN(k) && IN((k) + 1)) { XcdBarrier b_; b_.bar = (unsigned*)(kargs()->ws + WS_CTL) + CW_BAR; b_.x = xb_xcc_id(); b_.st = (volatile LAS unsigned*)(lds + MISC_OFF) + 8; xcd_barrier(b_, OTID()); if ((PROBE_DUP >> 7) & 1) xcd_barrier(b_, OTID()); } } while (0)
#define LSEAM(k) do { if (ONE_LAUNCH && IN(k) && IN((k) + 1)) { const unsigned bad_ = (unsigned)__builtin_amdgcn_readfirstlane((int)((volatile LAS unsigned*)(lds + MISC_OFF))[12]); \
    if (LOCAL_SEAMS && bad_ == 0u) grp_barrier((unsigned*)(kargs()->ws + WS_CTL) + CW_BAR, OTID()); \
    else { XcdBarrier b_; b_.bar = (unsigned*)(kargs()->ws + WS_CTL) + CW_BAR; b_.x = xb_xcc_id(); b_.st = (volatile LAS unsigned*)(lds + MISC_OFF) + 8; xcd_barrier(b_, OTID()); } } } while (0)
#define TIDS() const int tid = OTID(), lane = tid & 63, wave = __builtin_amdgcn_readfirstlane(tid >> 6); const int gw = vcu_of() * NWAVES + wave, NGW = (int)gridDim.x * NWAVES; (void)lane; (void)gw; (void)NGW
template <int L_>
__device__ __forceinline__ void layer_body(const int lo, const int hi, LAS unsigned char* lds, const int wave_s) {
    constexpr int l = L_;

        const int g0 = 1 + l * NP;
        for (int rep = 0; rep <= ((PROBE_DUP >> 1) & 1); ++rep)
        if (IN(g0 + PH_UP1)) {
            KArgs ka = kargs(); unsigned char* ws = ka->ws; unsigned char* wl = ws + WS_W + (size_t)l * W_LAYER;
            pg8::Gemm g{(const bf16*)(ws + WS_XB), (const bf16*)(wl + W_1A), M, 2 * FF, D}; pg8::StaticOrder S; S.init(M, 2 * FF, (int)gridDim.x, (int)blockIdx.x);
            rstd_cache_reset(lds, OTID()); EpiUp E{(bf16*)(ws + WS_ACT), (const u64*)(ws + WS_RSQ) + (size_t)(3 * l + 0) * M, lds};
            if ((PROBE_DUP >> 8) & 1) { S.r1 = 5; pg8::gemm_phase<EpiUp, pg8::StaticOrder, GEMM_ALIGN, GEMM_SP2>(lds, g, S, E, wave_s);
                { XcdBarrier b_; b_.bar = (unsigned*)(kargs()->ws + WS_CTL) + CW_BAR; b_.x = xb_xcc_id(); b_.st = (volatile LAS unsigned*)(lds + MISC_OFF) + 8; xcd_barrier(b_, OTID()); } S.r0 = 5; S.r1 = 1 << 30; }
            pg8::gemm_phase<EpiUp, pg8::StaticOrder, GEMM_ALIGN, GEMM_SP2>(lds, g, S, E, wave_s);
        }
        if ((PROBE_DUP >> 6) & 1) if (IN(g0 + PH_UP1)) {
            KArgs ka = kargs(); unsigned char* ws = ka->ws; unsigned char* wl = ws + WS_W + (size_t)l * W_LAYER;
            pg8::Gemm g{(const bf16*)(ws + WS_XB), (const bf16*)(wl + W_1A), M, 2 * FF, D}; pg8::StaticOrder S; S.init(M, 2 * FF, (int)gridDim.x, (int)blockIdx.x);
            EpiNull E{};
            pg8::gemm_phase<EpiNull, pg8::StaticOrder, GEMM_ALIGN, GEMM_SP2>(lds, g, S, E, wave_s);
        }
        LSEAM(g0 + PH_UP1);
        if (IN(g0 + PH_DN1)) {
            KArgs ka = kargs(); unsigned char* ws = ka->ws; unsigned char* wl = ws + WS_W + (size_t)l * W_LAYER;
            pg8::Gemm g{(const bf16*)(ws + WS_ACT), (const bf16*)(wl + W_1B), M, D, FF}; pg8::StaticOrder S; S.init(M, D, (int)gridDim.x, (int)blockIdx.x);
            EpiRes<1, false, FP8_GATES != 0> E{(bf16*)(ws + WS_XB), ws + WS_XL, nullptr, (u64*)(ws + WS_RSQ) + (size_t)(3 * l + 1) * M, ws + WS_XB8};
            pg8::gemm_phase<EpiRes<1, false, FP8_GATES != 0>, pg8::StaticOrder, GEMM_ALIGN, GEMM_SP2>(lds, g, S, E, wave_s);
        }
        if ((PROBE_DUP >> 9) & 1) if (IN(g0 + PH_DN1)) {
            KArgs ka = kargs(); unsigned char* ws = ka->ws; unsigned char* wl = ws + WS_W + (size_t)l * W_LAYER;
            pg8::Gemm g{(const bf16*)(ws + WS_ACT), (const bf16*)(wl + W_1B), M, D, FF}; pg8::StaticOrder S; S.init(M, D, (int)gridDim.x, (int)blockIdx.x);
            if ((PROBE_DUP >> 10) & 1) { g.ablk = true; g.bblk = true; }
            EpiNull E{};
            pg8::gemm_phase<EpiNull, pg8::StaticOrder, GEMM_ALIGN, GEMM_SP2>(lds, g, S, E, wave_s);
        }
        LSEAM(g0 + PH_DN1);
        for (int rep = 0; rep <= ((PROBE_DUP >> 2) & 1); ++rep)
        if (FP8_GATES && FP8_QK) {
            if (IN(g0 + PH_IN)) {
                KArgs ka = kargs(); unsigned char* ws = ka->ws; unsigned char* wl = ws + WS_W + (size_t)l * W_LAYER;
                pg8::Gemm g{(const bf16*)(ws + WS_XB8), (const bf16*)(wl + W_IN8), M, 12544, D / 2}; pg8::StaticOrder S; S.init(M, 12544, (int)gridDim.x, (int)blockIdx.x);
                EpiIn8 E{ws, (const u64*)(ws + WS_RSQ) + (size_t)(3 * l + 1) * M, ka->in[8] + (size_t)l * 768, lds};
                pg8::gemm_phase<EpiIn8, pg8::StaticOrder, GEMM_ALIGN, GEMM_SP2, true>(lds, g, S, E, wave_s);
            }
            if (IN(g0 + PH_IN)) {
                KArgs ka = kargs(); unsigned char* ws = ka->ws; unsigned char* wl = ws + WS_W + (size_t)l * W_LAYER;
                pg8::Gemm g{(const bf16*)(ws + WS_XB), (const bf16*)(wl + W_IN), M, 2816, D}; pg8::StaticOrder S; S.init(M, 2816, (int)gridDim.x, (int)gridDim.x - 1 - (int)blockIdx.x);
                EpiV E{ws, (const u64*)(ws + WS_RSQ) + (size_t)(3 * l + 1) * M};
                pg8::gemm_phase<EpiV, pg8::StaticOrder, GEMM_ALIGN, GEMM_SP2>(lds, g, S, E, wave_s);
            }
        } else {
        if (FP8_GATES && FP8_QA) {
            if (IN(g0 + PH_IN)) {
                KArgs ka = kargs(); unsigned char* ws = ka->ws; unsigned char* wl = ws + WS_W + (size_t)l * W_LAYER;
                constexpr int N8 = FP8_QA == 2 ? 11264 : 9216;
                pg8::Gemm g{(const bf16*)(ws + WS_XB8), (const bf16*)(wl + W_IN8), M, N8, D / 2}; pg8::StaticOrder S; S.init(M, N8, (int)gridDim.x, (int)blockIdx.x);
                rstd_cache_reset(lds, OTID()); EpiInT<2> E{ws, (const u64*)(ws + WS_RSQ) + (size_t)(3 * l + 1) * M, ka->in[8] + (size_t)l * 768, lds};
                pg8::gemm_phase<EpiInT<2>, pg8::StaticOrder, GEMM_ALIGN, GEMM_SP2, true>(lds, g, S, E, wave_s);
            }
            if (IN(g0 + PH_IN)) {
                KArgs ka = kargs(); unsigned char* ws = ka->ws; unsigned char* wl = ws + WS_W + (size_t)l * W_LAYER;
                constexpr int N16 = FP8_QA == 2 ? 4096 : 6144;
                pg8::Gemm g{(const bf16*)(ws + WS_XB), (const bf16*)(wl + W_IN) + (size_t)3072 * D, M, N16, D}; pg8::StaticOrder S; S.init(M, N16, (int)gridDim.x, (int)blockIdx.x);
                rstd_cache_reset(lds, OTID()); EpiInT<1> E{ws, (const u64*)(ws + WS_RSQ) + (size_t)(3 * l + 1) * M, ka->in[8] + (size_t)l * 768, lds};
                pg8::gemm_phase<EpiInT<1>, pg8::StaticOrder, GEMM_ALIGN, GEMM_SP2>(lds, g, S, E, wave_s);
            }
        } else {
        if (FP8_GATES && IN(g0 + PH_IN)) {
            KArgs ka = kargs(); unsigned char* ws = ka->ws; unsigned char* wl = ws + WS_W + (size_t)l * W_LAYER;
            pg8::Gemm g{(const bf16*)(ws + WS_XB8), (const bf16*)(wl + W_IN8), M, 6144, D / 2}; pg8::StaticOrder S; S.init(M, 6144, (int)gridDim.x, (int)blockIdx.x);
            rstd_cache_reset(lds, OTID()); EpiGate E{ws + WS_G, (const u64*)(ws + WS_RSQ) + (size_t)(3 * l + 1) * M, lds};
            pg8::gemm_phase<EpiGate, pg8::StaticOrder, GEMM_ALIGN, GEMM_SP2, true>(lds, g, S, E, wave_s);
        }
        if (IN(g0 + PH_IN)) {
            KArgs ka = kargs(); unsigned char* ws = ka->ws; unsigned char* wl = ws + WS_W + (size_t)l * W_LAYER;
            constexpr int NQKV = FP8_GATES ? 9216 : NIN;
            pg8::Gemm g{(const bf16*)(ws + WS_XB), (const bf16*)(wl + W_IN), M, NQKV, D}; pg8::StaticOrder S; S.init(M, NQKV, (int)gridDim.x, (int)blockIdx.x);
            rstd_cache_reset(lds, OTID()); EpiIn E{ws, (const u64*)(ws + WS_RSQ) + (size_t)(3 * l + 1) * M, ka->in[8] + (size_t)l * 768, lds};
            pg8::gemm_phase<EpiIn, pg8::StaticOrder, GEMM_ALIGN, GEMM_SP2>(lds, g, S, E, wave_s);
        }
        }
        }
        SEAM(g0 + PH_IN);
        if (!NORM_ON_LOAD && !QKN_IN_EPI && IN(g0 + PH_QKN)) { KArgs ka = kargs(); TIDS(); qknorm_phase(ka->ws, ka->in[8], l, gw, NGW, lane); }
        if (!NORM_ON_LOAD && !QKN_IN_EPI) SEAM(g0 + PH_QKN);
        for (int rep = 0; rep <= ((PROBE_DUP >> 3) & 1); ++rep)
        if (IN(g0 + PH_ATT)) {
            if (FAST_MASK != 0) { KArgs ka = kargs(); attn_fast_phase(ka->ws, ka->in[2], ka->in[8], ka->in[9], ka->in[10], l, lds, wave_s); __syncthreads(); }
            if (FAST_MASK != 7) { KArgs ka = kargs(); TIDS(); attn_naive_phase(ka->ws, ka->in[2], ka->in[9], ka->in[10], l, lds, gw, NGW, wave, lane); __syncthreads(); }
        }
        SEAM(g0 + PH_ATT);
        for (int rep = 0; rep <= ((PROBE_DUP >> 4) & 1); ++rep)
        if (IN(g0 + PH_CMB)) { KArgs ka = kargs(); TIDS(); combine_phase(ka->ws, gw, NGW, lane); }
        LSEAM(g0 + PH_CMB);
        for (int rep = 0; rep <= ((PROBE_DUP >> 5) & 1); ++rep)
        if (IN(g0 + PH_BR)) {
            KArgs ka = kargs(); unsigned char* ws = ka->ws; unsigned char* wl = ws + WS_W + (size_t)l * W_LAYER;
            pg8::Gemm g{(const bf16*)(ws + WS_O), (const bf16*)(wl + W_BR), M, D, KBR}; pg8::StaticOrder S; S.init(M, D, (int)gridDim.x, (int)blockIdx.x);
            EpiBr E{(const unsigned char*)(ws + WS_G), (bf16*)(ws + WS_Z)};
            pg8::gemm_phase<EpiBr, pg8::StaticOrder, GEMM_ALIGN, GEMM_SP2>(lds, g, S, E, wave_s);
        }
        LSEAM(g0 + PH_BR);
        if (IN(g0 + PH_OUT)) {
            KArgs ka = kargs(); unsigned char* ws = ka->ws; unsigned char* wl = ws + WS_W + (size_t)l * W_LAYER;
            pg8::Gemm g{(const bf16*)(ws + WS_Z), (const bf16*)(wl + W_O), M, D, D}; pg8::StaticOrder S; S.init(M, D, (int)gridDim.x, (int)blockIdx.x);
            EpiRes<0> E{(bf16*)(ws + WS_XB), ws + WS_XL, nullptr, (u64*)(ws + WS_RSQ) + (size_t)(3 * l + 2) * M};
            pg8::gemm_phase<EpiRes<0>, pg8::StaticOrder, GEMM_ALIGN, GEMM_SP2>(lds, g, S, E, wave_s);
        }
        LSEAM(g0 + PH_OUT);
        for (int rep = 0; rep <= ((PROBE_DUP >> 1) & 1); ++rep)
        if (IN(g0 + PH_UP2)) {
            KArgs ka = kargs(); unsigned char* ws = ka->ws; unsigned char* wl = ws + WS_W + (size_t)l * W_LAYER;
            pg8::Gemm g{(const bf16*)(ws + WS_XB), (const bf16*)(wl + W_2A), M, 2 * FF, D}; pg8::StaticOrder S; S.init(M, 2 * FF, (int)gridDim.x, (int)blockIdx.x);
            rstd_cache_reset(lds, OTID()); EpiUp E{(bf16*)(ws + WS_ACT), (const u64*)(ws + WS_RSQ) + (size_t)(3 * l + 2) * M, lds};
            if ((PROBE_DUP >> 8) & 1) { S.r1 = 5; pg8::gemm_phase<EpiUp, pg8::StaticOrder, GEMM_ALIGN, GEMM_SP2>(lds, g, S, E, wave_s);
                { XcdBarrier b_; b_.bar = (unsigned*)(kargs()->ws + WS_CTL) + CW_BAR; b_.x = xb_xcc_id(); b_.st = (volatile LAS unsigned*)(lds + MISC_OFF) + 8; xcd_barrier(b_, OTID()); } S.r0 = 5; S.r1 = 1 << 30; }
            pg8::gemm_phase<EpiUp, pg8::StaticOrder, GEMM_ALIGN, GEMM_SP2>(lds, g, S, E, wave_s);
        }
        LSEAM(g0 + PH_UP2);
        if (IN(g0 + PH_DN2)) {
            KArgs ka = kargs(); unsigned char* ws = ka->ws; unsigned char* wl = ws + WS_W + (size_t)l * W_LAYER;
            pg8::Gemm g{(const bf16*)(ws + WS_ACT), (const bf16*)(wl + W_2B), M, D, FF}; pg8::StaticOrder S; S.init(M, D, (int)gridDim.x, (int)blockIdx.x);
            if (l == DEPTH - 1) { EpiRes<1, true> E{(bf16*)(ws + WS_XB), ws + WS_XL, ka->out, nullptr};
                pg8::gemm_phase<EpiRes<1, true>, pg8::StaticOrder, GEMM_ALIGN, GEMM_SP2>(lds, g, S, E, wave_s); }
            else { EpiRes<1> E{(bf16*)(ws + WS_XB), ws + WS_XL, nullptr, (u64*)(ws + WS_RSQ) + (size_t)(3 * l + 3) * M};
                pg8::gemm_phase<EpiRes<1>, pg8::StaticOrder, GEMM_ALIGN, GEMM_SP2>(lds, g, S, E, wave_s); }
        }
        LSEAM(g0 + PH_DN2);

}
__global__ void __launch_bounds__(NWAVES * 64, 2) fwd(Args args) {
    extern __shared__ __attribute__((aligned(16))) unsigned char lds_raw[];
    LAS unsigned char* lds = (LAS unsigned char*)lds_raw;
#ifdef CODE_SHIFT_NOPS
    asm volatile(".rept " CODE_SHIFT_NOPS "\n\ts_nop 0\n\t.endr" ::: "memory");
#endif
    const int wave_s = __builtin_amdgcn_readfirstlane((int)threadIdx.x >> 6);
    { const int tid = OTID(); for (int u = tid; u < (LDS_BYTES - RING_BYTES) / 4; u += NWAVES * 64) ((LAS unsigned*)(lds + RING_BYTES))[u] = 0u; }
    __syncthreads();
    if (ONE_LAUNCH && LOCAL_SEAMS) { unsigned* xt = (unsigned*)(kargs()->ws + WS_CTL) + CW_BAR + XB_XTAB; const unsigned xv = xb_xcc_id() + 1u; if (OTID() == 0) xt[blockIdx.x] = xv; }
    if (ONE_LAUNCH) (void)xcd_barrier_post((unsigned*)(kargs()->ws + WS_CTL) + CW_BAR, (volatile LAS unsigned*)(lds + MISC_OFF) + 8, OTID());
    const int lo = args.ph_lo, hi = args.ph_hi;

    for (int rep = 0; rep <= (PROBE_DUP & 1); ++rep)
    if (IN(0)) { KArgs ka = kargs(); TIDS(); prologue(ka, lds, gw, NGW, wave, lane); __syncthreads(); }
    SEAM(0);
    if (ONE_LAUNCH && LOCAL_SEAMS) {
        const int tid = OTID(); const unsigned* xt = (const unsigned*)(kargs()->ws + WS_CTL) + CW_BAR + XB_XTAB;
        bool bad = (gridDim.x != 256u);
        if (!bad && tid < 256) { const unsigned a = xt[tid], b = xt[tid & 63]; bad = (a == 0u) || (a != b); }
        if (bad) ((volatile LAS unsigned*)(lds + MISC_OFF))[12] = 1u;
        __syncthreads();
    }
    layer_body<0>(lo, hi, lds, wave_s); layer_body<1>(lo, hi, lds, wave_s); layer_body<2>(lo, hi, lds, wave_s); layer_body<3>(lo, hi, lds, wave_s);
#undef IN
#undef SEAM
#undef LSEAM
#undef TIDS
#undef OTID
}

extern "C" void kernel_launch(void* const* d_in, const int* in_sizes, int n_in, void* d_out, int out_size, void* d_ws, size_t ws_size, hipStream_t stream) {
    static int grid = 0;
    if (grid == 0) {
        if (n_in != 18 || out_size != M * D || ws_size < WS_END) { fprintf(stderr, "kernel_launch: unexpected problem (n_in %d, out %d, ws %zu, need %zu); nothing launched\n", n_in, out_size, ws_size, (size_t)WS_END); grid = -1; return; }
        int dev = 0, cus = 0, per_cu = 0;
        if (hipGetDevice(&dev) != hipSuccess || hipDeviceGetAttribute(&cus, hipDeviceAttributeMultiprocessorCount, dev) != hipSuccess) { grid = -1; return; }
        if (hipFuncSetAttribute((const void*)fwd, hipFuncAttributeMaxDynamicSharedMemorySize, LDS_BYTES) != hipSuccess) { fprintf(stderr, "kernel_launch: hipFuncSetAttribute failed\n"); grid = -1; return; }
        if (hipOccupancyMaxActiveBlocksPerMultiprocessor(&per_cu, (const void*)fwd, NWAVES * 64, LDS_BYTES) != hipSuccess || per_cu < 1) { fprintf(stderr, "kernel_launch: occupancy query says %d\n", per_cu); }
        (void)hipGetLastError();
        grid = cus;
    }
    if (grid < 0) return;
    (void)hipMemsetAsync((char*)d_ws + WS_CTL, 0, CTL_ZERO_BYTES, stream);
    Args a{};
    for (int i = 0; i < 18; ++i) a.in[i] = (const float*)d_in[i];
    a.out = (float*)d_out; a.ws = (unsigned char*)d_ws;
    if (ONE_LAUNCH) { a.ph_lo = 0; a.ph_hi = NPH; hipLaunchKernelGGL(fwd, dim3(grid), dim3(NWAVES * 64), LDS_BYTES, stream, a); }
    else for (int p = 0; p < NPH; ++p) { a.ph_lo = p; a.ph_hi = p + 1; hipLaunchKernelGGL(fwd, dim3(grid), dim3(NWAVES * 64), LDS_BYTES, stream, a); }
}
```
